# Optimizing an MI355X kernel written in HIP

```python
import math
import jax, jax.numpy as jnp
from jax import lax
import numpy as np

D_MODEL = 1024
BATCH = 8
SEQ = 4096
DEPTH = 2

N_META = 16
DN_HEADS = 4
DN_DK = 128
DN_DV = 128
DN_CONV = 5
DN_CHUNK = 64
DIFF_HEADS = 4
DIFF_D = 64
DIFF_DV = 2 * DIFF_D
MLA_HEADS = 4
MLA_NOPE = 128
MLA_ROPE = 64
MLA_DV = 128
MLA_Q_RANK = 256
MLA_KV_RANK = 128
ROPE_THETA = 10000.0
T5_BUCKETS = 32
T5_MAX_DIST = 128
Q_BLOCK = 128
D_MIX = DN_HEADS * DN_DV + DIFF_HEADS * DIFF_DV + MLA_HEADS * MLA_DV
IN_SPLITS = (
    DN_HEADS * DN_DK,
    DN_HEADS * DN_DK,
    DN_HEADS * DN_DV,
    DN_HEADS * DN_DV,
    2 * DN_HEADS,
    2 * DN_HEADS,
    2 * DIFF_HEADS * DIFF_D,
    2 * DIFF_HEADS * DIFF_D,
    DIFF_HEADS * DIFF_DV,
    MLA_Q_RANK,
    MLA_KV_RANK,
    MLA_ROPE,
)
IN_COLS = 2 * DN_HEADS * DN_DK + 2 * DN_HEADS * DN_DV + 4 * DN_HEADS + 4 * DIFF_HEADS * DIFF_D + DIFF_HEADS * DIFF_DV + MLA_Q_RANK + MLA_KV_RANK + MLA_ROPE
D_FF = 2816
N_EXPERTS = 8
TOP_K = 2
D_FF_EXPERT = 3584
RMS_EPS = 1e-6

kernel_name = "hybrid_parallel_groups_encoder"


def rms_norm(x, w):
    xf = x.astype(jnp.float32)
    y = xf * lax.rsqrt(jnp.mean(xf * xf, axis=-1, keepdims=True) + RMS_EPS)
    return (y * w.astype(jnp.float32)).astype(x.dtype)


def l2_normalize(x):
    xf = x.astype(jnp.float32)
    return (xf * lax.rsqrt(jnp.sum(xf * xf, axis=-1, keepdims=True) + RMS_EPS)).astype(x.dtype)


def swiglu(h, w_gate, w_up, w_down):
    return (jax.nn.silu(h @ w_gate) * (h @ w_up)) @ w_down


def split_columns(proj):
    outs, start = [], 0
    for size in IN_SPLITS:
        outs.append(proj[..., start:start + size])
        start += size
    return outs


def over_query_blocks(attend, q, pos):
    out_meta = attend(q[..., :N_META, :], pos[:N_META])
    n_blk = (q.shape[-2] - N_META) // Q_BLOCK
    q_real = q[..., N_META:, :].reshape(q.shape[:-2] + (n_blk, Q_BLOCK, q.shape[-1]))
    q_real = jnp.moveaxis(q_real, -3, 0)
    pos_real = pos[N_META:].reshape(n_blk, Q_BLOCK)
    out = lax.map(lambda args: attend(args[0], args[1]), (q_real, pos_real))
    out = jnp.moveaxis(out, 0, -3)
    out = out.reshape(out.shape[:-3] + (n_blk * Q_BLOCK, out.shape[-1]))
    return jnp.concatenate([out_meta, out], axis=-2)


def t5_bucket(rel):
    half = T5_BUCKETS // 2
    exact = half // 2
    n = jnp.abs(rel)
    large = exact + (jnp.log(jnp.maximum(n, exact).astype(jnp.float32) / exact)
                     / math.log(T5_MAX_DIST / exact) * (half - exact)).astype(jnp.int32)
    large = jnp.minimum(large, half - 1)
    return jnp.where(rel > 0, half, 0) + jnp.where(n < exact, n, large)


def t5_bias(table, q_pos, k_pos):
    bucket = t5_bucket(k_pos[None, :] - q_pos[:, None])
    return jnp.transpose(table[bucket], (2, 0, 1)).astype(jnp.float32)


def rope(x, pos):
    half = MLA_ROPE // 2
    inv = 1.0 / (ROPE_THETA ** (jnp.arange(half, dtype=jnp.float32) / half))
    ang = pos.astype(jnp.float32)[:, None] * inv[None, :]
    cos, sin = jnp.cos(ang).astype(x.dtype), jnp.sin(ang).astype(x.dtype)
    x1, x2 = x[..., :half], x[..., half:]
    return jnp.concatenate([x1 * cos - x2 * sin, x1 * sin + x2 * cos], axis=-1)


def centred_depthwise_conv(x, w):
    k = w.shape[0]
    return lax.conv_general_dilated(
        x, w[:, None, :].astype(x.dtype), window_strides=(1,), padding=((k // 2, k // 2),),
        dimension_numbers=("NWC", "WIO", "NWC"), feature_group_count=x.shape[-1])


def meta_first_reverse(t):
    return jnp.concatenate([t[:, :N_META], jnp.flip(t[:, N_META:], axis=1)], axis=1)


def chunk_gated_delta_rule(q, k, v, beta, g):
    out_dtype = v.dtype
    q, k, v, beta, g = (t.astype(jnp.float32) for t in (q, k, v, beta, g))
    pad = DN_CHUNK - N_META
    padf = lambda t: jnp.pad(t, [(0, 0), (pad, 0)] + [(0, 0)] * (t.ndim - 2))
    q, k, v, beta, g = (padf(t) for t in (q, k, v, beta, g))
    b_, lp, h, dk = k.shape
    dv = v.shape[-1]
    n = lp // DN_CHUNK
    vec = lambda t: t.reshape(b_, n, DN_CHUNK, h, t.shape[-1]).transpose(1, 0, 3, 2, 4)
    sca = lambda t: t.reshape(b_, n, DN_CHUNK, h).transpose(1, 0, 3, 2)
    q, k, v, beta, g = vec(q), vec(k), vec(v), sca(beta), sca(g)
    gc = jnp.cumsum(g, axis=-1)
    tril = jnp.tril(jnp.ones((DN_CHUNK, DN_CHUNK), dtype=bool))
    strict = jnp.tril(jnp.ones((DN_CHUNK, DN_CHUNK), dtype=bool), -1)
    diff = gc[..., :, None] - gc[..., None, :]
    decay = jnp.where(tril, jnp.exp(jnp.where(tril, diff, 0.0)), 0.0)
    k_beta = k * beta[..., None]
    v_beta = v * beta[..., None]
    a_mat = jnp.where(strict, jnp.einsum("nbhid,nbhjd->nbhij", k_beta, k) * decay, 0.0)
    lhs = a_mat + jnp.eye(DN_CHUNK, dtype=jnp.float32)
    value = lax.linalg.triangular_solve(lhs, v_beta, left_side=True, lower=True, unit_diagonal=True)
    k_cumdecay = lax.linalg.triangular_solve(lhs, k_beta * jnp.exp(gc)[..., None],
                                             left_side=True, lower=True, unit_diagonal=True)
    qk = jnp.einsum("nbhid,nbhjd->nbhij", q, k) * decay

    def step(state, xs):
        q_i, k_i, value_i, kcd_i, qk_i, gc_i = xs
        v_new = value_i - kcd_i @ state
        out = (q_i * jnp.exp(gc_i)[..., None]) @ state + qk_i @ v_new
        g_last = gc_i[..., -1]
        k_w = k_i * jnp.exp(g_last[..., None] - gc_i)[..., None]
        state = state * jnp.exp(g_last)[..., None, None] + jnp.einsum("bhcd,bhce->bhde", k_w, v_new)
        return state, out

    state0 = jnp.zeros((b_, h, dk, dv), jnp.float32)
    _, out = lax.scan(step, state0, (q, k, value, k_cumdecay, qk, gc))
    out = out.transpose(1, 0, 3, 2, 4).reshape(b_, lp, h, dv)[:, pad:]
    return out.astype(out_dtype)


def gated_deltanet(q, k, v, z, b, a, conv_w, a_log, dt_bias, norm_w):
    bsz, seqlen, _ = q.shape
    qkv = jax.nn.silu(centred_depthwise_conv(jnp.concatenate([q, k, v], axis=-1), conv_w))
    q = qkv[..., :DN_HEADS * DN_DK]
    k = qkv[..., DN_HEADS * DN_DK:2 * DN_HEADS * DN_DK]
    v = qkv[..., 2 * DN_HEADS * DN_DK:]
    q = l2_normalize(q.reshape(bsz, seqlen, DN_HEADS, DN_DK)) * (DN_DK ** -0.5)
    k = l2_normalize(k.reshape(bsz, seqlen, DN_HEADS, DN_DK))
    v = v.reshape(bsz, seqlen, DN_HEADS, DN_DV)
    beta = jax.nn.sigmoid(b.reshape(bsz, seqlen, 2, DN_HEADS).astype(jnp.float32))
    g = -jnp.exp(a_log.astype(jnp.float32)) * jax.nn.softplus(
        a.reshape(bsz, seqlen, 2, DN_HEADS).astype(jnp.float32) + dt_bias.astype(jnp.float32))
    o_fwd = chunk_gated_delta_rule(q, k, v, beta[:, :, 0], g[:, :, 0])
    rev = meta_first_reverse
    o_bwd = rev(chunk_gated_delta_rule(rev(q), rev(k), rev(v), rev(beta[:, :, 1]), rev(g[:, :, 1])))
    o = rms_norm(o_fwd + o_bwd, norm_w) * jax.nn.silu(z.reshape(bsz, seqlen, DN_HEADS, DN_DV))
    return o.reshape(bsz, seqlen, DN_HEADS * DN_DV)


def diff_attention(q, k, v, q_norm_w, k_norm_w, lam_params, subln_w, rel_bias_table, pos, layer):
    bsz, seqlen, _ = q.shape
    q = rms_norm(q.reshape(bsz, seqlen, DIFF_HEADS, 2, DIFF_D), q_norm_w).transpose(0, 2, 3, 1, 4)
    k = rms_norm(k.reshape(bsz, seqlen, DIFF_HEADS, 2, DIFF_D), k_norm_w).transpose(0, 2, 3, 1, 4)
    v = v.reshape(bsz, seqlen, DIFF_HEADS, DIFF_DV).transpose(0, 2, 1, 3)
    lam_init = 0.8 - 0.6 * math.exp(-0.3 * layer)
    lp = lam_params.astype(jnp.float32)
    lam = jnp.exp(jnp.sum(lp[0] * lp[1])) - jnp.exp(jnp.sum(lp[2] * lp[3])) + lam_init
    scale = DIFF_D ** -0.5

    def attend(q_blk, pos_blk):
        s = jnp.einsum("bhcqd,bhckd->bhcqk", q_blk, k).astype(jnp.float32) * scale
        s = s + t5_bias(rel_bias_table, pos_blk, pos)[None, :, None]
        p = jax.nn.softmax(s, axis=-1)
        attn = p[:, :, 0] - lam * p[:, :, 1]
        return jnp.einsum("bhqk,bhkd->bhqd", attn.astype(v.dtype), v)

    o = over_query_blocks(attend, q, pos)
    o = rms_norm(o, subln_w) * (1.0 - lam_init)
    return o.transpose(0, 2, 1, 3).reshape(bsz, seqlen, DIFF_HEADS * DIFF_DV)


def mla_attention(c_q, c_kv, k_rope, q_lat_norm_w, w_uq, kv_lat_norm_w, w_ukv, q_norm_w, k_norm_w, pos):
    bsz, seqlen, _ = c_q.shape
    q = (rms_norm(c_q, q_lat_norm_w) @ w_uq).reshape(bsz, seqlen, MLA_HEADS, MLA_NOPE + MLA_ROPE)
    kv = (rms_norm(c_kv, kv_lat_norm_w) @ w_ukv).reshape(bsz, seqlen, MLA_HEADS, MLA_NOPE + MLA_DV)
    k_nope, v = kv[..., :MLA_NOPE], kv[..., MLA_NOPE:]
    k = jnp.concatenate([k_nope, jnp.broadcast_to(k_rope[:, :, None, :], (bsz, seqlen, MLA_HEADS, MLA_ROPE))], axis=-1)
    q = rms_norm(q, q_norm_w).transpose(0, 2, 1, 3)
    k = rms_norm(k, k_norm_w).transpose(0, 2, 1, 3)
    q = jnp.concatenate([q[..., :MLA_NOPE], rope(q[..., MLA_NOPE:], pos)], axis=-1)
    k = jnp.concatenate([k[..., :MLA_NOPE], rope(k[..., MLA_NOPE:], pos)], axis=-1)
    v = v.transpose(0, 2, 1, 3)
    scale = (MLA_NOPE + MLA_ROPE) ** -0.5

    def attend(q_blk, pos_blk):
        s = jnp.einsum("bhqd,bhkd->bhqk", q_blk, k).astype(jnp.float32) * scale
        p = jax.nn.softmax(s, axis=-1)
        return jnp.einsum("bhqk,bhkd->bhqd", p.astype(v.dtype), v)

    o = over_query_blocks(attend, q, pos)
    return o.transpose(0, 2, 1, 3).reshape(bsz, seqlen, MLA_HEADS * MLA_DV)


def moe_swiglu(h, router_w, w_gate, w_up, w_down):
    logits = (h @ router_w).astype(jnp.float32)
    top_vals, top_idx = lax.top_k(logits, TOP_K)
    gates = jax.nn.softmax(top_vals, axis=-1)
    combine = jnp.sum(jax.nn.one_hot(top_idx, N_EXPERTS, dtype=jnp.float32) * gates[..., None], axis=-2)
    out = jnp.zeros_like(h)
    for e in range(N_EXPERTS):
        out = out + combine[..., e:e + 1].astype(h.dtype) * swiglu(h, w_gate[e], w_up[e], w_down[e])
    return out


def setup_inputs(seed: int = 0) -> dict:
    key = jax.random.key(seed)
    ks = iter(jax.random.split(key, 40))
    nrm = lambda shape, scale: jax.random.normal(next(ks), shape, jnp.float32) * scale
    gain = lambda shape: 1.0 + 0.05 * jax.random.normal(next(ks), shape, jnp.float32)
    n_dense = (DEPTH + 1) // 2
    n_moe = DEPTH // 2
    a_init = jax.random.uniform(next(ks), (DEPTH, 2, DN_HEADS), jnp.float32, minval=1.0, maxval=16.0)
    dt = jnp.exp(jax.random.uniform(next(ks), (DEPTH, 2, DN_HEADS), jnp.float32,
                                    minval=math.log(1e-3), maxval=math.log(1e-1)))
    return {
        "x": nrm((BATCH, SEQ, D_MODEL), 1.0),
        "meta_tokens": nrm((N_META, D_MODEL), 1.0),
        "rel_bias_table": nrm((T5_BUCKETS, DIFF_HEADS), 0.5),
        "attn_norm_w": gain((DEPTH, D_MODEL)),
        "w_in": nrm((DEPTH, D_MODEL, IN_COLS), D_MODEL ** -0.5),
        "dn_conv_w": nrm((DEPTH, DN_CONV, 2 * DN_HEADS * DN_DK + DN_HEADS * DN_DV), DN_CONV ** -0.5),
        "dn_a_log": jnp.log(a_init),
        "dn_dt_bias": dt + jnp.log(-jnp.expm1(-dt)),
        "dn_norm_w": gain((DEPTH, DN_DV)),
        "diff_q_norm_w": gain((DEPTH, DIFF_D)),
        "diff_k_norm_w": gain((DEPTH, DIFF_D)),
        "diff_lambda": nrm((DEPTH, 4, DIFF_D), 0.1),
        "diff_subln_w": gain((DEPTH, DIFF_DV)),
        "mla_q_lat_norm_w": gain((DEPTH, MLA_Q_RANK)),
        "mla_w_uq": nrm((DEPTH, MLA_Q_RANK, MLA_HEADS * (MLA_NOPE + MLA_ROPE)), MLA_Q_RANK ** -0.5),
        "mla_kv_lat_norm_w": gain((DEPTH, MLA_KV_RANK)),
        "mla_w_ukv": nrm((DEPTH, MLA_KV_RANK, MLA_HEADS * (MLA_NOPE + MLA_DV)), MLA_KV_RANK ** -0.5),
        "mla_q_norm_w": gain((DEPTH, MLA_NOPE + MLA_ROPE)),
        "mla_k_norm_w": gain((DEPTH, MLA_NOPE + MLA_ROPE)),
        "w_out": nrm((DEPTH, D_MIX, D_MODEL), D_MIX ** -0.5),
        "ffn_norm_w": gain((DEPTH, D_MODEL)),
        "ffn_w_gate": nrm((n_dense, D_MODEL, D_FF), D_MODEL ** -0.5),
        "ffn_w_up": nrm((n_dense, D_MODEL, D_FF), D_MODEL ** -0.5),
        "ffn_w_down": nrm((n_dense, D_FF, D_MODEL), D_FF ** -0.5),
        "router_w": nrm((n_moe, D_MODEL, N_EXPERTS), D_MODEL ** -0.5),
        "moe_w_gate": nrm((n_moe, N_EXPERTS, D_MODEL, D_FF_EXPERT), D_MODEL ** -0.5),
        "moe_w_up": nrm((n_moe, N_EXPERTS, D_MODEL, D_FF_EXPERT), D_MODEL ** -0.5),
        "moe_w_down": nrm((n_moe, N_EXPERTS, D_FF_EXPERT, D_MODEL), D_FF_EXPERT ** -0.5),
    }


def reference(x, meta_tokens, rel_bias_table, attn_norm_w, w_in, dn_conv_w, dn_a_log, dn_dt_bias,
              dn_norm_w, diff_q_norm_w, diff_k_norm_w, diff_lambda, diff_subln_w, mla_q_lat_norm_w,
              mla_w_uq, mla_kv_lat_norm_w, mla_w_ukv, mla_q_norm_w, mla_k_norm_w, w_out, ffn_norm_w,
              ffn_w_gate, ffn_w_up, ffn_w_down, router_w, moe_w_gate, moe_w_up, moe_w_down):
    bsz = x.shape[0]
    meta = jnp.broadcast_to(meta_tokens[None].astype(x.dtype), (bsz, N_META, D_MODEL))
    h = jnp.concatenate([meta, x], axis=1)
    pos = jnp.arange(h.shape[1], dtype=jnp.int32)
    for l in range(DEPTH):
        u = rms_norm(h, attn_norm_w[l])
        (dn_q, dn_k, dn_v, dn_z, dn_b, dn_a, df_q, df_k, df_v, ml_cq, ml_ckv, ml_kr) = split_columns(u @ w_in[l])
        y_dn = gated_deltanet(dn_q, dn_k, dn_v, dn_z, dn_b, dn_a, dn_conv_w[l], dn_a_log[l], dn_dt_bias[l], dn_norm_w[l])
        y_df = diff_attention(df_q, df_k, df_v, diff_q_norm_w[l], diff_k_norm_w[l], diff_lambda[l],
                              diff_subln_w[l], rel_bias_table, pos, l)
        y_ml = mla_attention(ml_cq, ml_ckv, ml_kr, mla_q_lat_norm_w[l], mla_w_uq[l], mla_kv_lat_norm_w[l],
                             mla_w_ukv[l], mla_q_norm_w[l], mla_k_norm_w[l], pos)
        h = h + jnp.concatenate([y_dn, y_df, y_ml], axis=-1) @ w_out[l]
        u = rms_norm(h, ffn_norm_w[l])
        if l % 2 == 0:
            h = h + swiglu(u, ffn_w_gate[l // 2], ffn_w_up[l // 2], ffn_w_down[l // 2])
        else:
            h = h + moe_swiglu(u, router_w[l // 2], moe_w_gate[l // 2], moe_w_up[l // 2], moe_w_down[l // 2])
    return h[:, N_META:]
```

```cpp
#include <hip/hip_runtime.h>
#include <stdint.h>

namespace nv {
constexpr int NB = 8, SEQ = 4096, NM = 16, L = 4112, D = 1024, INC = 4048, DMIX = 1536, DFF = 2816, NE = 8, DFE = 3584;
constexpr int C_DNQ = 0, C_DNK = 512, C_DNV = 1024, C_DNZ = 1536, C_DNB = 2048, C_DNA = 2056, C_DFQ = 2064, C_DFK = 2576, C_DFV = 3088,
              C_MLQ = 3600, C_MLKV = 3856, C_MLKR = 3984;
constexpr float EPS = 1e-6f;

__device__ __forceinline__ float siluf(float x) { return x / (1.f + expf(-x)); }
__device__ __forceinline__ float wave_sum(float v) {
#pragma unroll
    for (int o = 32; o > 0; o >>= 1) v += __shfl_xor(v, o);
    return v;
}
__device__ __forceinline__ float wave_max(float v) {
#pragma unroll
    for (int o = 32; o > 0; o >>= 1) v = fmaxf(v, __shfl_xor(v, o));
    return v;
}

template <bool TB>
__global__ void __launch_bounds__(256) k_gemm(const float* __restrict__ A, int lda, const float* __restrict__ B, int ldb, float* __restrict__ C, int ldc,
                                              int M, int N, int K, const int* Mdev, int accumulate) {
    if (Mdev) M = *Mdev;
    const int bm = blockIdx.y * 64, bn = blockIdx.x * 64;
    if (bm >= M) return;
    __shared__ float As[16][65], Bs[16][65];
    const int tx = threadIdx.x & 15, ty = threadIdx.x >> 4;
    float acc[4][4];
#pragma unroll
    for (int i = 0; i < 4; ++i)
#pragma unroll
        for (int j = 0; j < 4; ++j) acc[i][j] = 0.f;
    for (int k0 = 0; k0 < K; k0 += 16) {
#pragma unroll
        for (int i = 0; i < 4; ++i) {
            const int idx = threadIdx.x + i * 256;
            { const int r = idx >> 4, kk = idx & 15; As[kk][r] = (bm + r < M && k0 + kk < K) ? A[(size_t)(bm + r) * lda + k0 + kk] : 0.f; }
            if (TB) { const int n = idx >> 4, kk = idx & 15; Bs[kk][n] = (bn + n < N && k0 + kk < K) ? B[(size_t)(bn + n) * ldb + k0 + kk] : 0.f; }
            else    { const int kk = idx >> 6, n = idx & 63; Bs[kk][n] = (bn + n < N && k0 + kk < K) ? B[(size_t)(k0 + kk) * ldb + bn + n] : 0.f; }
        }
        __syncthreads();
#pragma unroll
        for (int kk = 0; kk < 16; ++kk) {
            float a[4], b[4];
#pragma unroll
            for (int i = 0; i < 4; ++i) { a[i] = As[kk][ty * 4 + i]; b[i] = Bs[kk][tx * 4 + i]; }
#pragma unroll
            for (int i = 0; i < 4; ++i)
#pragma unroll
                for (int j = 0; j < 4; ++j) acc[i][j] = fmaf(a[i], b[j], acc[i][j]);
        }
        __syncthreads();
    }
#pragma unroll
    for (int i = 0; i < 4; ++i)
#pragma unroll
        for (int j = 0; j < 4; ++j) {
            const int r = bm + ty * 4 + i, c = bn + tx * 4 + j;
            if (r < M && c < N) { float* p = C + (size_t)r * ldc + c; *p = accumulate ? (*p + acc[i][j]) : acc[i][j]; }
        }
}

__global__ void k_build_h(const float* __restrict__ x, const float* __restrict__ meta, float* __restrict__ H) {
    const size_t n = (size_t)NB * L * D;
    for (size_t i = (size_t)blockIdx.x * blockDim.x + threadIdx.x; i < n; i += (size_t)gridDim.x * blockDim.x) {
        const int d = (int)(i % D); const size_t r = i / D; const int t = (int)(r % L), b = (int)(r / L);
        H[i] = t < NM ? meta[t * D + d] : x[((size_t)b * SEQ + (t - NM)) * D + d];
    }
}
__global__ void k_write_out(const float* __restrict__ H, float* __restrict__ out) {
    const size_t n = (size_t)NB * SEQ * D;
    for (size_t i = (size_t)blockIdx.x * blockDim.x + threadIdx.x; i < n; i += (size_t)gridDim.x * blockDim.x) {
        const int d = (int)(i % D); const size_t r = i / D; const int s = (int)(r % SEQ), b = (int)(r / SEQ);
        out[i] = H[((size_t)b * L + NM + s) * D + d];
    }
}

__global__ void __launch_bounds__(256) k_rmsnorm(const float* __restrict__ in, int in_ld, float* __restrict__ out, int out_ld, const float* __restrict__ w,
                                                 int rows, int groups, int n, float scale) {
    const int wid = (blockIdx.x * blockDim.x + threadIdx.x) >> 6, lane = threadIdx.x & 63;
    if (wid >= rows * groups) return;
    const int r = wid / groups, g = wid % groups;
    const float* p = in + (size_t)r * in_ld + g * n; float* q = out + (size_t)r * out_ld + g * n;
    float ss = 0.f;
    for (int i = lane; i < n; i += 64) { const float v = p[i]; ss += v * v; }
    ss = wave_sum(ss);
    const float rs = rsqrtf(ss / (float)n + EPS) * scale;
    for (int i = lane; i < n; i += 64) q[i] = p[i] * rs * w[i];
}

__global__ void k_dn_conv(const float* __restrict__ proj, const float* __restrict__ cw, float* __restrict__ qkvc) {
    const int n = L * 1536;
    for (int i = blockIdx.x * blockDim.x + threadIdx.x; i < n; i += gridDim.x * blockDim.x) {
        const int c = i % 1536, t = i / 1536; float a = 0.f;
#pragma unroll
        for (int j = 0; j < 5; ++j) { const int tt = t + j - 2; if (tt >= 0 && tt < L) a += proj[(size_t)tt * INC + c] * cw[j * 1536 + c]; }
        qkvc[i] = siluf(a);
    }
}
__global__ void __launch_bounds__(256) k_dn_l2(float* __restrict__ qkvc) {
    const int wid = (blockIdx.x * blockDim.x + threadIdx.x) >> 6, lane = threadIdx.x & 63;
    if (wid >= L * 8) return;
    const int t = wid / 8, g = wid % 8;
    float* p = qkvc + (size_t)t * 1536 + g * 128;
    const float a = p[lane], b = p[lane + 64];
    const float ss = wave_sum(a * a + b * b);
    const float rs = rsqrtf(ss + EPS) * (g < 4 ? 0.08838834764831845f : 1.f);
    p[lane] = a * rs; p[lane + 64] = b * rs;
}
__global__ void k_dn_bg(const float* __restrict__ proj, const float* __restrict__ a_log, const float* __restrict__ dt_bias, float* __restrict__ beta, float* __restrict__ g) {
    const int n = L * 8;
    for (int i = blockIdx.x * blockDim.x + threadIdx.x; i < n; i += gridDim.x * blockDim.x) {
        const int j = i % 8, t = i / 8;
        const float bl = proj[(size_t)t * INC + C_DNB + j], al = proj[(size_t)t * INC + C_DNA + j] + dt_bias[j];
        beta[i] = 1.f / (1.f + expf(-bl));
        const float sp = al > 20.f ? al : log1pf(expf(al));
        g[i] = -expf(a_log[j]) * sp;
    }
}
__global__ void __launch_bounds__(128) k_dn_scan(const float* __restrict__ qkvc, const float* __restrict__ beta, const float* __restrict__ g, float* __restrict__ odn) {
    const int j = blockIdx.x, dir = j >> 2, h = j & 3, e = threadIdx.x;
    __shared__ float sq[16][128], sk[16][128];
    __shared__ float sb[16], sg[16];
    float S[128];
#pragma unroll
    for (int d = 0; d < 128; ++d) S[d] = 0.f;
    float* o = odn + (size_t)dir * L * 512;
    for (int i0 = 0; i0 < L; i0 += 16) {
        __syncthreads();
        float vv[16];
#pragma unroll
        for (int s = 0; s < 16; ++s) {
            const int i = i0 + s; const int t = (dir == 0 || i < NM) ? i : (L + NM - 1 - i);
            sq[s][e] = qkvc[(size_t)t * 1536 + h * 128 + e];
            sk[s][e] = qkvc[(size_t)t * 1536 + 512 + h * 128 + e];
            vv[s] = qkvc[(size_t)t * 1536 + 1024 + h * 128 + e];
            if (e == 0) { sb[s] = beta[t * 8 + j]; sg[s] = g[t * 8 + j]; }
        }
        __syncthreads();
#pragma unroll
        for (int s = 0; s < 16; ++s) {
            const int i = i0 + s; const int t = (dir == 0 || i < NM) ? i : (L + NM - 1 - i);
            const float al = expf(sg[s]), be = sb[s];
            float r = 0.f;
#pragma unroll
            for (int d = 0; d < 128; ++d) { S[d] *= al; r = fmaf(sk[s][d], S[d], r); }
            const float vn = be * (vv[s] - r);
            float oo = 0.f;
#pragma unroll
            for (int d = 0; d < 128; ++d) { S[d] = fmaf(sk[s][d], vn, S[d]); oo = fmaf(sq[s][d], S[d], oo); }
            o[(size_t)t * 512 + h * 128 + e] = oo;
        }
    }
}
__global__ void __launch_bounds__(256) k_dn_out(const float* __restrict__ odn, const float* __restrict__ proj, const float* __restrict__ w, float* __restrict__ y) {
    const int wid = (blockIdx.x * blockDim.x + threadIdx.x) >> 6, lane = threadIdx.x & 63;
    if (wid >= L * 4) return;
    const int t = wid / 4, h = wid % 4;
    const size_t o = (size_t)t * 512 + h * 128;
    const float a = odn[o + lane] + odn[(size_t)L * 512 + o + lane], b = odn[o + lane + 64] + odn[(size_t)L * 512 + o + lane + 64];
    const float ss = wave_sum(a * a + b * b);
    const float rs = rsqrtf(ss / 128.f + EPS);
    const float z0 = proj[(size_t)t * INC + C_DNZ + h * 128 + lane], z1 = proj[(size_t)t * INC + C_DNZ + h * 128 + lane + 64];
    y[(size_t)t * DMIX + h * 128 + lane] = a * rs * w[lane] * siluf(z0);
    y[(size_t)t * DMIX + h * 128 + lane + 64] = b * rs * w[lane + 64] * siluf(z1);
}

__device__ __forceinline__ int t5_bucket(int rel) {
    const int n = rel < 0 ? -rel : rel;
    int f;
    if (n < 8) f = n; else if (n < 12) f = 8; else if (n < 16) f = 9; else if (n < 23) f = 10; else if (n < 32) f = 11;
    else if (n < 46) f = 12; else if (n < 64) f = 13; else if (n < 91) f = 14; else f = 15;
    return (rel > 0 ? 16 : 0) + f;
}
__global__ void k_lam(const float* __restrict__ lp, float lam_init, float* __restrict__ lam) {
    const int lane = threadIdx.x;
    const float a = wave_sum(lp[lane] * lp[64 + lane]), b = wave_sum(lp[128 + lane] * lp[192 + lane]);
    if (lane == 0) *lam = expf(a) - expf(b) + lam_init;
}
__device__ __forceinline__ float block_max(float v, float* sm) {
    v = wave_max(v); const int w = threadIdx.x >> 6;
    __syncthreads(); if ((threadIdx.x & 63) == 0) sm[w] = v; __syncthreads();
    return fmaxf(fmaxf(sm[0], sm[1]), fmaxf(sm[2], sm[3]));
}
__device__ __forceinline__ float block_sum(float v, float* sm) {
    v = wave_sum(v); const int w = threadIdx.x >> 6;
    __syncthreads(); if ((threadIdx.x & 63) == 0) sm[w] = v; __syncthreads();
    return sm[0] + sm[1] + sm[2] + sm[3];
}
__global__ void __launch_bounds__(256) k_diff_softmax(float* __restrict__ S0, const float* __restrict__ S1, const float* __restrict__ table, int h, const float* __restrict__ lamp) {
    __shared__ float sm[4];
    const int i = blockIdx.x; const float lam = *lamp;
    float* r0 = S0 + (size_t)i * L; const float* r1 = S1 + (size_t)i * L;
    float m0 = -3e38f, m1 = -3e38f;
    for (int jx = threadIdx.x; jx < L; jx += 256) { const float bz = table[t5_bucket(jx - i) * 4 + h]; m0 = fmaxf(m0, r0[jx] * 0.125f + bz); m1 = fmaxf(m1, r1[jx] * 0.125f + bz); }
    m0 = block_max(m0, sm); m1 = block_max(m1, sm);
    float s0 = 0.f, s1 = 0.f;
    for (int jx = threadIdx.x; jx < L; jx += 256) { const float bz = table[t5_bucket(jx - i) * 4 + h]; s0 += expf(r0[jx] * 0.125f + bz - m0); s1 += expf(r1[jx] * 0.125f + bz - m1); }
    s0 = block_sum(s0, sm); s1 = block_sum(s1, sm);
    const float i0 = 1.f / s0, i1 = 1.f / s1;
    for (int jx = threadIdx.x; jx < L; jx += 256) { const float bz = table[t5_bucket(jx - i) * 4 + h];
        r0[jx] = expf(r0[jx] * 0.125f + bz - m0) * i0 - lam * expf(r1[jx] * 0.125f + bz - m1) * i1; }
}
__global__ void __launch_bounds__(256) k_softmax(float* __restrict__ S0, float scale) {
    __shared__ float sm[4];
    float* r0 = S0 + (size_t)blockIdx.x * L;
    float m0 = -3e38f;
    for (int jx = threadIdx.x; jx < L; jx += 256) m0 = fmaxf(m0, r0[jx] * scale);
    m0 = block_max(m0, sm);
    float s0 = 0.f;
    for (int jx = threadIdx.x; jx < L; jx += 256) s0 += expf(r0[jx] * scale - m0);
    s0 = block_sum(s0, sm);
    const float i0 = 1.f / s0;
    for (int jx = threadIdx.x; jx < L; jx += 256) r0[jx] = expf(r0[jx] * scale - m0) * i0;
}
__global__ void __launch_bounds__(256) k_mla_prep(const float* __restrict__ mlq, const float* __restrict__ mlkv, const float* __restrict__ proj,
                                                  const float* __restrict__ qw, const float* __restrict__ kw, float* __restrict__ qf, float* __restrict__ kf) {
    const int wid = (blockIdx.x * blockDim.x + threadIdx.x) >> 6, lane = threadIdx.x & 63;
    if (wid >= L * 8) return;
    const int t = wid / 8, h = (wid % 8) >> 1, which = wid & 1;
    float v[3];
    if (which == 0) { v[0] = mlq[(size_t)t * 768 + h * 192 + lane]; v[1] = mlq[(size_t)t * 768 + h * 192 + 64 + lane]; v[2] = mlq[(size_t)t * 768 + h * 192 + 128 + lane]; }
    else { v[0] = mlkv[(size_t)t * 1024 + h * 256 + lane]; v[1] = mlkv[(size_t)t * 1024 + h * 256 + 64 + lane]; v[2] = proj[(size_t)t * INC + C_MLKR + lane]; }
    const float ss = wave_sum(v[0] * v[0] + v[1] * v[1] + v[2] * v[2]);
    const float rs = rsqrtf(ss / 192.f + EPS);
    const float* w = which == 0 ? qw : kw;
#pragma unroll
    for (int c = 0; c < 3; ++c) v[c] = v[c] * rs * w[c * 64 + lane];
    const int i = lane & 31;
    const float inv = 1.0f / powf(10000.0f, (float)i / 32.0f);
    const float ang = (float)t * inv;
    const float cs = cosf(ang), sn = sinf(ang);
    const float other = __shfl_xor(v[2], 32);
    const float rv = lane < 32 ? (v[2] * cs - other * sn) : (other * sn + v[2] * cs);
    float* o = (which == 0 ? qf : kf) + (size_t)t * 768 + h * 192;
    o[lane] = v[0]; o[64 + lane] = v[1]; o[128 + lane] = rv;
}

__global__ void k_swiglu_act(float* __restrict__ G, const float* __restrict__ U, int ld, int cols, int rows, const int* rowsdev) {
    if (rowsdev) rows = *rowsdev;
    const size_t n = (size_t)rows * cols;
    for (size_t i = (size_t)blockIdx.x * blockDim.x + threadIdx.x; i < n; i += (size_t)gridDim.x * blockDim.x) {
        const size_t r = i / cols, c = i % cols; const size_t o = r * ld + c;
        G[o] = siluf(G[o]) * U[o];
    }
}
__global__ void k_zero_int(int* p, int n) { const int i = blockIdx.x * blockDim.x + threadIdx.x; if (i < n) p[i] = 0; }
__global__ void __launch_bounds__(256) k_router(const float* __restrict__ U, const float* __restrict__ rw, int* __restrict__ cnt, int* __restrict__ list, float* __restrict__ gate) {
    const int t = (blockIdx.x * blockDim.x + threadIdx.x) >> 6, lane = threadIdx.x & 63;
    if (t >= L) return;
    float lg[NE];
#pragma unroll
    for (int e = 0; e < NE; ++e) lg[e] = 0.f;
    for (int d = lane; d < D; d += 64) { const float u = U[(size_t)t * D + d];
#pragma unroll
        for (int e = 0; e < NE; ++e) lg[e] = fmaf(u, rw[d * NE + e], lg[e]); }
#pragma unroll
    for (int e = 0; e < NE; ++e) lg[e] = wave_sum(lg[e]);
    if (lane == 0) {
        int i0 = 0; float v0 = lg[0];
#pragma unroll
        for (int e = 1; e < NE; ++e) if (lg[e] > v0) { v0 = lg[e]; i0 = e; }
        int i1 = -1; float v1 = -3e38f;
#pragma unroll
        for (int e = 0; e < NE; ++e) if (e != i0 && lg[e] > v1) { v1 = lg[e]; i1 = e; }
        const float e1 = expf(v1 - v0), g0 = 1.f / (1.f + e1), g1 = e1 / (1.f + e1);
        gate[t * 2] = g0; gate[t * 2 + 1] = g1;
        const int p0 = atomicAdd(&cnt[i0], 1); list[i0 * L + p0] = t * 2;
        const int p1 = atomicAdd(&cnt[i1], 1); list[i1 * L + p1] = t * 2 + 1;
    }
}
__global__ void k_gather(const float* __restrict__ U, const int* __restrict__ list, const int* __restrict__ cnt, float* __restrict__ X) {
    const int n = *cnt;
    for (size_t i = (size_t)blockIdx.x * blockDim.x + threadIdx.x; i < (size_t)n * D; i += (size_t)gridDim.x * blockDim.x) {
        const int r = (int)(i / D), d = (int)(i % D); X[i] = U[(size_t)(list[r] >> 1) * D + d];
    }
}
__global__ void k_scatter(const float* __restrict__ Y, const int* __restrict__ list, const int* __restrict__ cnt, float* __restrict__ YS) {
    const int n = *cnt;
    for (size_t i = (size_t)blockIdx.x * blockDim.x + threadIdx.x; i < (size_t)n * D; i += (size_t)gridDim.x * blockDim.x) {
        const int r = (int)(i / D), d = (int)(i % D); YS[(size_t)list[r] * D + d] = Y[i];
    }
}
__global__ void k_moe_combine(float* __restrict__ H, const float* __restrict__ YS, const float* __restrict__ gate) {
    const size_t n = (size_t)L * D;
    for (size_t i = (size_t)blockIdx.x * blockDim.x + threadIdx.x; i < n; i += (size_t)gridDim.x * blockDim.x) {
        const size_t t = i / D, d = i % D;
        H[i] = H[i] + (gate[t * 2] * YS[(t * 2) * D + d] + gate[t * 2 + 1] * YS[(t * 2 + 1) * D + d]);
    }
}
}

extern "C" void kernel_launch(void* const* d_in, const int* in_sizes, int n_in, void* d_out, int out_size, void* d_ws, size_t ws_size, hipStream_t stream) {
    using namespace nv;
    const float* x = (const float*)d_in[0];
    const float* meta = (const float*)d_in[1];
    const float* rel_table = (const float*)d_in[2];
    const float* attn_norm_w = (const float*)d_in[3];
    const float* w_in = (const float*)d_in[4];
    const float* dn_conv_w = (const float*)d_in[5];
    const float* dn_a_log = (const float*)d_in[6];
    const float* dn_dt_bias = (const float*)d_in[7];
    const float* dn_norm_w = (const float*)d_in[8];
    const float* diff_q_norm_w = (const float*)d_in[9];
    const float* diff_k_norm_w = (const float*)d_in[10];
    const float* diff_lambda = (const float*)d_in[11];
    const float* diff_subln_w = (const float*)d_in[12];
    const float* mla_q_lat_norm_w = (const float*)d_in[13];
    const float* mla_w_uq = (const float*)d_in[14];
    const float* mla_kv_lat_norm_w = (const float*)d_in[15];
    const float* mla_w_ukv = (const float*)d_in[16];
    const float* mla_q_norm_w = (const float*)d_in[17];
    const float* mla_k_norm_w = (const float*)d_in[18];
    const float* w_out = (const float*)d_in[19];
    const float* ffn_norm_w = (const float*)d_in[20];
    const float* ffn_w_gate = (const float*)d_in[21];
    const float* ffn_w_up = (const float*)d_in[22];
    const float* ffn_w_down = (const float*)d_in[23];
    const float* router_w = (const float*)d_in[24];
    const float* moe_w_gate = (const float*)d_in[25];
    const float* moe_w_up = (const float*)d_in[26];
    const float* moe_w_down = (const float*)d_in[27];
    float* out = (float*)d_out;

    float* ws = (float*)d_ws; size_t off = 0;
    auto take = [&](size_t n) { float* p = ws + off; off += (n + 63) & ~(size_t)63; return p; };
    float* H = take((size_t)NB * L * D);
    float* U = take((size_t)L * D);
    float* PROJ = take((size_t)L * INC);
    float* QKVC = take((size_t)L * 1536);
    float* BETA = take((size_t)L * 8);
    float* GG = take((size_t)L * 8);
    float* ODN = take((size_t)2 * L * 512);
    float* Y = take((size_t)L * DMIX);
    float* DFQ = take((size_t)L * 512);
    float* DFK = take((size_t)L * 512);
    float* ODF = take((size_t)L * 512);
    float* CQN = take((size_t)L * 256);
    float* CKVN = take((size_t)L * 128);
    float* MLQ = take((size_t)L * 768);
    float* MLKV = take((size_t)L * 1024);
    float* QF = take((size_t)L * 768);
    float* KF = take((size_t)L * 768);
    float* LAM = take(64);
    float* GATE = take((size_t)L * 2);
    int* CNT = (int*)take(64);
    int* LIST = (int*)take((size_t)NE * L);
    float* S0 = take((size_t)L * L);
    float* S1 = take((size_t)L * L);
    float* FG = S0;
    float* FU = S1;
    float* XG = QKVC;
    float* YE = PROJ;
    float* YS = PROJ + (size_t)L * D;

    auto gemm = [&](bool tb, const float* A, int lda, const float* B, int ldb, float* C, int ldc, int M, int N, int K, const int* Mdev, int acc) {
        dim3 g((N + 63) / 64, (M + 63) / 64);
        if (tb) k_gemm<true><<<g, 256, 0, stream>>>(A, lda, B, ldb, C, ldc, M, N, K, Mdev, acc);
        else    k_gemm<false><<<g, 256, 0, stream>>>(A, lda, B, ldb, C, ldc, M, N, K, Mdev, acc);
    };
    auto rms = [&](const float* in, int in_ld, float* o, int out_ld, const float* w, int rows, int groups, int n, float scale) {
        const int waves = rows * groups; k_rmsnorm<<<(waves + 3) / 4, 256, 0, stream>>>(in, in_ld, o, out_ld, w, rows, groups, n, scale);
    };

    k_build_h<<<2048, 256, 0, stream>>>(x, meta, H);
    for (int l = 0; l < 2; ++l) {
        const float lam_init = 0.8f - 0.6f * expf(-0.3f * (float)l);
        k_lam<<<1, 64, 0, stream>>>(diff_lambda + l * 256, lam_init, LAM);
        for (int b = 0; b < NB; ++b) {
            float* Hb = H + (size_t)b * L * D;
            rms(Hb, D, U, D, attn_norm_w + l * D, L, 1, D, 1.f);
            gemm(false, U, D, w_in + (size_t)l * D * INC, INC, PROJ, INC, L, INC, D, nullptr, 0);
            k_dn_conv<<<2048, 256, 0, stream>>>(PROJ, dn_conv_w + l * 5 * 1536, QKVC);
            k_dn_l2<<<(L * 8 + 3) / 4, 256, 0, stream>>>(QKVC);
            k_dn_bg<<<(L * 8 + 255) / 256, 256, 0, stream>>>(PROJ, dn_a_log + l * 8, dn_dt_bias + l * 8, BETA, GG);
            k_dn_scan<<<8, 128, 0, stream>>>(QKVC, BETA, GG, ODN);
            k_dn_out<<<(L * 4 + 3) / 4, 256, 0, stream>>>(ODN, PROJ, dn_norm_w + l * 128, Y);
            rms(PROJ + C_DFQ, INC, DFQ, 512, diff_q_norm_w + l * 64, L, 8, 64, 1.f);
            rms(PROJ + C_DFK, INC, DFK, 512, diff_k_norm_w + l * 64, L, 8, 64, 1.f);
            for (int h = 0; h < 4; ++h) {
                gemm(true, DFQ + h * 128, 512, DFK + h * 128, 512, S0, L, L, L, 64, nullptr, 0);
                gemm(true, DFQ + h * 128 + 64, 512, DFK + h * 128 + 64, 512, S1, L, L, L, 64, nullptr, 0);
                k_diff_softmax<<<L, 256, 0, stream>>>(S0, S1, rel_table, h, LAM);
                gemm(false, S0, L, PROJ + C_DFV + h * 128, INC, ODF + h * 128, 512, L, 128, L, nullptr, 0);
            }
            rms(ODF, 512, Y + 512, DMIX, diff_subln_w + l * 128, L, 4, 128, 1.f - lam_init);
            rms(PROJ + C_MLQ, INC, CQN, 256, mla_q_lat_norm_w + l * 256, L, 1, 256, 1.f);
            rms(PROJ + C_MLKV, INC, CKVN, 128, mla_kv_lat_norm_w + l * 128, L, 1, 128, 1.f);
            gemm(false, CQN, 256, mla_w_uq + (size_t)l * 256 * 768, 768, MLQ, 768, L, 768, 256, nullptr, 0);
            gemm(false, CKVN, 128, mla_w_ukv + (size_t)l * 128 * 1024, 1024, MLKV, 1024, L, 1024, 128, nullptr, 0);
            k_mla_prep<<<(L * 8 + 3) / 4, 256, 0, stream>>>(MLQ, MLKV, PROJ, mla_q_norm_w + l * 192, mla_k_norm_w + l * 192, QF, KF);
            for (int h = 0; h < 4; ++h) {
                gemm(true, QF + h * 192, 768, KF + h * 192, 768, S0, L, L, L, 192, nullptr, 0);
                k_softmax<<<L, 256, 0, stream>>>(S0, 0.07216878364870322f);
                gemm(false, S0, L, MLKV + h * 256 + 128, 1024, Y + 1024 + h * 128, DMIX, L, 128, L, nullptr, 0);
            }
            gemm(false, Y, DMIX, w_out + (size_t)l * DMIX * D, D, Hb, D, L, D, DMIX, nullptr, 1);
            rms(Hb, D, U, D, ffn_norm_w + l * D, L, 1, D, 1.f);
            if (l == 0) {
                gemm(false, U, D, ffn_w_gate, DFF, FG, DFF, L, DFF, D, nullptr, 0);
                gemm(false, U, D, ffn_w_up, DFF, FU, DFF, L, DFF, D, nullptr, 0);
                k_swiglu_act<<<2048, 256, 0, stream>>>(FG, FU, DFF, DFF, L, nullptr);
                gemm(false, FG, DFF, ffn_w_down, D, Hb, D, L, D, DFF, nullptr, 1);
            } else {
                k_zero_int<<<1, 64, 0, stream>>>(CNT, 64);
                k_router<<<(L + 3) / 4, 256, 0, stream>>>(U, router_w, CNT, LIST, GATE);
                for (int e = 0; e < NE; ++e) {
                    k_gather<<<1024, 256, 0, stream>>>(U, LIST + e * L, CNT + e, XG);
                    gemm(false, XG, D, moe_w_gate + (size_t)e * D * DFE, DFE, FG, DFE, L, DFE, D, CNT + e, 0);
                    gemm(false, XG, D, moe_w_up + (size_t)e * D * DFE, DFE, FU, DFE, L, DFE, D, CNT + e, 0);
                    k_swiglu_act<<<2048, 256, 0, stream>>>(FG, FU, DFE, DFE, L, CNT + e);
                    gemm(false, FG, DFE, moe_w_down + (size_t)e * DFE * D, D, YE, D, L, D, DFE, CNT + e, 0);
                    k_scatter<<<1024, 256, 0, stream>>>(YE, LIST + e * L, CNT + e, YS);
                }
                k_moe_combine<<<2048, 256, 0, stream>>>(Hb, YS, GATE);
            }
        }
    }
    k_write_out<<<2048, 256, 0, stream>>>(H, out);
}
```

```cpp
#include <hip/hip_runtime.h>
#include <stdint.h>
#include <stdio.h>

#ifndef DEBUG_CHECK
#define DEBUG_CHECK 0
#endif
#if DEBUG_CHECK
#define NBF 1
#else
#define NBF 8
#endif

namespace nv {
constexpr int NB = 8, SEQ = 4096, NM = 16, L = 4112, D = 1024, INC = 4048, DMIX = 1536, DFF = 2816, NE = 8, DFE = 3584;
constexpr int C_DNQ = 0, C_DNK = 512, C_DNV = 1024, C_DNZ = 1536, C_DNB = 2048, C_DNA = 2056, C_DFQ = 2064, C_DFK = 2576, C_DFV = 3088,
              C_MLQ = 3600, C_MLKV = 3856, C_MLKR = 3984;
constexpr float EPS = 1e-6f;

__device__ __forceinline__ float siluf(float x) { return x / (1.f + expf(-x)); }
__device__ __forceinline__ float wave_sum(float v) {
#pragma unroll
    for (int o = 32; o > 0; o >>= 1) v += __shfl_xor(v, o);
    return v;
}
__device__ __forceinline__ float wave_max(float v) {
#pragma unroll
    for (int o = 32; o > 0; o >>= 1) v = fmaxf(v, __shfl_xor(v, o));
    return v;
}

template <bool TB>
__global__ void __launch_bounds__(256) k_gemm(const float* __restrict__ A, int lda, const float* __restrict__ B, int ldb, float* __restrict__ C, int ldc,
                                              int M, int N, int K, const int* Mdev, int accumulate) {
    if (Mdev) M = *Mdev;
    const int bm = blockIdx.y * 64, bn = blockIdx.x * 64;
    if (bm >= M) return;
    __shared__ float As[16][65], Bs[16][65];
    const int tx = threadIdx.x & 15, ty = threadIdx.x >> 4;
    float acc[4][4];
#pragma unroll
    for (int i = 0; i < 4; ++i)
#pragma unroll
        for (int j = 0; j < 4; ++j) acc[i][j] = 0.f;
    for (int k0 = 0; k0 < K; k0 += 16) {
#pragma unroll
        for (int i = 0; i < 4; ++i) {
            const int idx = threadIdx.x + i * 256;
            { const int r = idx >> 4, kk = idx & 15; As[kk][r] = (bm + r < M && k0 + kk < K) ? A[(size_t)(bm + r) * lda + k0 + kk] : 0.f; }
            if (TB) { const int n = idx >> 4, kk = idx & 15; Bs[kk][n] = (bn + n < N && k0 + kk < K) ? B[(size_t)(bn + n) * ldb + k0 + kk] : 0.f; }
            else    { const int kk = idx >> 6, n = idx & 63; Bs[kk][n] = (bn + n < N && k0 + kk < K) ? B[(size_t)(k0 + kk) * ldb + bn + n] : 0.f; }
        }
        __syncthreads();
#pragma unroll
        for (int kk = 0; kk < 16; ++kk) {
            float a[4], b[4];
#pragma unroll
            for (int i = 0; i < 4; ++i) { a[i] = As[kk][ty * 4 + i]; b[i] = Bs[kk][tx * 4 + i]; }
#pragma unroll
            for (int i = 0; i < 4; ++i)
#pragma unroll
                for (int j = 0; j < 4; ++j) acc[i][j] = fmaf(a[i], b[j], acc[i][j]);
        }
        __syncthreads();
    }
#pragma unroll
    for (int i = 0; i < 4; ++i)
#pragma unroll
        for (int j = 0; j < 4; ++j) {
            const int r = bm + ty * 4 + i, c = bn + tx * 4 + j;
            if (r < M && c < N) { float* p = C + (size_t)r * ldc + c; *p = accumulate ? (*p + acc[i][j]) : acc[i][j]; }
        }
}

__global__ void k_build_h(const float* __restrict__ x, const float* __restrict__ meta, float* __restrict__ H) {
    const size_t n = (size_t)NB * L * D;
    for (size_t i = (size_t)blockIdx.x * blockDim.x + threadIdx.x; i < n; i += (size_t)gridDim.x * blockDim.x) {
        const int d = (int)(i % D); const size_t r = i / D; const int t = (int)(r % L), b = (int)(r / L);
        H[i] = t < NM ? meta[t * D + d] : x[((size_t)b * SEQ + (t - NM)) * D + d];
    }
}
__global__ void k_write_out(const float* __restrict__ H, float* __restrict__ out) {
    const size_t n = (size_t)NB * SEQ * D;
    for (size_t i = (size_t)blockIdx.x * blockDim.x + threadIdx.x; i < n; i += (size_t)gridDim.x * blockDim.x) {
        const int d = (int)(i % D); const size_t r = i / D; const int s = (int)(r % SEQ), b = (int)(r / SEQ);
        out[i] = H[((size_t)b * L + NM + s) * D + d];
    }
}

__global__ void __launch_bounds__(256) k_rmsnorm(const float* __restrict__ in, int in_ld, float* __restrict__ out, int out_ld, const float* __restrict__ w,
                                                 int rows, int groups, int n, float scale) {
    const int wid = (blockIdx.x * blockDim.x + threadIdx.x) >> 6, lane = threadIdx.x & 63;
    if (wid >= rows * groups) return;
    const int r = wid / groups, g = wid % groups;
    const float* p = in + (size_t)r * in_ld + g * n; float* q = out + (size_t)r * out_ld + g * n;
    float ss = 0.f;
    for (int i = lane; i < n; i += 64) { const float v = p[i]; ss += v * v; }
    ss = wave_sum(ss);
    const float rs = rsqrtf(ss / (float)n + EPS) * scale;
    for (int i = lane; i < n; i += 64) q[i] = p[i] * rs * w[i];
}

__global__ void k_dn_conv(const float* __restrict__ proj, const float* __restrict__ cw, float* __restrict__ qkvc) {
    const int n = L * 1536;
    for (int i = blockIdx.x * blockDim.x + threadIdx.x; i < n; i += gridDim.x * blockDim.x) {
        const int c = i % 1536, t = i / 1536; float a = 0.f;
#pragma unroll
        for (int j = 0; j < 5; ++j) { const int tt = t + j - 2; if (tt >= 0 && tt < L) a += proj[(size_t)tt * INC + c] * cw[j * 1536 + c]; }
        qkvc[i] = siluf(a);
    }
}
__global__ void __launch_bounds__(256) k_dn_l2(float* __restrict__ qkvc) {
    const int wid = (blockIdx.x * blockDim.x + threadIdx.x) >> 6, lane = threadIdx.x & 63;
    if (wid >= L * 8) return;
    const int t = wid / 8, g = wid % 8;
    float* p = qkvc + (size_t)t * 1536 + g * 128;
    const float a = p[lane], b = p[lane + 64];
    const float ss = wave_sum(a * a + b * b);
    const float rs = rsqrtf(ss + EPS) * (g < 4 ? 0.08838834764831845f : 1.f);
    p[lane] = a * rs; p[lane + 64] = b * rs;
}
__global__ void k_dn_bg(const float* __restrict__ proj, const float* __restrict__ a_log, const float* __restrict__ dt_bias, float* __restrict__ beta, float* __restrict__ g) {
    const int n = L * 8;
    for (int i = blockIdx.x * blockDim.x + threadIdx.x; i < n; i += gridDim.x * blockDim.x) {
        const int j = i % 8, t = i / 8;
        const float bl = proj[(size_t)t * INC + C_DNB + j], al = proj[(size_t)t * INC + C_DNA + j] + dt_bias[j];
        beta[i] = 1.f / (1.f + expf(-bl));
        const float sp = al > 20.f ? al : log1pf(expf(al));
        g[i] = -expf(a_log[j]) * sp;
    }
}
__global__ void __launch_bounds__(128) k_dn_scan(const float* __restrict__ qkvc, const float* __restrict__ beta, const float* __restrict__ g, float* __restrict__ odn) {
    const int j = blockIdx.x, dir = j >> 2, h = j & 3, e = threadIdx.x;
    __shared__ float sq[16][128], sk[16][128];
    __shared__ float sb[16], sg[16];
    float S[128];
#pragma unroll
    for (int d = 0; d < 128; ++d) S[d] = 0.f;
    float* o = odn + (size_t)dir * L * 512;
    for (int i0 = 0; i0 < L; i0 += 16) {
        __syncthreads();
        float vv[16];
#pragma unroll
        for (int s = 0; s < 16; ++s) {
            const int i = i0 + s; const int t = (dir == 0 || i < NM) ? i : (L + NM - 1 - i);
            sq[s][e] = qkvc[(size_t)t * 1536 + h * 128 + e];
            sk[s][e] = qkvc[(size_t)t * 1536 + 512 + h * 128 + e];
            vv[s] = qkvc[(size_t)t * 1536 + 1024 + h * 128 + e];
            if (e == 0) { sb[s] = beta[t * 8 + j]; sg[s] = g[t * 8 + j]; }
        }
        __syncthreads();
#pragma unroll
        for (int s = 0; s < 16; ++s) {
            const int i = i0 + s; const int t = (dir == 0 || i < NM) ? i : (L + NM - 1 - i);
            const float al = expf(sg[s]), be = sb[s];
            float r = 0.f;
#pragma unroll
            for (int d = 0; d < 128; ++d) { S[d] *= al; r = fmaf(sk[s][d], S[d], r); }
            const float vn = be * (vv[s] - r);
            float oo = 0.f;
#pragma unroll
            for (int d = 0; d < 128; ++d) { S[d] = fmaf(sk[s][d], vn, S[d]); oo = fmaf(sq[s][d], S[d], oo); }
            o[(size_t)t * 512 + h * 128 + e] = oo;
        }
    }
}
__global__ void __launch_bounds__(256) k_dn_out(const float* __restrict__ odn, const float* __restrict__ proj, const float* __restrict__ w, float* __restrict__ y) {
    const int wid = (blockIdx.x * blockDim.x + threadIdx.x) >> 6, lane = threadIdx.x & 63;
    if (wid >= L * 4) return;
    const int t = wid / 4, h = wid % 4;
    const size_t o = (size_t)t * 512 + h * 128;
    const float a = odn[o + lane] + odn[(size_t)L * 512 + o + lane], b = odn[o + lane + 64] + odn[(size_t)L * 512 + o + lane + 64];
    const float ss = wave_sum(a * a + b * b);
    const float rs = rsqrtf(ss / 128.f + EPS);
    const float z0 = proj[(size_t)t * INC + C_DNZ + h * 128 + lane], z1 = proj[(size_t)t * INC + C_DNZ + h * 128 + lane + 64];
    y[(size_t)t * DMIX + h * 128 + lane] = a * rs * w[lane] * siluf(z0);
    y[(size_t)t * DMIX + h * 128 + lane + 64] = b * rs * w[lane + 64] * siluf(z1);
}

__device__ __forceinline__ int t5_bucket(int rel) {
    const int n = rel < 0 ? -rel : rel;
    int f;
    if (n < 8) f = n; else if (n < 12) f = 8; else if (n < 16) f = 9; else if (n < 23) f = 10; else if (n < 32) f = 11;
    else if (n < 46) f = 12; else if (n < 64) f = 13; else if (n < 91) f = 14; else f = 15;
    return (rel > 0 ? 16 : 0) + f;
}
__global__ void k_lam(const float* __restrict__ lp, float lam_init, float* __restrict__ lam) {
    const int lane = threadIdx.x;
    const float a = wave_sum(lp[lane] * lp[64 + lane]), b = wave_sum(lp[128 + lane] * lp[192 + lane]);
    if (lane == 0) *lam = expf(a) - expf(b) + lam_init;
}
__device__ __forceinline__ float block_max(float v, float* sm) {
    v = wave_max(v); const int w = threadIdx.x >> 6;
    __syncthreads(); if ((threadIdx.x & 63) == 0) sm[w] = v; __syncthreads();
    return fmaxf(fmaxf(sm[0], sm[1]), fmaxf(sm[2], sm[3]));
}
__device__ __forceinline__ float block_sum(float v, float* sm) {
    v = wave_sum(v); const int w = threadIdx.x >> 6;
    __syncthreads(); if ((threadIdx.x & 63) == 0) sm[w] = v; __syncthreads();
    return sm[0] + sm[1] + sm[2] + sm[3];
}
__global__ void __launch_bounds__(256) k_diff_softmax(float* __restrict__ S0, const float* __restrict__ S1, const float* __restrict__ table, int h, const float* __restrict__ lamp) {
    __shared__ float sm[4];
    const int i = blockIdx.x; const float lam = *lamp;
    float* r0 = S0 + (size_t)i * L; const float* r1 = S1 + (size_t)i * L;
    float m0 = -3e38f, m1 = -3e38f;
    for (int jx = threadIdx.x; jx < L; jx += 256) { const float bz = table[t5_bucket(jx - i) * 4 + h]; m0 = fmaxf(m0, r0[jx] * 0.125f + bz); m1 = fmaxf(m1, r1[jx] * 0.125f + bz); }
    m0 = block_max(m0, sm); m1 = block_max(m1, sm);
    float s0 = 0.f, s1 = 0.f;
    for (int jx = threadIdx.x; jx < L; jx += 256) { const float bz = table[t5_bucket(jx - i) * 4 + h]; s0 += expf(r0[jx] * 0.125f + bz - m0); s1 += expf(r1[jx] * 0.125f + bz - m1); }
    s0 = block_sum(s0, sm); s1 = block_sum(s1, sm);
    const float i0 = 1.f / s0, i1 = 1.f / s1;
    for (int jx = threadIdx.x; jx < L; jx += 256) { const float bz = table[t5_bucket(jx - i) * 4 + h];
        r0[jx] = expf(r0[jx] * 0.125f + bz - m0) * i0 - lam * expf(r1[jx] * 0.125f + bz - m1) * i1; }
}
__global__ void __launch_bounds__(256) k_softmax(float* __restrict__ S0, float scale) {
    __shared__ float sm[4];
    float* r0 = S0 + (size_t)blockIdx.x * L;
    float m0 = -3e38f;
    for (int jx = threadIdx.x; jx < L; jx += 256) m0 = fmaxf(m0, r0[jx] * scale);
    m0 = block_max(m0, sm);
    float s0 = 0.f;
    for (int jx = threadIdx.x; jx < L; jx += 256) s0 += expf(r0[jx] * scale - m0);
    s0 = block_sum(s0, sm);
    const float i0 = 1.f / s0;
    for (int jx = threadIdx.x; jx < L; jx += 256) r0[jx] = expf(r0[jx] * scale - m0) * i0;
}
__global__ void __launch_bounds__(256) k_mla_prep(const float* __restrict__ mlq, const float* __restrict__ mlkv, const float* __restrict__ proj,
                                                  const float* __restrict__ qw, const float* __restrict__ kw, float* __restrict__ qf, float* __restrict__ kf) {
    const int wid = (blockIdx.x * blockDim.x + threadIdx.x) >> 6, lane = threadIdx.x & 63;
    if (wid >= L * 8) return;
    const int t = wid / 8, h = (wid % 8) >> 1, which = wid & 1;
    float v[3];
    if (which == 0) { v[0] = mlq[(size_t)t * 768 + h * 192 + lane]; v[1] = mlq[(size_t)t * 768 + h * 192 + 64 + lane]; v[2] = mlq[(size_t)t * 768 + h * 192 + 128 + lane]; }
    else { v[0] = mlkv[(size_t)t * 1024 + h * 256 + lane]; v[1] = mlkv[(size_t)t * 1024 + h * 256 + 64 + lane]; v[2] = proj[(size_t)t * INC + C_MLKR + lane]; }
    const float ss = wave_sum(v[0] * v[0] + v[1] * v[1] + v[2] * v[2]);
    const float rs = rsqrtf(ss / 192.f + EPS);
    const float* w = which == 0 ? qw : kw;
#pragma unroll
    for (int c = 0; c < 3; ++c) v[c] = v[c] * rs * w[c * 64 + lane];
    const int i = lane & 31;
    const float inv = 1.0f / powf(10000.0f, (float)i / 32.0f);
    const float ang = (float)t * inv;
    const float cs = cosf(ang), sn = sinf(ang);
    const float other = __shfl_xor(v[2], 32);
    const float rv = lane < 32 ? (v[2] * cs - other * sn) : (other * sn + v[2] * cs);
    float* o = (which == 0 ? qf : kf) + (size_t)t * 768 + h * 192;
    o[lane] = v[0]; o[64 + lane] = v[1]; o[128 + lane] = rv;
}

__global__ void k_swiglu_act(float* __restrict__ G, const float* __restrict__ U, int ld, int cols, int rows, const int* rowsdev) {
    if (rowsdev) rows = *rowsdev;
    const size_t n = (size_t)rows * cols;
    for (size_t i = (size_t)blockIdx.x * blockDim.x + threadIdx.x; i < n; i += (size_t)gridDim.x * blockDim.x) {
        const size_t r = i / cols, c = i % cols; const size_t o = r * ld + c;
        G[o] = siluf(G[o]) * U[o];
    }
}
__global__ void k_zero_int(int* p, int n) { const int i = blockIdx.x * blockDim.x + threadIdx.x; if (i < n) p[i] = 0; }
__global__ void __launch_bounds__(256) k_router(const float* __restrict__ U, const float* __restrict__ rw, int* __restrict__ cnt, int* __restrict__ list, float* __restrict__ gate) {
    const int t = (blockIdx.x * blockDim.x + threadIdx.x) >> 6, lane = threadIdx.x & 63;
    if (t >= L) return;
    float lg[NE];
#pragma unroll
    for (int e = 0; e < NE; ++e) lg[e] = 0.f;
    for (int d = lane; d < D; d += 64) { const float u = U[(size_t)t * D + d];
#pragma unroll
        for (int e = 0; e < NE; ++e) lg[e] = fmaf(u, rw[d * NE + e], lg[e]); }
#pragma unroll
    for (int e = 0; e < NE; ++e) lg[e] = wave_sum(lg[e]);
    if (lane == 0) {
        int i0 = 0; float v0 = lg[0];
#pragma unroll
        for (int e = 1; e < NE; ++e) if (lg[e] > v0) { v0 = lg[e]; i0 = e; }
        int i1 = -1; float v1 = -3e38f;
#pragma unroll
        for (int e = 0; e < NE; ++e) if (e != i0 && lg[e] > v1) { v1 = lg[e]; i1 = e; }
        const float e1 = expf(v1 - v0), g0 = 1.f / (1.f + e1), g1 = e1 / (1.f + e1);
        gate[t * 2] = g0; gate[t * 2 + 1] = g1;
        const int p0 = atomicAdd(&cnt[i0], 1); list[i0 * L + p0] = t * 2;
        const int p1 = atomicAdd(&cnt[i1], 1); list[i1 * L + p1] = t * 2 + 1;
    }
}
__global__ void k_gather(const float* __restrict__ U, const int* __restrict__ list, const int* __restrict__ cnt, float* __restrict__ X) {
    const int n = *cnt;
    for (size_t i = (size_t)blockIdx.x * blockDim.x + threadIdx.x; i < (size_t)n * D; i += (size_t)gridDim.x * blockDim.x) {
        const int r = (int)(i / D), d = (int)(i % D); X[i] = U[(size_t)(list[r] >> 1) * D + d];
    }
}
__global__ void k_scatter(const float* __restrict__ Y, const int* __restrict__ list, const int* __restrict__ cnt, float* __restrict__ YS) {
    const int n = *cnt;
    for (size_t i = (size_t)blockIdx.x * blockDim.x + threadIdx.x; i < (size_t)n * D; i += (size_t)gridDim.x * blockDim.x) {
        const int r = (int)(i / D), d = (int)(i % D); YS[(size_t)list[r] * D + d] = Y[i];
    }
}
__global__ void k_moe_combine(float* __restrict__ H, const float* __restrict__ YS, const float* __restrict__ gate) {
    const size_t n = (size_t)L * D;
    for (size_t i = (size_t)blockIdx.x * blockDim.x + threadIdx.x; i < n; i += (size_t)gridDim.x * blockDim.x) {
        const size_t t = i / D, d = i % D;
        H[i] = H[i] + (gate[t * 2] * YS[(t * 2) * D + d] + gate[t * 2 + 1] * YS[(t * 2 + 1) * D + d]);
    }
}
}
namespace fx {
typedef unsigned short bf16_t;
typedef short bf16x8 __attribute__((ext_vector_type(8)));
typedef short s16x4 __attribute__((ext_vector_type(4)));
typedef float f32x4 __attribute__((ext_vector_type(4)));
typedef float f32x16 __attribute__((ext_vector_type(16)));
typedef unsigned u32x4 __attribute__((ext_vector_type(4)));
typedef unsigned u32x2 __attribute__((ext_vector_type(2)));
#define LAS __attribute__((address_space(3)))

constexpr int NB = NBF, SEQ = 4096, NM = 16, L = 4112, LP = 4160, PADF = 48, D = 1024, DMIX = 1536, DFF = 2816, NE = 8, DFE = 3584;
constexpr int MP = ((NB * LP + 255) / 256) * 256;
constexpr int NWG_THREADS = 512;
constexpr float EPS = 1e-6f;

#define XB_TMO      128
#define XB_XCNT(j)  (256  + 64 * (j))
#define XB_XSUB(j)  (1280 + 64 * (j))
#define XB_XGEN(j)  (2304 + 64 * (j))
#define XB_TOP      3328
#define XB_TOPGEN   3392
#define XCD_BAR_WORDS 3456
#define XB_SPIN_CAP (1u << 18)
__device__ __forceinline__ unsigned xb_ld(unsigned* p)              { return __hip_atomic_load(p, __ATOMIC_RELAXED, __HIP_MEMORY_SCOPE_AGENT); }
__device__ __forceinline__ unsigned xb_add(unsigned* p, unsigned v) { return __hip_atomic_fetch_add(p, v, __ATOMIC_RELAXED, __HIP_MEMORY_SCOPE_AGENT); }
__device__ __forceinline__ unsigned xb_xcc_id() { return (unsigned)__builtin_amdgcn_s_getreg((3 << 11) | 20) & 0xFu; }
#define XB_SPIN(cond, bar) do { unsigned _sp = 0; while (cond) { __builtin_amdgcn_s_sleep(1); \
    if ((++_sp & 255u) == 0u) { if (xb_ld(&(bar)[XB_TMO])) break; if (_sp > XB_SPIN_CAP) { atomicAdd(&(bar)[XB_TMO], 1u); break; } } } } while (0)
struct XcdBarrier { unsigned* bar; unsigned x; volatile LAS unsigned* st; };
__device__ __forceinline__ XcdBarrier xcd_barrier_post(unsigned* bar, volatile LAS unsigned* st) {
    XcdBarrier b; b.bar = bar; b.x = xb_xcc_id(); b.st = st;
    if (threadIdx.x == 0) (void)xb_add(&bar[XB_XCNT(b.x)], 1u);
    return b;
}
__device__ __forceinline__ void xcd_barrier_complete(unsigned* bar, unsigned x, unsigned& nloc, unsigned& nx) {
    const unsigned G = gridDim.x * gridDim.y * gridDim.z;
    unsigned sum, cnt, mine, sp = 0u;
    for (;;) {
        sum = 0u; cnt = 0u; mine = 0u;
#pragma unroll
        for (unsigned j = 0; j < 16; ++j) { const unsigned c = xb_ld(&bar[XB_XCNT(j)]); sum += c; cnt += (c > 0u) ? 1u : 0u; mine = (j == x) ? c : mine; }
        if (sum == G) break;
        __builtin_amdgcn_s_sleep(1);
        if ((++sp & 255u) == 0u) { if (xb_ld(&bar[XB_TMO])) break; if (sp > XB_SPIN_CAP) { atomicAdd(&bar[XB_TMO], 1u); break; } }
    }
    nloc = mine > 0u ? mine : 1u; nx = cnt > 0u ? cnt : 1u;
}
__device__ __forceinline__ void xcd_barrier(const XcdBarrier& b) {
    asm volatile("s_waitcnt vmcnt(0)" ::: "memory");
    __syncthreads();
    if (threadIdx.x == 0) {
        unsigned* bar = b.bar;
        __builtin_amdgcn_s_waitcnt(0);
        unsigned nloc = b.st[0], nx = b.st[1];
        if (nloc == 0u) { xcd_barrier_complete(bar, b.x, nloc, nx); b.st[0] = nloc; b.st[1] = nx; }
        const unsigned old = xb_add(&bar[XB_XSUB(b.x)], 1u);
        const unsigned gen = old / nloc;
        if (old + 1u == (gen + 1u) * nloc) {
            __builtin_amdgcn_fence(__ATOMIC_RELEASE, "agent");
            asm volatile("s_waitcnt vmcnt(0)" ::: "memory");
            const unsigned og = xb_add(&bar[XB_TOP], 1u);
            const unsigned tg = og / nx;
            if (og + 1u == (tg + 1u) * nx) xb_add(&bar[XB_TOPGEN], 1u);
            else XB_SPIN(xb_ld(&bar[XB_TOPGEN]) == tg, bar);
            __builtin_amdgcn_fence(__ATOMIC_ACQUIRE, "agent");
            xb_add(&bar[XB_XGEN(b.x)], 1u);
            asm volatile("s_waitcnt vmcnt(0)" ::: "memory");
        } else {
            XB_SPIN(xb_ld(&bar[XB_XGEN(b.x)]) == gen, bar);
            __builtin_amdgcn_fence(__ATOMIC_ACQUIRE, "agent");
            asm volatile("s_waitcnt vmcnt(0)" ::: "memory");
        }
    }
    __syncthreads();
}

__device__ __forceinline__ int lane_id() { return (int)__builtin_amdgcn_mbcnt_hi(~0u, __builtin_amdgcn_mbcnt_lo(~0u, 0u)); }
__device__ int g_dummy_never_used;
#define fresh_tid() (wave_idx_ * 64 + lane_id())
__device__ __forceinline__ unsigned cvt_pk_bf16(float lo, float hi) { unsigned r; asm volatile("v_cvt_pk_bf16_f32 %0, %1, %2" : "=v"(r) : "v"(lo), "v"(hi)); return r; }
__device__ __forceinline__ bf16_t f2bf(float f) { return (bf16_t)(cvt_pk_bf16(f, 0.f) & 0xFFFFu); }
__device__ __forceinline__ float bf2f(bf16_t b) { return __uint_as_float(((unsigned)b) << 16); }
__device__ __forceinline__ float bflo(unsigned u) { return __uint_as_float(u << 16); }
__device__ __forceinline__ float bfhi(unsigned u) { return __uint_as_float(u & 0xFFFF0000u); }
__device__ __forceinline__ float siluf(float x) { return x / (1.f + __expf(-x)); }
__device__ __forceinline__ float wave_sum(float v) {
#pragma unroll
    for (int o = 32; o > 0; o >>= 1) v += __shfl_xor(v, o);
    return v;
}
__device__ __forceinline__ float* hf_row(float* Hout, float* Hside, int row) {
    if (row >= NB * LP) return Hside + (size_t)(NB * 64 + (row - NB * LP)) * D;
    const int b = row / LP, lp = row - b * LP;
    return lp >= 64 ? Hout + ((size_t)b * SEQ + (lp - 64)) * D : Hside + (size_t)(b * 64 + lp) * D;
}
__device__ __forceinline__ bool row_valid(int row) {
    const int lp = row % LP; return row < NB * LP && lp >= PADF;
}

struct Bufs {
    unsigned* ctl;
    float* Hout;
    float* Hside;
    bf16_t* Ub;
    bf16_t* G1;
    bf16_t* G2;
    bf16_t* G3;
    bf16_t* G4;
    bf16_t* MLX;
    bf16_t* ODN;
    float* BG;
    bf16_t* ACT;
    bf16_t* WinT;
    bf16_t* WuT;
    bf16_t* WoutT;
    bf16_t* WguT;
    bf16_t* WdT;
    float* misc;
    bf16_t* W1T;
    bf16_t* W2T;
    bf16_t* ACTM;
    bf16_t* YS1;
    int* LST;
    float* GL;
};
struct Params {
    const float* in[28];
    float* out;
    Bufs b;
    int ph_lo, ph_hi, fused, pad;
};
typedef const __attribute__((address_space(4))) Params CParams;
__device__ __forceinline__ CParams* opaque_params() {
    CParams* q = (CParams*)__builtin_amdgcn_kernarg_segment_ptr();
    asm volatile("" : "+s"(q));
    return q;
}

namespace pg8 {
constexpr int BM = 256, BK = 64, HALF = 128, HTB = HALF * BK * 2, STAGE_BYTES = 8 * HTB, NXCD = 8, WGM = 8;
__host__ __device__ __forceinline__ int lds_byte(int r, int c) { const int st = (r >> 4) * 2 + (c >> 5), rr = r & 15, cc = c & 31, ob = rr * 64 + cc * 2; return st * 1024 + (ob ^ (((ob >> 9) & 1) << 5)); }
__host__ __device__ __forceinline__ void stage_rc(int b, int& R, int& C) { const int st = b / 1024, sb = b % 1024, swz = sb ^ (((sb >> 9) & 1) << 5); R = (st >> 1) * 16 + swz / 64; C = (st & 1) * 32 + (swz % 64) / 2; }
__host__ __device__ __forceinline__ int perm32(int rho) { const int n = rho >> 4, i = rho & 15; return 8 * (i >> 2) + 4 * n + (i & 3); }

struct Unit { int pm, pn; const char* A; const char* B; const int* rows; const float* gates; int valid, orow0; };

struct StaticOrder {
    int nM, nN, nwg, G, c; const char* A; const char* B; size_t tstepA, tstepB;
    __device__ void init(int nM_, int nN_, int G_, int c_, const void* A_, int lda, const void* B_, int K) {
        nM = nM_; nN = nN_; nwg = nM * nN; G = G_; c = c_; A = (const char*)A_; B = (const char*)B_; tstepA = (size_t)BM * lda * 2; tstepB = (size_t)BM * K * 2; }
    __device__ bool next(int i, Unit& u) const {
        const long Lx = (long)i * G + c; if (Lx >= nwg) return false;
        int wgid = (int)Lx; { const int q = nwg / NXCD, r = nwg % NXCD, xcd = wgid % NXCD, off = wgid / NXCD; wgid = (xcd < r ? xcd * (q + 1) : r * (q + 1) + (xcd - r) * q) + off; }
        const int nig = WGM * nN, gid = wgid / nig, fm = gid * WGM, gsz = (nM - fm) < WGM ? (nM - fm) : WGM;
        u.pm = fm + ((wgid % nig) % gsz); u.pn = (wgid % nig) / gsz; u.A = A + (size_t)u.pm * tstepA; u.B = B + (size_t)u.pn * tstepB; u.rows = nullptr; u.gates = nullptr; u.valid = BM; u.orow0 = u.pm * BM; return true;
    }
};

template <class Epi, class Sched, bool GATHER>
__device__ __forceinline__ void gemm_phase(LAS unsigned char* lds, const int lda, const int K, const Sched& S, const Epi& E, const int wave_idx_) {
    int tid_ = fresh_tid(); asm volatile("" : "+v"(tid_));
    const int tid = tid_, wid = __builtin_amdgcn_readfirstlane(tid >> 6), lane = tid & 63, wr = wid >> 2, wc = wid & 3, fr = lane & 15, fq = lane >> 4;
    const int nt = K / BK;
    unsigned voffB[2];
#pragma unroll
    for (int i = 0; i < 2; ++i) { int R, C; stage_rc(tid * 16 + i * 8192, R, C); const int Rb = Epi::PERM ? ((R & ~31) + perm32(R & 31)) : R;
        voffB[i] = (unsigned)(Rb * K + C) * 2u; }
    const size_t kstep = (size_t)(BK * 2);
    const size_t hstepB = (size_t)HALF * K * 2;
    const unsigned ldsw = (unsigned)wid * 1024u;
    const int aoff = lds_byte(wr * 64 + fr, fq * 8), boff = lds_byte(wc * 32 + fr, fq * 8);
#define PG8_SA(b, h) (((b) * 2 + (h)) * HTB)
#define PG8_SB(b, h) ((4 + (b) * 2 + (h)) * HTB)
#define PG8_STAGE(bufoff, gbase, voff) do { _Pragma("unroll") for (int _i = 0; _i < 2; ++_i) \
        __builtin_amdgcn_global_load_lds((const unsigned*)((const char*)(gbase) + (voff)[_i]), (LAS unsigned*)(lds + (bufoff) + ldsw + _i * 8192), 16, 0, 0); } while (0)
#define PG8_LDA(dst, b, h) do { _Pragma("unroll") for (int m = 0; m < 4; ++m) _Pragma("unroll") for (int k = 0; k < 2; ++k) dst[m][k] = *(const LAS bf16x8*)(lds + PG8_SA(b, h) + aoff + m * 2048 + k * 1024); } while (0)
#define PG8_LDB(dst, b, h) do { _Pragma("unroll") for (int n = 0; n < 2; ++n) _Pragma("unroll") for (int k = 0; k < 2; ++k) dst[n][k] = *(const LAS bf16x8*)(lds + PG8_SB(b, h) + boff + n * 2048 + k * 1024); } while (0)
#define PG8_MMA(ai, bj, At, Bt) do { __builtin_amdgcn_s_setprio(1); _Pragma("unroll") for (int m = 0; m < 4; ++m) _Pragma("unroll") for (int n = 0; n < 2; ++n) _Pragma("unroll") for (int k = 0; k < 2; ++k) \
        acc[ai][bj][m][n] = __builtin_amdgcn_mfma_f32_16x16x32_bf16(Bt[n][k], At[m][k], acc[ai][bj][m][n], 0, 0, 0); __builtin_amdgcn_s_setprio(0); } while (0)
#define PG8_WAIT_V(n) asm volatile("s_waitcnt vmcnt(" #n ")" ::: "memory")
#define PG8_WAIT_L(n) asm volatile("s_waitcnt lgkmcnt(" #n ")" ::: "memory")
#define PG8_BAR __builtin_amdgcn_s_barrier()
#define PG8_SCHED __builtin_amdgcn_sched_barrier(0)
#define PG8_SETOFF(u, o0, o1) do { int t2_ = tid; asm volatile("" : "+v"(t2_)); _Pragma("unroll") for (int _i = 0; _i < 2; ++_i) { int R_, C_; stage_rc(t2_ * 16 + _i * 8192, R_, C_); \
        if (GATHER) { const int r0_ = R_ < (u).valid ? ((u).rows[R_] >> 1) : 0, r1_ = R_ + HALF < (u).valid ? ((u).rows[R_ + HALF] >> 1) : 0; \
            o0[_i] = (unsigned)r0_ * (unsigned)(lda * 2) + (unsigned)C_ * 2u; o1[_i] = (unsigned)r1_ * (unsigned)(lda * 2) + (unsigned)C_ * 2u; } \
        else { o0[_i] = (unsigned)(R_ * lda + C_) * 2u; o1[_i] = o0[_i] + (unsigned)(HALF * lda * 2); } } } while (0)
    Unit cur, nxt; int ui = 0;
    if (!S.next(0, cur)) return;
    f32x4 acc[2][2][4][2];
#pragma unroll
    for (int a = 0; a < 2; ++a)
#pragma unroll
        for (int b = 0; b < 2; ++b)
#pragma unroll
            for (int m = 0; m < 4; ++m)
#pragma unroll
                for (int n = 0; n < 2; ++n) acc[a][b][m][n] = (f32x4){0.f, 0.f, 0.f, 0.f};
    bf16x8 At[4][2], B0[2][2], B1[2][2];
    unsigned vA0[2], vA1[2];
    LAS unsigned* rowbuf = (LAS unsigned*)(lds + STAGE_BYTES + 1024);
    PG8_SETOFF(cur, vA0, vA1);
    const char* cA = cur.A; const char* cB = cur.B;
    PG8_STAGE(PG8_SB(0, 0), cB, voffB); PG8_STAGE(PG8_SA(0, 0), cA, vA0); PG8_STAGE(PG8_SB(0, 1), cB + hstepB, voffB); PG8_STAGE(PG8_SA(0, 1), cA, vA1);
    if (wr == 1) PG8_BAR;
    PG8_WAIT_V(4); PG8_BAR;
    PG8_STAGE(PG8_SB(1, 0), cB + kstep, voffB); PG8_STAGE(PG8_SA(1, 0), cA + kstep, vA0); PG8_STAGE(PG8_SB(1, 1), cB + hstepB + kstep, voffB);
    PG8_WAIT_V(6); PG8_BAR;
    for (;;) {
        const bool has_next = S.next(ui + 1, nxt);
        if (GATHER && has_next) { int t3_ = tid; asm volatile("" : "+v"(t3_)); if (t3_ < BM) rowbuf[t3_] = (unsigned)(t3_ < nxt.valid ? (nxt.rows[t3_] >> 1) : 0) * (unsigned)(lda * 2); }
        const char* nA = has_next ? nxt.A : cA; const char* nB = has_next ? nxt.B : cB;
        for (int t = 0; t < nt; t += 2) {
            const bool last = (t == nt - 2);
            const char* a1 = cA + (size_t)(t + 1) * kstep;
            const char* a2 = last ? nA : cA + (size_t)(t + 2) * kstep; const char* b2 = last ? nB : cB + (size_t)(t + 2) * kstep;
            const char* a3 = a2 + kstep; const char* b3 = b2 + kstep;
            PG8_LDB(B0, 0, 0); PG8_SCHED; PG8_LDA(At, 0, 0); PG8_STAGE(PG8_SA(1, 1), a1, vA1);
            PG8_WAIT_L(8); PG8_BAR; PG8_WAIT_L(0); PG8_MMA(0, 0, At, B0); PG8_BAR; PG8_SCHED;
            if (GATHER && last && has_next) {
                int t4_ = tid; asm volatile("" : "+v"(t4_));
                _Pragma("unroll") for (int _i = 0; _i < 2; ++_i) { int R_, C_; stage_rc(t4_ * 16 + _i * 8192, R_, C_); vA0[_i] = rowbuf[R_] + (unsigned)C_ * 2u; vA1[_i] = rowbuf[R_ + HALF] + (unsigned)C_ * 2u; }
            }
            PG8_LDB(B1, 0, 1); PG8_STAGE(PG8_SB(0, 0), b2, voffB);
            PG8_BAR; PG8_WAIT_L(0); PG8_MMA(0, 1, At, B1); PG8_BAR;
            PG8_LDA(At, 0, 1); PG8_STAGE(PG8_SA(0, 0), a2, vA0);
            PG8_BAR; PG8_WAIT_L(0); PG8_MMA(1, 0, At, B0); PG8_BAR; PG8_SCHED;
            PG8_STAGE(PG8_SB(0, 1), b2 + hstepB, voffB);
            PG8_WAIT_V(6); PG8_BAR; PG8_MMA(1, 1, At, B1); PG8_BAR;
            PG8_LDB(B0, 1, 0); PG8_SCHED; PG8_LDA(At, 1, 0); PG8_STAGE(PG8_SA(0, 1), a2, vA1);
            PG8_WAIT_L(8); PG8_BAR; PG8_WAIT_L(0); PG8_MMA(0, 0, At, B0); PG8_BAR; PG8_SCHED;
            PG8_LDB(B1, 1, 1); PG8_STAGE(PG8_SB(1, 0), b3, voffB);
            PG8_BAR; PG8_WAIT_L(0); PG8_MMA(0, 1, At, B1); PG8_BAR;
            PG8_LDA(At, 1, 1); PG8_STAGE(PG8_SA(1, 0), a3, vA0);
            PG8_BAR; PG8_WAIT_L(0); PG8_MMA(1, 0, At, B0); PG8_BAR; PG8_SCHED;
            PG8_STAGE(PG8_SB(1, 1), b3 + hstepB, voffB);
            PG8_WAIT_V(6); PG8_BAR; PG8_MMA(1, 1, At, B1); PG8_BAR;
        }
        E(acc, cur, wr, wc, fr, fq);
        if (!has_next) break;
#pragma unroll
        for (int a = 0; a < 2; ++a)
#pragma unroll
            for (int b = 0; b < 2; ++b)
#pragma unroll
                for (int m = 0; m < 4; ++m)
#pragma unroll
                    for (int n = 0; n < 2; ++n) acc[a][b][m][n] = (f32x4){0.f, 0.f, 0.f, 0.f};
        cur = nxt; cA = nA; cB = nB; ++ui;
    }
    PG8_WAIT_V(0);
    if (wr == 0) PG8_BAR;
    PG8_BAR;
#undef PG8_SA
#undef PG8_SB
#undef PG8_STAGE
#undef PG8_LDA
#undef PG8_LDB
#undef PG8_MMA
#undef PG8_WAIT_V
#undef PG8_WAIT_L
#undef PG8_BAR
#undef PG8_SCHED
#undef PG8_SETOFF
}

struct EpiBf16 {
    static constexpr bool PERM = true;
    bf16_t* O; int ldc;
    bf16_t* R[4]; int rld[4]; int rt0[5];
    int route;
    __device__ __forceinline__ void operator()(const f32x4 (&acc)[2][2][4][2], const Unit& u, int wr, int wc, int fr, int fq) const {
        const int row0 = u.pm * BM + wr * 64 + fr; bf16_t* base = O + (size_t)u.pn * BM; int ld = ldc;
        if (route) {
#pragma unroll
            for (int k = 0; k < 4; ++k) if (u.pn >= rt0[k] && u.pn < rt0[k + 1]) { base = R[k] + (size_t)(u.pn - rt0[k]) * BM; ld = rld[k]; }
        }
        const int col0 = wc * 32 + 8 * fq;
#pragma unroll
        for (int ai = 0; ai < 2; ++ai)
#pragma unroll
            for (int m = 0; m < 4; ++m) { bf16_t* rowp = base + (size_t)(row0 + ai * HALF + m * 16) * ld + col0;
#pragma unroll
                for (int bj = 0; bj < 2; ++bj) { const f32x4 v0 = acc[ai][bj][m][0], v1 = acc[ai][bj][m][1];
                    u32x4 w = {cvt_pk_bf16(v0[0], v0[1]), cvt_pk_bf16(v0[2], v0[3]), cvt_pk_bf16(v1[0], v1[1]), cvt_pk_bf16(v1[2], v1[3])};
                    *(u32x4*)(rowp + bj * HALF) = w; } }
    }
};
struct EpiResid {
    static constexpr bool PERM = false;
    float* Hout; float* Hside;
    __device__ __forceinline__ void operator()(const f32x4 (&acc)[2][2][4][2], const Unit& u, int wr, int wc, int fr, int fq) const {
        const int row0 = u.pm * BM + wr * 64 + fr, col0 = u.pn * BM + wc * 32 + 4 * fq;
#pragma unroll
        for (int ai = 0; ai < 2; ++ai)
#pragma unroll
            for (int m = 0; m < 4; ++m) { const int row = row0 + ai * HALF + m * 16; if (!row_valid(row)) continue;
                float* rowp = hf_row(Hout, Hside, row) + col0;
#pragma unroll
                for (int bj = 0; bj < 2; ++bj)
#pragma unroll
                    for (int n = 0; n < 2; ++n) { f32x4* p = (f32x4*)(rowp + bj * HALF + n * 16); *p = *p + acc[ai][bj][m][n]; } }
    }
};
struct EpiSwiglu {
    static constexpr bool PERM = true;
    bf16_t* O; int ldc;
    __device__ __forceinline__ void operator()(const f32x4 (&acc)[2][2][4][2], const Unit& u, int wr, int wc, int fr, int fq) const {
        const int row0 = u.orow0 + wr * 64 + fr, col0 = u.pn * HALF + wc * 32 + 8 * fq;
#pragma unroll
        for (int ai = 0; ai < 2; ++ai)
#pragma unroll
            for (int m = 0; m < 4; ++m) { bf16_t* rowp = O + (size_t)(row0 + ai * HALF + m * 16) * ldc + col0;
                float r[8];
#pragma unroll
                for (int n = 0; n < 2; ++n)
#pragma unroll
                    for (int j = 0; j < 4; ++j) r[n * 4 + j] = siluf(acc[ai][0][m][n][j]) * acc[ai][1][m][n][j];
                u32x4 w = {cvt_pk_bf16(r[0], r[1]), cvt_pk_bf16(r[2], r[3]), cvt_pk_bf16(r[4], r[5]), cvt_pk_bf16(r[6], r[7])};
                *(u32x4*)rowp = w; }
    }
};

struct MoeSched {
    int G, c, nN, cap, gather; const unsigned* cntw; const char* A; const char* B; size_t tstepA, tstepB, estepB; const int* lst; const float* gl;
    __device__ void init(const unsigned* cntw_, int nN_, int G_, int c_, const void* A_, int lda, const void* B_, int K, size_t estep_elems, const int* lst_, const float* gl_, int cap_, int gather_) {
        cntw = cntw_; nN = nN_; G = G_; c = c_; A = (const char*)A_; B = (const char*)B_; tstepA = (size_t)BM * lda * 2; tstepB = (size_t)BM * K * 2; estepB = estep_elems * 2; lst = lst_; gl = gl_; cap = cap_; gather = gather_;
    }
    __device__ bool next(int i, Unit& u) const {
        const int c0 = (int)cntw[0], c1 = (int)cntw[64], c2 = (int)cntw[128], c3 = (int)cntw[192], c4 = (int)cntw[256], c5 = (int)cntw[320], c6 = (int)cntw[384], c7 = (int)cntw[448];
        const int t1 = (c0 + 255) >> 8, t2 = t1 + ((c1 + 255) >> 8), t3 = t2 + ((c2 + 255) >> 8), t4 = t3 + ((c3 + 255) >> 8), t5 = t4 + ((c4 + 255) >> 8), t6 = t5 + ((c5 + 255) >> 8), t7 = t6 + ((c6 + 255) >> 8), nM = t7 + ((c7 + 255) >> 8);
        const int nwg = nM * nN; const long Lx = (long)i * G + c; if (Lx >= nwg) return false;
        int wgid = (int)Lx; { const int q = nwg / NXCD, r = nwg % NXCD, xcd = wgid % NXCD, off = wgid / NXCD; wgid = (xcd < r ? xcd * (q + 1) : r * (q + 1) + (xcd - r) * q) + off; }
        const int nig = WGM * nN, gid = wgid / nig, fm = gid * WGM, gsz = (nM - fm) < WGM ? (nM - fm) : WGM;
        const int pm = fm + ((wgid % nig) % gsz), pn = (wgid % nig) / gsz;
        const int e = (pm >= t1) + (pm >= t2) + (pm >= t3) + (pm >= t4) + (pm >= t5) + (pm >= t6) + (pm >= t7);
        const int tb = e == 0 ? 0 : e == 1 ? t1 : e == 2 ? t2 : e == 3 ? t3 : e == 4 ? t4 : e == 5 ? t5 : e == 6 ? t6 : t7;
        const int ce = e == 0 ? c0 : e == 1 ? c1 : e == 2 ? c2 : e == 3 ? c3 : e == 4 ? c4 : e == 5 ? c5 : e == 6 ? c6 : c7;
        const int m = pm - tb, rem = ce - m * BM;
        u.pm = pm; u.pn = pn; u.valid = rem < BM ? rem : BM; u.orow0 = pm * BM;
        u.rows = lst + (size_t)e * cap + m * BM; u.gates = gl + (size_t)e * cap + m * BM;
        u.A = gather ? A : A + (size_t)pm * tstepA; u.B = B + (size_t)e * estepB + (size_t)pn * tstepB;
        return true;
    }
};
struct EpiMoeDown {
    static constexpr bool PERM = false;
    float* Hout; float* Hside; bf16_t* YS1; int b0;
    __device__ __forceinline__ void operator()(const f32x4 (&acc)[2][2][4][2], const Unit& u, int wr, int wc, int fr, int fq) const {
        const int col0 = u.pn * BM + wc * 32 + 4 * fq;
#pragma unroll
        for (int ai = 0; ai < 2; ++ai)
#pragma unroll
            for (int m = 0; m < 4; ++m) { const int rl = ai * HALF + wr * 64 + m * 16 + fr; if (rl >= u.valid) continue;
                const int entry = u.rows[rl]; const float g = u.gates[rl]; const int row = entry >> 1;
                if ((entry & 1) == 0) { float* rowp = hf_row(Hout, Hside, row) + col0;
#pragma unroll
                    for (int bj = 0; bj < 2; ++bj)
#pragma unroll
                        for (int n = 0; n < 2; ++n) { f32x4* p = (f32x4*)(rowp + bj * HALF + n * 16); *p = *p + acc[ai][bj][m][n] * g; }
                } else { const int b = row / LP, lp = row - b * LP; bf16_t* rowp = YS1 + ((size_t)(b - b0) * L + (lp - PADF)) * D + col0;
#pragma unroll
                    for (int bj = 0; bj < 2; ++bj)
#pragma unroll
                        for (int n = 0; n < 2; ++n) { const f32x4 v = acc[ai][bj][m][n] * g; *(u32x2*)(rowp + bj * HALF + n * 16) = (u32x2){cvt_pk_bf16(v[0], v[1]), cvt_pk_bf16(v[2], v[3])}; }
                } }
    }
};
}

__device__ __forceinline__ int inproj_src_col(int n) {
    if (n < 2048) return n;
    if (n < 3584) return 2064 + (n - 2048);
    if (n < 3840) return 3600 + (n - 3584);
    if (n < 3968) return 3856 + (n - 3840);
    if (n < 4032) return 3984 + (n - 3968);
    if (n < 4048) return 2048 + (n - 4032);
    return -1;
}
__device__ __forceinline__ void xpose_convert(const int MODE, LAS unsigned char* lds, const float* __restrict__ src, int ldsrc, int K, int N, bf16_t* __restrict__ dst, int lddst, int wg, int nwg, const int wave_idx_) {
    LAS bf16_t* tile = (LAS bf16_t*)lds;
    int tid_ = fresh_tid(); asm volatile("" : "+v"(tid_));
    const int tid = tid_, ntn = (N + 63) / 64, ntk = K / 64, ntiles = ntn * ntk;
    for (int t = wg; t < ntiles; t += nwg) {
        const int tn = t % ntn, tk = t / ntn, n0 = tn * 64, k0 = tk * 64;
        {
            const int kk = tid >> 3, nn = (tid & 7) * 8;
            const int n = n0 + nn;
            int sc = n; if (MODE == 1) sc = inproj_src_col(n);
            float v[8];
            if (sc >= 0 && n < N) { const f32x4 a = *(const f32x4*)(src + (size_t)(k0 + kk) * ldsrc + sc), b = *(const f32x4*)(src + (size_t)(k0 + kk) * ldsrc + sc + 4);
                v[0] = a[0]; v[1] = a[1]; v[2] = a[2]; v[3] = a[3]; v[4] = b[0]; v[5] = b[1]; v[6] = b[2]; v[7] = b[3]; }
            else {
#pragma unroll
                for (int j = 0; j < 8; ++j) v[j] = 0.f; }
#pragma unroll
            for (int j = 0; j < 8; ++j) tile[(nn + j) * 72 + kk] = f2bf(v[j]);
        }
        __syncthreads();
        {
            const int nn = tid >> 3, kc = (tid & 7) * 8; const int n = n0 + nn;
            if (n < N || MODE == 1) {
                int dr = n; if (MODE == 2) dr = (n >> 7) * 256 + (n & 127); if (MODE == 3) dr = (n >> 7) * 256 + 128 + (n & 127);
                const u32x4 w = *(const LAS u32x4*)(tile + nn * 72 + kc);
                *(u32x4*)(dst + (size_t)dr * lddst + k0 + kc) = w;
            }
        }
        __syncthreads();
    }
}

__device__ __forceinline__ void norm_rows(float* Hout, float* Hside, const float* __restrict__ w, bf16_t* __restrict__ Ub, int wg, int nwg, const int wave_idx_) {
    int tid_ = fresh_tid(); asm volatile("" : "+v"(tid_));
    const int lane = tid_ & 63, wv = tid_ >> 6;
    for (int row = wg * 8 + wv; row < MP; row += nwg * 8) {
        const float* p = hf_row(Hout, Hside, row); f32x4 v[4]; float ss = 0.f;
#pragma unroll
        for (int j = 0; j < 4; ++j) { v[j] = *(const f32x4*)(p + j * 256 + lane * 4); ss += v[j][0] * v[j][0] + v[j][1] * v[j][1] + v[j][2] * v[j][2] + v[j][3] * v[j][3]; }
        ss = wave_sum(ss);
        const float rs = rsqrtf(ss * (1.f / D) + EPS);
#pragma unroll
        for (int j = 0; j < 4; ++j) { const f32x4 g = *(const f32x4*)(w + j * 256 + lane * 4);
            u32x2 o = {cvt_pk_bf16(v[j][0] * rs * g[0], v[j][1] * rs * g[1]), cvt_pk_bf16(v[j][2] * rs * g[2], v[j][3] * rs * g[3])};
            *(u32x2*)(Ub + (size_t)row * D + j * 256 + lane * 4) = o; }
    }
}
__device__ __forceinline__ void build_rows(const float* __restrict__ x, const float* __restrict__ meta, const float* __restrict__ w, float* Hout, float* Hside, bf16_t* __restrict__ Ub, int wg, int nwg, const int wave_idx_) {
    int tid_ = fresh_tid(); asm volatile("" : "+v"(tid_));
    const int lane = tid_ & 63, wv = tid_ >> 6;
    for (int row = wg * 8 + wv; row < MP; row += nwg * 8) {
        const int b = row / LP, lp = row % LP;
        const float* p = nullptr;
        if (row < NB * LP && lp >= PADF) p = lp < PADF + NM ? meta + (size_t)(lp - PADF) * D : x + ((size_t)b * SEQ + (lp - PADF - NM)) * D;
        f32x4 v[4]; float ss = 0.f;
#pragma unroll
        for (int j = 0; j < 4; ++j) { v[j] = p ? *(const f32x4*)(p + j * 256 + lane * 4) : (f32x4){0.f, 0.f, 0.f, 0.f}; ss += v[j][0] * v[j][0] + v[j][1] * v[j][1] + v[j][2] * v[j][2] + v[j][3] * v[j][3]; }
        ss = wave_sum(ss);
        const float rs = rsqrtf(ss * (1.f / D) + EPS);
#pragma unroll
        for (int j = 0; j < 4; ++j) { const f32x4 g = *(const f32x4*)(w + j * 256 + lane * 4);
            *(f32x4*)(hf_row(Hout, Hside, row) + j * 256 + lane * 4) = v[j];
            u32x2 o = {cvt_pk_bf16(v[j][0] * rs * g[0], v[j][1] * rs * g[1]), cvt_pk_bf16(v[j][2] * rs * g[2], v[j][3] * rs * g[3])};
            *(u32x2*)(Ub + (size_t)row * D + j * 256 + lane * 4) = o; }
    }
}
constexpr float LOG2E = 1.4426950408889634f;
constexpr float DIFF_QSCALE = 0.125f * LOG2E;
constexpr float MLA_QSCALE = 0.07216878364870322f * LOG2E;

__device__ __forceinline__ void unpack8(const u32x4 w, float (&v)[8]) {
    v[0] = bflo(w[0]); v[1] = bfhi(w[0]); v[2] = bflo(w[1]); v[3] = bfhi(w[1]); v[4] = bflo(w[2]); v[5] = bfhi(w[2]); v[6] = bflo(w[3]); v[7] = bfhi(w[3]);
}
__device__ __forceinline__ u32x4 pack8(const float (&v)[8]) { return (u32x4){cvt_pk_bf16(v[0], v[1]), cvt_pk_bf16(v[2], v[3]), cvt_pk_bf16(v[4], v[5]), cvt_pk_bf16(v[6], v[7])}; }

__device__ __forceinline__ void prep_rows(CParams& p, int l, int wg, int nwg, const int wave_idx_) {
    auto& B = p.b;
    int tid_ = fresh_tid(); asm volatile("" : "+v"(tid_));
    const int lane = tid_ & 63, wv = tid_ >> 6;
    const float* qw = p.in[9] + l * 64; const float* kw = p.in[10] + l * 64;
    const float* cqw = p.in[13] + l * 256; const float* ckvw = p.in[15] + l * 128;
    const float* a_log = p.in[6] + l * 8; const float* dt_bias = p.in[7] + l * 8;
    float gq[8], gk[8];
#pragma unroll
    for (int j = 0; j < 8; ++j) { gq[j] = qw[(lane & 7) * 8 + j] * DIFF_QSCALE; gk[j] = kw[(lane & 7) * 8 + j]; }
    float gcq[4], gckv[2];
#pragma unroll
    for (int j = 0; j < 4; ++j) gcq[j] = cqw[lane * 4 + j];
    gckv[0] = ckvw[lane * 2]; gckv[1] = ckvw[lane * 2 + 1];
    for (int row = wg * 8 + wv; row < MP; row += nwg * 8) {
        bf16_t* g3 = B.G3 + (size_t)row * 1536;
        {
            float v[8];
            u32x4 w = *(const u32x4*)(g3 + lane * 8); unpack8(w, v);
            float ss = 0.f;
#pragma unroll
            for (int j = 0; j < 8; ++j) ss += v[j] * v[j];
            ss += __shfl_xor(ss, 1); ss += __shfl_xor(ss, 2); ss += __shfl_xor(ss, 4);
            float rs = rsqrtf(ss * (1.f / 64.f) + EPS);
#pragma unroll
            for (int j = 0; j < 8; ++j) v[j] = v[j] * rs * gq[j];
            *(u32x4*)(g3 + lane * 8) = pack8(v);
            w = *(const u32x4*)(g3 + 512 + lane * 8); unpack8(w, v);
            ss = 0.f;
#pragma unroll
            for (int j = 0; j < 8; ++j) ss += v[j] * v[j];
            ss += __shfl_xor(ss, 1); ss += __shfl_xor(ss, 2); ss += __shfl_xor(ss, 4);
            rs = rsqrtf(ss * (1.f / 64.f) + EPS);
#pragma unroll
            for (int j = 0; j < 8; ++j) v[j] = v[j] * rs * gk[j];
            *(u32x4*)(g3 + 512 + lane * 8) = pack8(v);
        }
        bf16_t* g4 = B.G4 + (size_t)row * 512;
        {
            const u32x2 w = *(const u32x2*)(g4 + lane * 4);
            float a0 = bflo(w[0]), a1 = bfhi(w[0]), a2 = bflo(w[1]), a3 = bfhi(w[1]);
            float ss = wave_sum(a0 * a0 + a1 * a1 + a2 * a2 + a3 * a3);
            float rs = rsqrtf(ss * (1.f / 256.f) + EPS);
            *(u32x2*)(g4 + lane * 4) = (u32x2){cvt_pk_bf16(a0 * rs * gcq[0], a1 * rs * gcq[1]), cvt_pk_bf16(a2 * rs * gcq[2], a3 * rs * gcq[3])};
            const unsigned w2 = *(const unsigned*)(g4 + 256 + lane * 2);
            a0 = bflo(w2); a1 = bfhi(w2);
            ss = wave_sum(a0 * a0 + a1 * a1);
            rs = rsqrtf(ss * (1.f / 128.f) + EPS);
            *(unsigned*)(g4 + 256 + lane * 2) = cvt_pk_bf16(a0 * rs * gckv[0], a1 * rs * gckv[1]);
        }
        if (lane < 8) {
            const float bl = bf2f(g4[448 + lane]), al = bf2f(g4[456 + lane]) + dt_bias[lane];
            const float sp = al > 20.f ? al : __logf(1.f + __expf(al));
            B.BG[(size_t)row * 16 + lane] = 1.f / (1.f + __expf(-bl));
            B.BG[(size_t)row * 16 + 8 + lane] = -__expf(a_log[lane]) * sp;
        }
    }
}

__device__ __forceinline__ void build_wu(CParams& p, int wg, int nwg, const int wave_idx_) {
    const size_t n = (size_t)2 * 2048 * 384;
    int tid_ = fresh_tid(); asm volatile("" : "+v"(tid_));
    for (size_t i = (size_t)wg * NWG_THREADS + tid_; i < n; i += (size_t)nwg * NWG_THREADS) {
        const int k = (int)(i % 384); const int nn = (int)((i / 384) % 2048); const int l = (int)(i / (384 * 2048));
        float v = 0.f;
        if (nn < 1024) { const int h = nn >> 8, j = nn & 255; if (j < 192 && k < 256) v = p.in[14][((size_t)l * 256 + k) * 768 + h * 192 + j]; }
        else { const int h = (nn - 1024) >> 8, j = nn & 255; if (k >= 256) v = p.in[16][((size_t)l * 128 + (k - 256)) * 1024 + h * 256 + j]; }
        p.b.WuT[i] = f2bf(v);
    }
}

__device__ __forceinline__ void mla_finalize(CParams& p, int l, int wg, int nwg, const int wave_idx_) {
    auto& B = p.b;
    int tid_ = fresh_tid(); asm volatile("" : "+v"(tid_));
    const int lane = tid_ & 63, wv = tid_ >> 6;
    const float* qw = p.in[17] + l * 192; const float* kw = p.in[18] + l * 192;
    float gq[4] = {0.f, 0.f, 0.f, 0.f}, gk[4] = {0.f, 0.f, 0.f, 0.f};
    if (lane < 48) {
#pragma unroll
        for (int j = 0; j < 4; ++j) { gq[j] = qw[lane * 4 + j] * MLA_QSCALE; gk[j] = kw[lane * 4 + j]; }
    }
    const int ibase = (lane >= 40 ? lane - 40 : lane - 32) * 4;
    float invf[4];
#pragma unroll
    for (int j = 0; j < 4; ++j) invf[j] = __builtin_amdgcn_exp2f(-(float)(ibase + j) * (13.287712379549449f / 32.0f)) * 0.15915494309189535f;
    for (int row = wg * 8 + wv; row < MP; row += nwg * 8) {
        const int lp = row % LP; const float pos = (float)(lp - PADF);
        float cs[4], sn[4];
        if (lane >= 32 && lane < 48) {
#pragma unroll
            for (int j = 0; j < 4; ++j) { const float th = pos * invf[j], k = rintf(th), fr = fmaf(pos, invf[j], -k);
                cs[j] = __builtin_amdgcn_cosf(fr); sn[j] = __builtin_amdgcn_sinf(fr); }
        } else {
#pragma unroll
            for (int j = 0; j < 4; ++j) { cs[j] = 1.f; sn[j] = 0.f; }
        }
        bf16_t* mx = B.MLX + (size_t)row * 2048;
        const bf16_t* g4 = B.G4 + (size_t)row * 512;
#pragma unroll
        for (int h = 0; h < 4; ++h) {
#pragma unroll
            for (int which = 0; which < 2; ++which) {
                float v[4] = {0.f, 0.f, 0.f, 0.f};
                if (lane < 48) {
                    const bf16_t* src = which == 0 ? mx + 256 * h + lane * 4 : (lane < 32 ? mx + 1024 + 256 * h + lane * 4 : g4 + 384 + (lane - 32) * 4);
                    const u32x2 w = *(const u32x2*)src;
                    v[0] = bflo(w[0]); v[1] = bfhi(w[0]); v[2] = bflo(w[1]); v[3] = bfhi(w[1]);
                }
                const float ss = wave_sum(v[0] * v[0] + v[1] * v[1] + v[2] * v[2] + v[3] * v[3]);
                const float rs = rsqrtf(ss * (1.f / 192.f) + EPS);
#pragma unroll
                for (int j = 0; j < 4; ++j) v[j] = v[j] * rs * (which == 0 ? gq[j] : gk[j]);
                float o[4];
#pragma unroll
                for (int j = 0; j < 4; ++j) { const float other = __shfl_xor(v[j], 8);
                    o[j] = lane < 32 ? v[j] : (lane < 40 ? v[j] * cs[j] - other * sn[j] : other * sn[j] + v[j] * cs[j]); }
                if (lane < 48) {
                    bf16_t* dst = which == 0 ? mx + 256 * h + lane * 4 : (lane < 32 ? mx + 1024 + 256 * h + lane * 4 : mx + 256 * h + 192 + (lane - 32) * 4);
                    *(u32x2*)dst = (u32x2){cvt_pk_bf16(o[0], o[1]), cvt_pk_bf16(o[2], o[3])};
                }
            }
        }
    }
}

__device__ __forceinline__ void post_mixer(CParams& p, int l, int wg, int nwg, const int wave_idx_) {
    auto& B = p.b;
    int tid_ = fresh_tid(); asm volatile("" : "+v"(tid_));
    const int lane = tid_ & 63, wv = tid_ >> 6;
    const float* dnw = p.in[8] + l * 128; const float* slw = p.in[12] + l * 128;
    const float lam_scale = 1.f - (0.8f - 0.6f * __expf(-0.3f * (float)l));
    float g1[8], g2[8];
#pragma unroll
    for (int j = 0; j < 8; ++j) { g1[j] = dnw[(lane & 15) * 8 + j]; g2[j] = slw[(lane & 15) * 8 + j] * lam_scale; }
    bf16_t* Y = B.G1;
    for (int row = wg * 8 + wv; row < MP; row += nwg * 8) {
        float a[8], c[8], z[8];
        unpack8(*(const u32x4*)(B.ODN + (size_t)row * 512 + lane * 8), a);
        unpack8(*(const u32x4*)(B.ODN + (size_t)MP * 512 + (size_t)row * 512 + lane * 8), c);
        unpack8(*(const u32x4*)(B.G2 + (size_t)row * 512 + lane * 8), z);
        float ss = 0.f;
#pragma unroll
        for (int j = 0; j < 8; ++j) { a[j] += c[j]; ss += a[j] * a[j]; }
        ss += __shfl_xor(ss, 1); ss += __shfl_xor(ss, 2); ss += __shfl_xor(ss, 4); ss += __shfl_xor(ss, 8);
        float rs = rsqrtf(ss * (1.f / 128.f) + EPS);
#pragma unroll
        for (int j = 0; j < 8; ++j) a[j] = a[j] * rs * g1[j] * siluf(z[j]);
        const u32x4 y0 = pack8(a);
        unpack8(*(const u32x4*)(B.G3 + (size_t)row * 1536 + lane * 8), a);
        ss = 0.f;
#pragma unroll
        for (int j = 0; j < 8; ++j) ss += a[j] * a[j];
        ss += __shfl_xor(ss, 1); ss += __shfl_xor(ss, 2); ss += __shfl_xor(ss, 4); ss += __shfl_xor(ss, 8);
        rs = rsqrtf(ss * (1.f / 128.f) + EPS);
#pragma unroll
        for (int j = 0; j < 8; ++j) a[j] = a[j] * rs * g2[j];
        const u32x4 y1 = pack8(a);
        const u32x4 y2 = *(const u32x4*)(B.MLX + (size_t)row * 2048 + (lane >> 4) * 256 + (lane & 15) * 8);
        *(u32x4*)(Y + (size_t)row * 1536 + lane * 8) = y0;
        *(u32x4*)(Y + (size_t)row * 1536 + 512 + lane * 8) = y1;
        *(u32x4*)(Y + (size_t)row * 1536 + 1024 + lane * 8) = y2;
    }
}
namespace att {
constexpr int NT = LP / 64;
constexpr int SHM_V = 64 * 128 * 2;
__device__ __forceinline__ int crow(int r, int hi) { return (r & 3) + 8 * (r >> 2) + 4 * hi; }
__device__ __forceinline__ int v_st(int k, int c) { const int kk = (k & ~0xC) | ((k & 4) << 1) | ((k & 8) >> 1); return ((kk >> 3) * 4 + (c >> 5)) * 512 + ((kk & 7) * 32 + (c & 31)) * 2; }
__device__ __forceinline__ int v_rd_base(int lane) { return ((lane & 3) << 3) | (((lane >> 2) & 3) << 6) | (((lane >> 4) & 1) << 5) | (((lane >> 5) & 1) << 8); }
constexpr int v_rd_off(int d0, int ks, int half) { return d0 * 512 + ks * 4096 + half * 2048; }
template <int OFF> __device__ __forceinline__ s16x4 tr_read(int vb) {
    s16x4 r; asm volatile("ds_read_b64_tr_b16 %0, %1 offset:%2" : "=&v"(r) : "v"(vb), "i"(OFF) : "memory"); return r;
}
template <int D0> __device__ __forceinline__ void pv_one(f32x16& od, int vb, bf16x8 pa0, bf16x8 pa1, bf16x8 pa2, bf16x8 pa3) {
    const s16x4 l0 = tr_read<v_rd_off(D0, 0, 0)>(vb), h0 = tr_read<v_rd_off(D0, 0, 1)>(vb), l1 = tr_read<v_rd_off(D0, 1, 0)>(vb), h1 = tr_read<v_rd_off(D0, 1, 1)>(vb);
    const s16x4 l2 = tr_read<v_rd_off(D0, 2, 0)>(vb), h2 = tr_read<v_rd_off(D0, 2, 1)>(vb), l3 = tr_read<v_rd_off(D0, 3, 0)>(vb), h3 = tr_read<v_rd_off(D0, 3, 1)>(vb);
    asm volatile("s_waitcnt lgkmcnt(0)" ::: "memory"); __builtin_amdgcn_sched_barrier(0);
#define PK(Lx, Hx) (bf16x8){Lx[0], Lx[1], Lx[2], Lx[3], Hx[0], Hx[1], Hx[2], Hx[3]}
    od = __builtin_amdgcn_mfma_f32_32x32x16_bf16(pa0, PK(l0, h0), od, 0, 0, 0);
    od = __builtin_amdgcn_mfma_f32_32x32x16_bf16(pa1, PK(l1, h1), od, 0, 0, 0);
    od = __builtin_amdgcn_mfma_f32_32x32x16_bf16(pa2, PK(l2, h2), od, 0, 0, 0);
    od = __builtin_amdgcn_mfma_f32_32x32x16_bf16(pa3, PK(l3, h3), od, 0, 0, 0);
#undef PK
}
template <int ROWB> __device__ __forceinline__ int kswz(int row, int colB) { return row * ROWB + (colB ^ (((row >> 1) & 7) << 4)); }

struct KVSrc {
    const bf16_t* k0; int ldk;
    const bf16_t* k1;
    const bf16_t* v; int ldv;
};

template <int DQK, int KSPLIT, bool BIAS>
__device__ __forceinline__ void attn_pass(const bf16x8 (&qr)[DQK / 16], const KVSrc& S, LAS unsigned char* lds, int qpos0, const LAS float* bias_tab, float bias_neg, float bias_pos, f32x16 (&o)[4], const int wave_idx_) {
    constexpr int ROWB = DQK * 2, SHM_K = 64 * ROWB, NKC = DQK / 8, NKP = (64 * NKC) / 512;
    static_assert((64 * NKC) % 512 == 0, "K tile pieces");
    int tid_ = fresh_tid(); asm volatile("" : "+v"(tid_));
    const int tid = tid_, wid = tid >> 6, lane = tid & 63, r32 = lane & 31, hi = lane >> 5;
    LAS unsigned char* V_lds = lds; LAS unsigned char* K_lds = lds + 2 * SHM_V;
    LAS float* wsl = (LAS float*)(lds + 2 * SHM_V + 2 * SHM_K) + wid * 64; LAS float* li_l = wsl; LAS float* al_l = wsl + 32;
    float m_reg = -1e30f, l_reg = 0.f;
#pragma unroll
    for (int d = 0; d < 4; ++d)
#pragma unroll
        for (int r = 0; r < 16; ++r) o[d][r] = 0.f;
    unsigned voffs[2], koffs[NKP];
#pragma unroll
    for (int i = 0; i < 2; ++i) { const int P = i * 512 + tid, sub = P >> 5, kk = (sub >> 2) * 8 + ((P & 31) >> 2), c = (sub & 3) * 32 + (P & 3) * 8;
        const int k = (kk & ~0xC) | ((kk & 4) << 1) | ((kk & 8) >> 1); voffs[i] = (unsigned)(k * S.ldv + c); }
#pragma unroll
    for (int i = 0; i < NKP; ++i) { const int P = i * 512 + tid, row = P / NKC, cs = P % NKC, ch = cs ^ ((row >> 1) & 7); const int col = ch * 8;
        koffs[i] = (unsigned)(row * S.ldk + (col < KSPLIT ? col : col - KSPLIT)) | (col < KSPLIT ? 0u : 0x80000000u); }
    const unsigned ldsw = (unsigned)__builtin_amdgcn_readfirstlane(wid) * 1024u;
#define SDMA(t, bb) do { const size_t kr_ = (size_t)(t) * 64; \
        _Pragma("unroll") for (int i_ = 0; i_ < 2; ++i_) __builtin_amdgcn_global_load_lds((const unsigned*)(S.v + kr_ * S.ldv + voffs[i_]), (LAS unsigned*)(V_lds + (bb) * SHM_V + i_ * 8192 + ldsw), 16, 0, 0); \
        _Pragma("unroll") for (int i_ = 0; i_ < NKP; ++i_) { const bf16_t* kb_ = (koffs[i_] & 0x80000000u) ? S.k1 : S.k0; \
            __builtin_amdgcn_global_load_lds((const unsigned*)(kb_ + kr_ * S.ldk + (koffs[i_] & 0x7FFFFFFFu)), (LAS unsigned*)(K_lds + (bb) * SHM_K + i_ * 8192 + ldsw), 16, 0, 0); } } while (0)
    const int vb0 = (int)(uintptr_t)V_lds + v_rd_base(lane);
    SDMA(0, 0);
    asm volatile("s_waitcnt vmcnt(0)" ::: "memory");
    __syncthreads();
    for (int j = 0; j < NT; ++j) {
        const int b = j & 1;
        if (j + 1 < NT) SDMA(j + 1, b ^ 1);
        f32x16 p0, p1;
#pragma unroll
        for (int r = 0; r < 16; ++r) { p0[r] = 0.f; p1[r] = 0.f; }
        {
            const LAS unsigned char* Kb = K_lds + b * SHM_K;
#pragma unroll
            for (int g = 0; g < DQK / 64; ++g) {
#pragma unroll
                for (int dd = 0; dd < 4; ++dd) { const int d0 = g * 4 + dd; const int cb = (d0 * 16 + hi * 8) * 2;
                    const bf16x8 b0 = *(const LAS bf16x8*)(Kb + kswz<ROWB>(r32, cb));
                    const bf16x8 b1 = *(const LAS bf16x8*)(Kb + kswz<ROWB>(32 + r32, cb));
                    p0 = __builtin_amdgcn_mfma_f32_32x32x16_bf16(b0, qr[d0], p0, 0, 0, 0);
                    p1 = __builtin_amdgcn_mfma_f32_32x32x16_bf16(b1, qr[d0], p1, 0, 0, 0); }
                __builtin_amdgcn_sched_barrier(0);
            }
        }
        if (BIAS) {
            const int kpos0 = j * 64 - PADF;
            const int rel_min = kpos0 - (qpos0 + 31), rel_max = kpos0 + 63 - qpos0;
            if (rel_min >= 91) {
#pragma unroll
                for (int r = 0; r < 16; ++r) { p0[r] += bias_pos; p1[r] += bias_pos; }
            } else if (rel_max <= -91) {
#pragma unroll
                for (int r = 0; r < 16; ++r) { p0[r] += bias_neg; p1[r] += bias_neg; }
            } else {
                const int base = kpos0 - (qpos0 + r32) + 128;
#pragma unroll
                for (int r = 0; r < 16; ++r) { int i0 = base + crow(r, hi), i1 = i0 + 32;
                    i0 = i0 < 0 ? 0 : (i0 > 255 ? 255 : i0); i1 = i1 < 0 ? 0 : (i1 > 255 ? 255 : i1);
                    p0[r] += bias_tab[i0]; p1[r] += bias_tab[i1]; }
            }
        }
        if (j == 0) {
#pragma unroll
            for (int r = 0; r < 16; ++r) p0[r] = -1e30f;
#pragma unroll
            for (int r = 0; r < 8; ++r) p1[r] = -1e30f;
        }
        float pmax = p0[0];
#pragma unroll
        for (int r = 1; r < 16; ++r) pmax = fmaxf(pmax, p0[r]);
#pragma unroll
        for (int r = 0; r < 16; ++r) pmax = fmaxf(pmax, p1[r]);
        { auto rr = __builtin_amdgcn_permlane32_swap(__float_as_uint(pmax), __float_as_uint(pmax), false, false);
          pmax = fmaxf(__uint_as_float(rr[0]), __uint_as_float(rr[1])); }
        float alpha = 1.f, mn = m_reg;
        const bool need = !__all(pmax - m_reg <= 8.f);
        if (need) { mn = fmaxf(m_reg, pmax); alpha = __builtin_amdgcn_exp2f(m_reg - mn); m_reg = mn; }
        float ps = 0.f;
#pragma unroll
        for (int r = 0; r < 16; ++r) { p0[r] = __builtin_amdgcn_exp2f(p0[r] - mn); ps += p0[r]; }
#pragma unroll
        for (int r = 0; r < 16; ++r) { p1[r] = __builtin_amdgcn_exp2f(p1[r] - mn); ps += p1[r]; }
        l_reg = l_reg * alpha + ps;
        bf16x8 pa0, pa1, pa2, pa3;
#define PK4(P, BASE, OUT) do { unsigned a0 = cvt_pk_bf16(P[BASE + 0], P[BASE + 1]), a1 = cvt_pk_bf16(P[BASE + 2], P[BASE + 3]);   \
        unsigned b0_ = cvt_pk_bf16(P[BASE + 4], P[BASE + 5]), b1_ = cvt_pk_bf16(P[BASE + 6], P[BASE + 7]);                              \
        auto r0 = __builtin_amdgcn_permlane32_swap(a0, b0_, false, false); auto r1 = __builtin_amdgcn_permlane32_swap(a1, b1_, false, false); \
        u32x4 w = {r0[0], r1[0], r0[1], r1[1]}; OUT = *reinterpret_cast<bf16x8*>(&w); } while (0)
        PK4(p0, 0, pa0); PK4(p0, 8, pa1); PK4(p1, 0, pa2); PK4(p1, 8, pa3);
#undef PK4
        if (need) {
            if (hi == 0) al_l[r32] = alpha;
            asm volatile("s_waitcnt lgkmcnt(0)" ::: "memory");
#pragma unroll
            for (int r = 0; r < 16; ++r) { const float a = al_l[crow(r, hi)];
#pragma unroll
                for (int d = 0; d < 4; ++d) o[d][r] *= a; }
        }
        {
            const int vb = vb0 + b * SHM_V;
            pv_one<0>(o[0], vb, pa0, pa1, pa2, pa3); pv_one<1>(o[1], vb, pa0, pa1, pa2, pa3); pv_one<2>(o[2], vb, pa0, pa1, pa2, pa3); pv_one<3>(o[3], vb, pa0, pa1, pa2, pa3);
        }
        asm volatile("s_waitcnt vmcnt(0)" ::: "memory");
        __syncthreads();
    }
    { auto rr = __builtin_amdgcn_permlane32_swap(__float_as_uint(l_reg), __float_as_uint(l_reg), false, false);
      l_reg = __uint_as_float(rr[0]) + __uint_as_float(rr[1]); }
    if (hi == 0) li_l[r32] = l_reg;
    asm volatile("s_waitcnt lgkmcnt(0)" ::: "memory");
#pragma unroll
    for (int r = 0; r < 16; ++r) { const float il = __builtin_amdgcn_rcpf(li_l[crow(r, hi)]);
#pragma unroll
        for (int d = 0; d < 4; ++d) o[d][r] *= il; }
    __syncthreads();
#undef SDMA
}
}

__device__ __forceinline__ int t5_bucket(int rel) {
    const int n = rel < 0 ? -rel : rel;
    int f;
    if (n < 8) f = n; else if (n < 12) f = 8; else if (n < 16) f = 9; else if (n < 23) f = 10; else if (n < 32) f = 11;
    else if (n < 46) f = 12; else if (n < 64) f = 13; else if (n < 91) f = 14; else f = 15;
    return (rel > 0 ? 16 : 0) + f;
}

__device__ __forceinline__ void diff_unit(CParams& p, int l, int b, int h, int qb, LAS unsigned char* lds, const int wave_idx_) {
    auto& B = p.b;
    int tid_ = fresh_tid(); asm volatile("" : "+v"(tid_));
    const int tid = tid_, wid = tid >> 6, lane = tid & 63, r32 = lane & 31, hi = lane >> 5;
    constexpr int LDS_TAB = 2 * att::SHM_V + 2 * 64 * 128 + 8 * 64 * 4;
    LAS float* tab = (LAS float*)(lds + LDS_TAB);
    const float* table = p.in[2];
    if (tid < 256) { const int rel = tid - 128; tab[tid] = table[t5_bucket(rel) * 4 + h] * LOG2E; }
    const float bias_neg = table[15 * 4 + h] * LOG2E, bias_pos = table[31 * 4 + h] * LOG2E;
    const float lam = p.b.misc[l];
    const size_t row0 = (size_t)b * LP;
    const int qrow = qb * 256 + wid * 32 + r32;
    const bool valid = qrow < LP;
    const size_t qr_g = row0 + (valid ? qrow : LP - 1);
    bf16x8 q0[4];
    const bf16_t* qp = B.G3 + qr_g * 1536 + h * 128 + hi * 8;
#pragma unroll
    for (int d0 = 0; d0 < 4; ++d0) q0[d0] = *(const bf16x8*)(qp + d0 * 16);
    __syncthreads();
    att::KVSrc S; S.ldk = 1536; S.ldv = 1536; S.v = B.G3 + row0 * 1536 + 1024 + h * 128;
    const int qpos0 = qb * 256 + wid * 32 - PADF;
    const int wrow0 = qb * 256 + wid * 32;
    f32x16 o[4];
    S.k0 = B.G3 + row0 * 1536 + 512 + h * 128; S.k1 = S.k0;
    att::attn_pass<64, 64, true>(q0, S, lds, qpos0, tab, bias_neg, bias_pos, o, wave_idx_);
#pragma unroll
    for (int d0 = 0; d0 < 4; ++d0) q0[d0] = *(const bf16x8*)(qp + 64 + d0 * 16);
    asm volatile("s_waitcnt vmcnt(0)" ::: "memory");
#pragma unroll
    for (int r = 0; r < 16; ++r) { const int lr = wrow0 + att::crow(r, hi);
        if (lr < LP) { bf16_t* op = B.G3 + (row0 + lr) * 1536 + h * 128 + r32;
#pragma unroll
            for (int d = 0; d < 4; ++d) op[d * 32] = f2bf(o[d][r]); } }
    S.k0 = B.G3 + row0 * 1536 + 512 + h * 128 + 64; S.k1 = S.k0;
    att::attn_pass<64, 64, true>(q0, S, lds, qpos0, tab, bias_neg, bias_pos, o, wave_idx_);
#pragma unroll
    for (int r = 0; r < 16; ++r) { const int lr = wrow0 + att::crow(r, hi);
        if (lr < LP) { bf16_t* op = B.G3 + (row0 + lr) * 1536 + h * 128 + r32;
#pragma unroll
            for (int d = 0; d < 4; ++d) { const float a = bf2f(op[d * 32]); op[d * 32] = f2bf(a - lam * o[d][r]); } } }
}

__device__ __forceinline__ void mla_unit(CParams& p, int b, int h, int qb, LAS unsigned char* lds, const int wave_idx_) {
    auto& B = p.b;
    int tid_ = fresh_tid(); asm volatile("" : "+v"(tid_));
    const int tid = tid_, wid = tid >> 6, lane = tid & 63, r32 = lane & 31, hi = lane >> 5;
    const size_t row0 = (size_t)b * LP;
    const int qrow = qb * 256 + wid * 32 + r32;
    const bool valid = qrow < LP;
    const size_t qr_g = row0 + (valid ? qrow : LP - 1);
    bf16x8 q[12];
    const bf16_t* qp = B.MLX + qr_g * 2048 + h * 256 + hi * 8;
#pragma unroll
    for (int d0 = 0; d0 < 12; ++d0) q[d0] = *(const bf16x8*)(qp + d0 * 16);
    att::KVSrc S; S.ldk = 2048; S.ldv = 2048;
    S.k0 = B.MLX + row0 * 2048 + 1024 + h * 256; S.k1 = B.MLX + row0 * 2048 + h * 256 + 192; S.v = B.MLX + row0 * 2048 + 1024 + h * 256 + 128;
    f32x16 o[4];
    att::attn_pass<192, 128, false>(q, S, lds, 0, nullptr, 0.f, 0.f, o, wave_idx_);
    const int wrow0 = qb * 256 + wid * 32;
#pragma unroll
    for (int r = 0; r < 16; ++r) { const int lr = wrow0 + att::crow(r, hi);
        if (lr < LP) { bf16_t* op = B.MLX + (row0 + lr) * 2048 + h * 256 + r32;
#pragma unroll
            for (int d = 0; d < 4; ++d) op[d * 32] = f2bf(o[d][r]); } }
}
namespace dn {
typedef float f32x4_t __attribute__((ext_vector_type(4)));
constexpr int RS = 272;
constexpr int QS = 136;
constexpr int O_Q = 0, O_K = 17408, O_KB = 2 * 17408, O_VB = 3 * 17408, O_KT = 4 * 17408, O_QK = 5 * 17408, O_A = O_QK + 8704, O_TAB = O_A + 16384;
__device__ __forceinline__ int crow32(int r, int hi) { return (r & 3) + 8 * (r >> 2) + 4 * hi; }
typedef short bf16x4 __attribute__((ext_vector_type(4)));
__device__ __forceinline__ bf16x8 cat4(bf16x4 a, bf16x4 b) { return (bf16x8){a[0], a[1], a[2], a[3], b[0], b[1], b[2], b[3]}; }

__device__ __forceinline__ void dn_item(CParams& p, int l, int b, int h, int dir, LAS unsigned char* lds, const int wave_idx_) {
    auto& B = p.b;
    int tid_ = fresh_tid(); asm volatile("" : "+v"(tid_));
    const int tid = tid_, w = __builtin_amdgcn_readfirstlane(tid >> 6), lane = tid & 63;
    LAS float* tab = (LAS float*)(lds + O_TAB);
    LAS float* Amat = (LAS float*)(lds + O_A);
    const size_t row0 = (size_t)b * LP;
    const bf16_t* G1 = B.G1 + row0 * 1536;
    const float* BGb = B.BG + row0 * 16;
    const int jb = dir * 4 + h;
    f32x4 St[8];
#pragma unroll
    for (int t = 0; t < 8; ++t) St[t] = (f32x4){0.f, 0.f, 0.f, 0.f};
    const int n16 = lane & 15, q4 = lane >> 4;
    bf16_t* outp = B.ODN + (size_t)dir * MP * 512 + row0 * 512 + h * 128 + 16 * w + n16;

    for (int c = 0; c < 65; ++c) {
        const bool rev = (dir == 1 && c > 0);
        {
            int lp_lo = rev ? (4223 - 64 * c - 8 * w - 7) : (64 * c + 8 * w);
            asm volatile("" : "+v"(lp_lo));
            float cw[3][5][2];
            {
                const float* cwp = p.in[5] + (size_t)l * 5 * 1536 + h * 128 + 2 * lane;
#pragma unroll
                for (int t = 0; t < 3; ++t)
#pragma unroll
                    for (int j = 0; j < 5; ++j) { const float2 c2 = *(const float2*)(cwp + j * 1536 + t * 512); cw[t][j][0] = c2.x; cw[t][j][1] = c2.y; }
            }
            float x[3][12][2];
            const bf16_t* gp = G1 + (ptrdiff_t)(lp_lo - 2) * 1536 + h * 128 + 2 * lane;
#pragma unroll
            for (int rr = 0; rr < 12; ++rr) { const int lp = lp_lo - 2 + rr; const bool ok = (lp >= PADF) && (lp < LP);
#pragma unroll
                for (int t = 0; t < 3; ++t) { unsigned u = 0u; if (ok) u = *(const unsigned*)(gp + rr * 1536 + t * 512);
                    x[t][rr][0] = bflo(u); x[t][rr][1] = bfhi(u); } }
            const bool zero_wave = (c == 0 && w < 6);
            float y[3][8][2];
#pragma unroll
            for (int t = 0; t < 3; ++t)
#pragma unroll
                for (int m = 0; m < 8; ++m)
#pragma unroll
                    for (int e = 0; e < 2; ++e) { float a = 0.f;
#pragma unroll
                        for (int j = 0; j < 5; ++j) a = fmaf(x[t][m + j][e], cw[t][j][e], a);
                        y[t][m][e] = zero_wave ? 0.f : siluf(a); }
#pragma unroll
            for (int m = 0; m < 8; ++m) {
                const float sq = wave_sum(y[0][m][0] * y[0][m][0] + y[0][m][1] * y[0][m][1]);
                const float sk = wave_sum(y[1][m][0] * y[1][m][0] + y[1][m][1] * y[1][m][1]);
                const float rq = rsqrtf(sq + EPS) * 0.08838834764831845f, rk = rsqrtf(sk + EPS);
                y[0][m][0] *= rq; y[0][m][1] *= rq; y[1][m][0] *= rk; y[1][m][1] *= rk;
            }
            unsigned ktp[2][8];
#pragma unroll
            for (int m = 0; m < 8; ++m) {
                const int lp = lp_lo + m; const int r = rev ? 7 - m : m; const int i = 8 * w + r;
                const float be = zero_wave ? 0.f : BGb[(size_t)lp * 16 + jb];
                *(LAS unsigned*)(lds + O_Q + i * RS + 4 * lane) = cvt_pk_bf16(y[0][m][0], y[0][m][1]);
                *(LAS unsigned*)(lds + O_K + i * RS + 4 * lane) = cvt_pk_bf16(y[1][m][0], y[1][m][1]);
                *(LAS unsigned*)(lds + O_KB + i * RS + 4 * lane) = cvt_pk_bf16(y[1][m][0] * be, y[1][m][1] * be);
                *(LAS unsigned*)(lds + O_VB + i * RS + 4 * lane) = cvt_pk_bf16(y[2][m][0] * be, y[2][m][1] * be);
                ktp[0][m] = cvt_pk_bf16(y[1][m][0], 0.f) & 0xFFFFu; ktp[1][m] = cvt_pk_bf16(y[1][m][1], 0.f) & 0xFFFFu;
            }
#pragma unroll
            for (int e = 0; e < 2; ++e)
#pragma unroll
                for (int mm = 0; mm < 4; ++mm) {
                    const unsigned lo = rev ? ktp[e][7 - 2 * mm] : ktp[e][2 * mm], hi2 = rev ? ktp[e][6 - 2 * mm] : ktp[e][2 * mm + 1];
                    *(LAS unsigned*)(lds + O_KT + (2 * lane + e) * QS + (8 * w + 2 * mm) * 2) = lo | (hi2 << 16);
                }
            if (w == 0) {
                const int lp = rev ? (4223 - 64 * c - lane) : (64 * c + lane);
                const bool ok = !(c == 0 && lane < PADF);
                const float g = ok ? BGb[(size_t)lp * 16 + 8 + jb] : 0.f, be = ok ? BGb[(size_t)lp * 16 + jb] : 0.f;
                float gc = g;
#pragma unroll
                for (int o = 1; o < 64; o <<= 1) { const float t = __shfl_up(gc, o); if (lane >= o) gc += t; }
                const float gl = __shfl(gc, 63);
                tab[lane] = gc; tab[64 + lane] = __expf(gc); tab[128 + lane] = __expf(gl - gc); tab[192 + lane] = be;
            }
        }
        __syncthreads();
        {
            const int tsel = w >> 2, a = (w >> 1) & 1, bc = w & 1, r32 = lane & 31, hi = lane >> 5;
            if (!(a == 0 && bc == 1)) {
                f32x16 acc;
#pragma unroll
                for (int r = 0; r < 16; ++r) acc[r] = 0.f;
                const LAS unsigned char* Ai = lds + (tsel ? O_Q : O_KB) + (32 * a + r32) * RS + hi * 16;
                const LAS unsigned char* Bi = lds + O_K + (32 * bc + r32) * RS + hi * 16;
#pragma unroll
                for (int s = 0; s < 8; ++s) { const bf16x8 af = *(const LAS bf16x8*)(Ai + s * 32), bf = *(const LAS bf16x8*)(Bi + s * 32);
                    acc = __builtin_amdgcn_mfma_f32_32x32x16_bf16(af, bf, acc, 0, 0, 0); }
                const int j = 32 * bc + r32; const float gcj = tab[j];
#pragma unroll
                for (int r = 0; r < 16; ++r) { const int i = 32 * a + crow32(r, hi); const float gci = tab[i];
                    const bool keep = tsel ? (j <= i) : (j < i);
                    const float v = keep ? acc[r] * __expf(gci - gcj) : 0.f;
                    if (tsel == 0) Amat[i * 64 + j] = v; else *(LAS bf16_t*)(lds + O_QK + i * QS + j * 2) = f2bf(v); }
            } else {
                const int j = 32 + (lane & 31);
#pragma unroll
                for (int r = 0; r < 16; ++r) { const int i = crow32(r, lane >> 5);
                    if (tsel == 0) Amat[i * 64 + j] = 0.f; else *(LAS bf16_t*)(lds + O_QK + i * QS + j * 2) = (bf16_t)0; }
            }
        }
        __syncthreads();
        if (tid < 256) {
            const bool isk = tid >= 128; const int col = tid & 127;
            LAS unsigned char* img = lds + (isk ? O_KB : O_VB) + col * 2;
            unsigned abase = (unsigned)(uintptr_t)Amat, tbase = (unsigned)(uintptr_t)tab;
            asm volatile("" : "+v"(abase), "+v"(tbase));
            float xs[64];
#pragma unroll
            for (int i = 0; i < 64; ++i) {
                float a = bf2f(*(const LAS bf16_t*)(img + i * RS));
                if (isk) a *= *(const LAS float*)(uintptr_t)(tbase + (64 + i) * 4);
#pragma unroll
                for (int j4 = 0; j4 < (i + 3) / 4; ++j4) { const f32x4 av = *(const LAS f32x4*)(uintptr_t)(abase + (i * 64 + j4 * 4) * 4);
#pragma unroll
                    for (int jj = 0; jj < 4; ++jj) if (j4 * 4 + jj < i) a = fmaf(-av[jj], xs[j4 * 4 + jj], a); }
                xs[i] = a;
                *(LAS bf16_t*)(img + i * RS) = f2bf(a);
            }
        }
        __syncthreads();
        {
            bf16x8 Sb[4];
#pragma unroll
            for (int s = 0; s < 4; ++s) { const u32x4 wv = {cvt_pk_bf16(St[2 * s][0], St[2 * s][1]), cvt_pk_bf16(St[2 * s][2], St[2 * s][3]), cvt_pk_bf16(St[2 * s + 1][0], St[2 * s + 1][1]), cvt_pk_bf16(St[2 * s + 1][2], St[2 * s + 1][3])};
                Sb[s] = *reinterpret_cast<const bf16x8*>(&wv); }
            f32x4 U[4], Q[4];
#pragma unroll
            for (int a = 0; a < 4; ++a) { U[a] = (f32x4){0.f, 0.f, 0.f, 0.f}; Q[a] = (f32x4){0.f, 0.f, 0.f, 0.f}; }
#pragma unroll
            for (int a = 0; a < 4; ++a)
#pragma unroll
                for (int s = 0; s < 4; ++s) {
                    const LAS unsigned char* pk = lds + O_KB + (16 * a + n16) * RS + (32 * s + 4 * q4) * 2;
                    const LAS unsigned char* pq = lds + O_Q + (16 * a + n16) * RS + (32 * s + 4 * q4) * 2;
                    const bf16x8 ak = cat4(*(const LAS bf16x4*)pk, *(const LAS bf16x4*)(pk + 32));
                    const bf16x8 aq = cat4(*(const LAS bf16x4*)pq, *(const LAS bf16x4*)(pq + 32));
                    U[a] = __builtin_amdgcn_mfma_f32_16x16x32_bf16(ak, Sb[s], U[a], 0, 0, 0);
                    Q[a] = __builtin_amdgcn_mfma_f32_16x16x32_bf16(aq, Sb[s], Q[a], 0, 0, 0);
                }
            f32x4 Vn[4];
#pragma unroll
            for (int a = 0; a < 4; ++a)
#pragma unroll
                for (int r = 0; r < 4; ++r) { const int i = 16 * a + 4 * q4 + r;
                    const float val = bf2f(*(const LAS bf16_t*)(lds + O_VB + i * RS + (16 * w + n16) * 2));
                    Vn[a][r] = val - U[a][r]; Q[a][r] *= tab[64 + i]; }
            bf16x8 Vb[2], Vs[2];
#pragma unroll
            for (int s = 0; s < 2; ++s) {
                float e0[4], e1[4];
#pragma unroll
                for (int r = 0; r < 4; ++r) { e0[r] = tab[128 + 32 * s + 4 * q4 + r]; e1[r] = tab[128 + 32 * s + 16 + 4 * q4 + r]; }
                const u32x4 w0 = {cvt_pk_bf16(Vn[2 * s][0], Vn[2 * s][1]), cvt_pk_bf16(Vn[2 * s][2], Vn[2 * s][3]), cvt_pk_bf16(Vn[2 * s + 1][0], Vn[2 * s + 1][1]), cvt_pk_bf16(Vn[2 * s + 1][2], Vn[2 * s + 1][3])};
                const u32x4 w1 = {cvt_pk_bf16(Vn[2 * s][0] * e0[0], Vn[2 * s][1] * e0[1]), cvt_pk_bf16(Vn[2 * s][2] * e0[2], Vn[2 * s][3] * e0[3]),
                                  cvt_pk_bf16(Vn[2 * s + 1][0] * e1[0], Vn[2 * s + 1][1] * e1[1]), cvt_pk_bf16(Vn[2 * s + 1][2] * e1[2], Vn[2 * s + 1][3] * e1[3])};
                Vb[s] = *reinterpret_cast<const bf16x8*>(&w0); Vs[s] = *reinterpret_cast<const bf16x8*>(&w1);
            }
#pragma unroll
            for (int a = 0; a < 4; ++a)
#pragma unroll
                for (int s = 0; s < 2; ++s) {
                    const LAS unsigned char* pa = lds + O_QK + (16 * a + n16) * QS + (32 * s + 4 * q4) * 2;
                    const bf16x8 af = cat4(*(const LAS bf16x4*)pa, *(const LAS bf16x4*)(pa + 32));
                    Q[a] = __builtin_amdgcn_mfma_f32_16x16x32_bf16(af, Vb[s], Q[a], 0, 0, 0);
                }
            const float egl = tab[64 + 63];
#pragma unroll
            for (int t = 0; t < 8; ++t) {
                St[t] *= egl;
#pragma unroll
                for (int s = 0; s < 2; ++s) {
                    const LAS unsigned char* pa = lds + O_KT + (16 * t + n16) * QS + (32 * s + 4 * q4) * 2;
                    const bf16x8 af = cat4(*(const LAS bf16x4*)pa, *(const LAS bf16x4*)(pa + 32));
                    St[t] = __builtin_amdgcn_mfma_f32_16x16x32_bf16(af, Vs[s], St[t], 0, 0, 0);
                }
            }
#pragma unroll
            for (int a = 0; a < 4; ++a)
#pragma unroll
                for (int r = 0; r < 4; ++r) { const int i = 16 * a + 4 * q4 + r; const int lp = rev ? (4223 - 64 * c - i) : (64 * c + i);
                    outp[(size_t)lp * 512] = f2bf(Q[a][r]); }
        }
        __syncthreads();
    }
}
}
constexpr int NHALF = NB >= 2 ? 2 : 1, BPH = NB / NHALF, CAP = BPH * L;
constexpr int CW_MOECNT = 8192;

__device__ __forceinline__ void norm_router_rows(CParams& p, int wg, int nwg, LAS unsigned char* lds, const int wave_idx_) {
    auto& B = p.b;
    int tid_ = fresh_tid(); asm volatile("" : "+v"(tid_));
    const int tid = tid_, lane = tid & 63, wv = tid >> 6;
    LAS float* Wr = (LAS float*)lds;
    { const float* rw = p.in[24];
      for (int i = tid; i < 8192; i += NWG_THREADS) { const int d = i >> 3, e = i & 7; Wr[e * 1024 + d] = rw[i]; } }
    __syncthreads();
    const float* w = p.in[20] + D;
    int kr = 0, ke0 = 0, ke1 = 0; float kg0 = 0.f, kg1 = 0.f; int nk = 0;
    for (int row = wg * 8 + wv; row < MP; row += nwg * 8) {
        const float* hp = hf_row(B.Hout, B.Hside, row); f32x4 v[4]; float ss = 0.f;
#pragma unroll
        for (int j = 0; j < 4; ++j) { v[j] = *(const f32x4*)(hp + j * 256 + lane * 4); ss += v[j][0] * v[j][0] + v[j][1] * v[j][1] + v[j][2] * v[j][2] + v[j][3] * v[j][3]; }
        ss = wave_sum(ss);
        const float rs = rsqrtf(ss * (1.f / D) + EPS);
        float lg[8];
#pragma unroll
        for (int e = 0; e < 8; ++e) lg[e] = 0.f;
#pragma unroll
        for (int j = 0; j < 4; ++j) { const f32x4 g = *(const f32x4*)(w + j * 256 + lane * 4);
            f32x4 u; u[0] = v[j][0] * rs * g[0]; u[1] = v[j][1] * rs * g[1]; u[2] = v[j][2] * rs * g[2]; u[3] = v[j][3] * rs * g[3];
            *(u32x2*)(B.Ub + (size_t)row * D + j * 256 + lane * 4) = (u32x2){cvt_pk_bf16(u[0], u[1]), cvt_pk_bf16(u[2], u[3])};
#pragma unroll
            for (int e = 0; e < 8; ++e) { const f32x4 wr4 = *(const LAS f32x4*)(Wr + e * 1024 + j * 256 + lane * 4);
                lg[e] += u[0] * wr4[0] + u[1] * wr4[1] + u[2] * wr4[2] + u[3] * wr4[3]; } }
#pragma unroll
        for (int e = 0; e < 8; ++e) lg[e] = wave_sum(lg[e]);
        int i0 = 0; float v0 = lg[0];
#pragma unroll
        for (int e = 1; e < 8; ++e) if (lg[e] > v0) { v0 = lg[e]; i0 = e; }
        int i1 = -1; float v1 = -3e38f;
#pragma unroll
        for (int e = 0; e < 8; ++e) if (e != i0 && lg[e] > v1) { v1 = lg[e]; i1 = e; }
        const float e1 = __expf(v1 - v0), g0 = 1.f / (1.f + e1), g1 = e1 / (1.f + e1);
        if (row_valid(row)) { if (lane == nk) { kr = row; ke0 = i0; ke1 = i1; kg0 = g0; kg1 = g1; } ++nk; }
    }
    const bool have = lane < nk; const int hfl = have ? (kr / LP) / BPH : -1;
    const unsigned long long lt = (1ull << lane) - 1ull;
#pragma unroll
    for (int hf = 0; hf < NHALF; ++hf)
#pragma unroll
        for (int e = 0; e < 8; ++e) {
            const bool m0 = have && hfl == hf && ke0 == e, m1 = have && hfl == hf && ke1 == e;
            const unsigned long long b0 = __ballot(m0), b1 = __ballot(m1);
            const int n0 = __popcll(b0), n = n0 + __popcll(b1);
            if (n) {
                unsigned base = 0u;
                if (lane == 0) base = __hip_atomic_fetch_add(B.ctl + CW_MOECNT + (hf * 8 + e) * 64, (unsigned)n, __ATOMIC_RELAXED, __HIP_MEMORY_SCOPE_AGENT);
                base = (unsigned)__builtin_amdgcn_readfirstlane((int)base);
                if (m0) { const size_t pos = (size_t)(hf * 8 + e) * CAP + base + __popcll(b0 & lt); B.LST[pos] = kr * 2; B.GL[pos] = kg0; }
                if (m1) { const size_t pos = (size_t)(hf * 8 + e) * CAP + base + n0 + __popcll(b1 & lt); B.LST[pos] = kr * 2 + 1; B.GL[pos] = kg1; }
            }
        }
}
__device__ __forceinline__ void moe_combine(CParams& p, int hf, int wg, int nwg, const int wave_idx_) {
    auto& B = p.b;
    int tid_ = fresh_tid(); asm volatile("" : "+v"(tid_));
    const int lane = tid_ & 63, wv = tid_ >> 6;
    for (int t = wg * 8 + wv; t < CAP; t += nwg * 8) {
        const int bl = t / L, pos = t - bl * L; const int row = (hf * BPH + bl) * LP + PADF + pos;
        float* hp = hf_row(B.Hout, B.Hside, row); const bf16_t* yp = B.YS1 + (size_t)t * D;
#pragma unroll
        for (int j = 0; j < 2; ++j) { float y[8]; unpack8(*(const u32x4*)(yp + j * 512 + lane * 8), y);
            f32x4* h0 = (f32x4*)(hp + j * 512 + lane * 8); f32x4 a = h0[0], c = h0[1];
            a[0] += y[0]; a[1] += y[1]; a[2] += y[2]; a[3] += y[3]; c[0] += y[4]; c[1] += y[5]; c[2] += y[6]; c[3] += y[7];
            h0[0] = a; h0[1] = c; }
    }
}
constexpr int LDS_STAGE = 131072, MISC_OFF = LDS_STAGE, LDS_BYTES = LDS_STAGE + 2048;
constexpr int PH_PROLOGUE = 0, PH_LAYER0 = 1, PH_PER_LAYER = 16, PH_FINAL = PH_LAYER0 + 2 * PH_PER_LAYER, PH_END = PH_FINAL + 1;
constexpr int PL_NORM1 = 0, PL_INPROJ = 1, PL_PREP = 2, PL_MLAUP = 3, PL_MLAFIN = 4, PL_MIXER = 5, PL_POST = 6, PL_OUTPROJ = 7, PL_NORM2 = 8, PL_FFN1 = 9, PL_FFN2 = 10, PL_COMB = 11, PL_FFN1B = 12, PL_FFN2B = 13, PL_COMBB = 14;

__device__ __forceinline__ int opq(int v) { asm volatile("" : "+s"(v)); return v; }
__device__ __forceinline__ bool in_phase(int lo, int hi, int k) { asm volatile("" : "+s"(lo), "+s"(hi)); return lo <= k && k < hi; }
__global__ void __launch_bounds__(NWG_THREADS, 2) mega(Params p_) {
    extern __shared__ __attribute__((aligned(16))) unsigned char lds_raw[];
    LAS unsigned char* lds = (LAS unsigned char*)lds_raw;
    volatile LAS unsigned* misc = (volatile LAS unsigned*)(lds + MISC_OFF);
    const int wave_idx_ = __builtin_amdgcn_readfirstlane((int)threadIdx.x >> 6);
    const int tid = fresh_tid();
    if (tid < 64) misc[tid] = 0u;
    __syncthreads();
    const int G0 = gridDim.x; const int bx0 = blockIdx.x;
    XcdBarrier bar; bar.bar = p_.b.ctl; bar.x = 0; bar.st = misc + 8;
    const int fused = p_.fused;
    if (fused) bar = xcd_barrier_post(p_.b.ctl, misc + 8);
    const int lo = p_.ph_lo, hi = p_.ph_hi;
#define IN(k) in_phase(lo, hi, (k))
#define SEAM(k) do { if (fused && IN((k) + 1)) xcd_barrier(bar); } while (0)

    if (IN(PH_PROLOGUE)) { CParams& p = *opaque_params(); auto& B = p.b; const int bx = opq(bx0), G = opq(G0); (void)B; (void)bx; (void)G;
        for (int job = 0; job < 7; ++job) {
            int mode, ldsrc, K, N, lddst; const float* src; bf16_t* dst;
            if (job < 2)      { mode = 1; src = p.in[4] + (size_t)job * D * 4048; ldsrc = 4048; K = D; N = 4096; dst = B.WinT + (size_t)job * 4096 * D; lddst = D; }
            else if (job < 4) { mode = 0; src = p.in[19] + (size_t)(job - 2) * DMIX * D; ldsrc = D; K = DMIX; N = D; dst = B.WoutT + (size_t)(job - 2) * D * DMIX; lddst = DMIX; }
            else if (job == 4) { mode = 2; src = p.in[21]; ldsrc = DFF; K = D; N = DFF; dst = B.WguT; lddst = D; }
            else if (job == 5) { mode = 3; src = p.in[22]; ldsrc = DFF; K = D; N = DFF; dst = B.WguT; lddst = D; }
            else               { mode = 0; src = p.in[23]; ldsrc = D; K = DFF; N = D; dst = B.WdT; lddst = DFF; }
            xpose_convert(mode, lds, src, ldsrc, K, N, dst, lddst, bx, G, wave_idx_);
        }
        build_wu(p, bx, G, wave_idx_);
        if (bx == 0 && tid < 64) {
            for (int l = 0; l < 2; ++l) { const float* lp = p.in[11] + l * 256;
                const float a = wave_sum(lp[tid] * lp[64 + tid]), c = wave_sum(lp[128 + tid] * lp[192 + tid]);
                if (tid == 0) B.misc[l] = __expf(a) - __expf(c) + (0.8f - 0.6f * __expf(-0.3f * (float)l)); }
        }
        build_rows(p.in[0], p.in[1], p.in[3], B.Hout, B.Hside, B.Ub, bx, G, wave_idx_);
        SEAM(PH_PROLOGUE);
    }
    for (int l = 0; l < 2; ++l) {
        const int pb = PH_LAYER0 + l * PH_PER_LAYER;
        if (IN(pb + PL_NORM1)) { CParams& p = *opaque_params(); auto& B = p.b; const int bx = opq(bx0), G = opq(G0); (void)B; (void)bx; (void)G;
            if (l > 0) norm_rows(B.Hout, B.Hside, p.in[3] + (size_t)l * D, B.Ub, bx, G, wave_idx_);
            SEAM(pb + PL_NORM1);
        }
        if (IN(pb + PL_INPROJ)) { CParams& p = *opaque_params(); auto& B = p.b; const int bx = opq(bx0), G = opq(G0); (void)B; (void)bx; (void)G;
            pg8::StaticOrder S; S.init(MP / 256, 16, G, bx, B.Ub, D, B.WinT + (size_t)l * 4096 * D, D);
            pg8::EpiBf16 E; E.O = B.G1; E.ldc = 1536; E.route = 1;
            E.R[0] = B.G1; E.rld[0] = 1536; E.R[1] = B.G2; E.rld[1] = 512; E.R[2] = B.G3; E.rld[2] = 1536; E.R[3] = B.G4; E.rld[3] = 512;
            E.rt0[0] = 0; E.rt0[1] = 6; E.rt0[2] = 8; E.rt0[3] = 14; E.rt0[4] = 16;
            pg8::gemm_phase<pg8::EpiBf16, pg8::StaticOrder, false>(lds, D, D, S, E, wave_idx_);
            SEAM(pb + PL_INPROJ);
        }
        if (IN(pb + PL_PREP)) { CParams& p = *opaque_params(); auto& B = p.b; const int bx = opq(bx0), G = opq(G0); (void)B; (void)bx; (void)G; prep_rows(p, l, bx, G, wave_idx_); SEAM(pb + PL_PREP); }
        if (IN(pb + PL_MLAUP)) { CParams& p = *opaque_params(); auto& B = p.b; const int bx = opq(bx0), G = opq(G0); (void)B; (void)bx; (void)G;
            pg8::StaticOrder S; S.init(MP / 256, 8, G, bx, B.G4, 512, B.WuT + (size_t)l * 2048 * 384, 384);
            pg8::EpiBf16 E; E.O = B.MLX; E.ldc = 2048; E.route = 0;
            E.R[0] = E.R[1] = E.R[2] = E.R[3] = B.MLX; E.rld[0] = E.rld[1] = E.rld[2] = E.rld[3] = 2048; E.rt0[0] = E.rt0[1] = E.rt0[2] = E.rt0[3] = E.rt0[4] = 0;
            pg8::gemm_phase<pg8::EpiBf16, pg8::StaticOrder, false>(lds, 512, 384, S, E, wave_idx_);
            SEAM(pb + PL_MLAUP);
        }
        if (IN(pb + PL_MLAFIN)) { CParams& p = *opaque_params(); auto& B = p.b; const int bx = opq(bx0), G = opq(G0); (void)B; (void)bx; (void)G; mla_finalize(p, l, bx, G, wave_idx_); SEAM(pb + PL_MLAFIN); }
        if (IN(pb + PL_MIXER)) { CParams& p = *opaque_params(); auto& B = p.b; const int bx = opq(bx0), G = opq(G0); (void)B; (void)bx; (void)G;
            unsigned* qctr = B.ctl + 4096 + l * 256;
            const int n_att = NB * 4 * 17;
            for (int it = bx; it < NB * 8; it += G) dn::dn_item(p, l, it >> 3, (it >> 1) & 3, it & 1, lds, wave_idx_);
            for (;;) {
                __syncthreads();
                if (tid == 0) misc[16] = atomicAdd(qctr, 1u);
                __syncthreads();
                const int u = (int)misc[16];
                if (u >= n_att) break;
                const int qb = u % 17, h = (u / 17) & 3, b = u / 68;
                diff_unit(p, l, b, h, qb, lds, wave_idx_);
            }
            for (;;) {
                __syncthreads();
                if (tid == 0) misc[16] = atomicAdd(qctr + 64, 1u);
                __syncthreads();
                const int u = (int)misc[16];
                if (u >= n_att) break;
                const int qb = u % 17, h = (u / 17) & 3, b = u / 68;
                mla_unit(p, b, h, qb, lds, wave_idx_);
            }
            SEAM(pb + PL_MIXER);
        }
        if (IN(pb + PL_POST)) { CParams& p = *opaque_params(); auto& B = p.b; const int bx = opq(bx0), G = opq(G0); (void)B; (void)bx; (void)G; post_mixer(p, l, bx, G, wave_idx_); SEAM(pb + PL_POST); }
        if (IN(pb + PL_OUTPROJ)) { CParams& p = *opaque_params(); auto& B = p.b; const int bx = opq(bx0), G = opq(G0); (void)B; (void)bx; (void)G;
            pg8::StaticOrder S; S.init(MP / 256, 4, G, bx, B.G1, DMIX, B.WoutT + (size_t)l * D * DMIX, DMIX);
            pg8::EpiResid E; E.Hout = B.Hout; E.Hside = B.Hside;
            pg8::gemm_phase<pg8::EpiResid, pg8::StaticOrder, false>(lds, DMIX, DMIX, S, E, wave_idx_);
            SEAM(pb + PL_OUTPROJ);
        }
        if (IN(pb + PL_NORM2)) { CParams& p = *opaque_params(); auto& B = p.b; const int bx = opq(bx0), G = opq(G0); (void)B; (void)bx; (void)G;
            if (l == 0) norm_rows(B.Hout, B.Hside, p.in[20], B.Ub, bx, G, wave_idx_);
            else {
                for (int job = 0; job < 24; ++job) {
                    const int e = job / 3, kind = job - 3 * e;
                    int mode, ldsrc, K, N, lddst; const float* src; bf16_t* dst;
                    if (kind == 0)      { mode = 2; src = p.in[25] + (size_t)e * D * DFE; ldsrc = DFE; K = D; N = DFE; dst = B.W1T + (size_t)e * 2 * DFE * D; lddst = D; }
                    else if (kind == 1) { mode = 3; src = p.in[26] + (size_t)e * D * DFE; ldsrc = DFE; K = D; N = DFE; dst = B.W1T + (size_t)e * 2 * DFE * D; lddst = D; }
                    else                { mode = 0; src = p.in[27] + (size_t)e * DFE * D; ldsrc = D; K = DFE; N = D; dst = B.W2T + (size_t)e * D * DFE; lddst = DFE; }
                    xpose_convert(mode, lds, src, ldsrc, K, N, dst, lddst, bx, G, wave_idx_);
                }
                __syncthreads();
                norm_router_rows(p, bx, G, lds, wave_idx_);
            }
            SEAM(pb + PL_NORM2); }
        if (l == 0) {
            if (IN(pb + PL_FFN1)) { CParams& p = *opaque_params(); auto& B = p.b; const int bx = opq(bx0), G = opq(G0); (void)B; (void)bx; (void)G;
                pg8::StaticOrder S; S.init(MP / 256, DFF / 128, G, bx, B.Ub, D, B.WguT, D);
                pg8::EpiSwiglu E; E.O = B.ACT; E.ldc = DFF;
                pg8::gemm_phase<pg8::EpiSwiglu, pg8::StaticOrder, false>(lds, D, D, S, E, wave_idx_);
                SEAM(pb + PL_FFN1);
            }
            if (IN(pb + PL_FFN2)) { CParams& p = *opaque_params(); auto& B = p.b; const int bx = opq(bx0), G = opq(G0); (void)B; (void)bx; (void)G;
                pg8::StaticOrder S; S.init(MP / 256, 4, G, bx, B.ACT, DFF, B.WdT, DFF);
                pg8::EpiResid E; E.Hout = B.Hout; E.Hside = B.Hside;
                pg8::gemm_phase<pg8::EpiResid, pg8::StaticOrder, false>(lds, DFF, DFF, S, E, wave_idx_);
                SEAM(pb + PL_FFN2);
            }
        } else {
            for (int hf = 0; hf < NHALF; ++hf) {
                const int po = pb + (hf == 0 ? PL_FFN1 : PL_FFN1B);
                if (IN(po)) { CParams& p = *opaque_params(); auto& B = p.b; const int bx = opq(bx0), G = opq(G0); (void)B; (void)bx; (void)G;
                    pg8::MoeSched S; S.init(B.ctl + CW_MOECNT + hf * 8 * 64, 2 * DFE / 256, G, bx, B.Ub, D, B.W1T, D, (size_t)2 * DFE * D, B.LST + (size_t)hf * 8 * CAP, B.GL + (size_t)hf * 8 * CAP, CAP, 1);
                    pg8::EpiSwiglu E; E.O = B.ACTM; E.ldc = DFE;
                    pg8::gemm_phase<pg8::EpiSwiglu, pg8::MoeSched, true>(lds, D, D, S, E, wave_idx_);
                    SEAM(po);
                }
                if (IN(po + 1)) { CParams& p = *opaque_params(); auto& B = p.b; const int bx = opq(bx0), G = opq(G0); (void)B; (void)bx; (void)G;
                    pg8::MoeSched S; S.init(B.ctl + CW_MOECNT + hf * 8 * 64, D / 256, G, bx, B.ACTM, DFE, B.W2T, DFE, (size_t)D * DFE, B.LST + (size_t)hf * 8 * CAP, B.GL + (size_t)hf * 8 * CAP, CAP, 0);
                    pg8::EpiMoeDown E; E.Hout = B.Hout; E.Hside = B.Hside; E.YS1 = B.YS1; E.b0 = hf * BPH;
                    pg8::gemm_phase<pg8::EpiMoeDown, pg8::MoeSched, false>(lds, DFE, DFE, S, E, wave_idx_);
                    SEAM(po + 1);
                }
                if (IN(po + 2)) { CParams& p = *opaque_params(); const int bx = opq(bx0), G = opq(G0); moe_combine(p, hf, bx, G, wave_idx_); SEAM(po + 2); }
            }
        }
    }
#undef IN
#undef SEAM
}
}
namespace dbg {
__global__ void __launch_bounds__(256) k_cmp(const void* fast, int is_bf16, int ldf, int colf, const float* ref, int ldr, int colr, int cols, float refscale, float* acc, int frow0, int rrow0, int nrows) {
    __shared__ float s0[4], s1[4];
    float d2 = 0.f, r2 = 0.f;
    const size_t n = (size_t)nrows * cols;
    for (size_t i = (size_t)blockIdx.x * blockDim.x + threadIdx.x; i < n; i += (size_t)gridDim.x * blockDim.x) {
        const int pos = (int)(i / cols), c = (int)(i % cols);
        const size_t fo = (size_t)(frow0 + pos) * ldf + colf + c;
        const float a = is_bf16 ? fx::bf2f(((const fx::bf16_t*)fast)[fo]) : ((const float*)fast)[fo];
        const float b = ref[(size_t)(rrow0 + pos) * ldr + colr + c] * refscale;
        d2 += (a - b) * (a - b); r2 += b * b;
    }
    d2 = nv::wave_sum(d2); r2 = nv::wave_sum(r2);
    if ((threadIdx.x & 63) == 0) { s0[threadIdx.x >> 6] = d2; s1[threadIdx.x >> 6] = r2; }
    __syncthreads();
    if (threadIdx.x == 0) { atomicAdd(acc, s0[0] + s0[1] + s0[2] + s0[3]); atomicAdd(acc + 1, s1[0] + s1[1] + s1[2] + s1[3]); }
}
__global__ void k_zero(float* p, int n) { const int i = blockIdx.x * blockDim.x + threadIdx.x; if (i < n) p[i] = 0.f; }
struct Thr { float t[128]; };
__global__ void k_encode(const float* acc, Thr thr, int nchk, float* sx) {
    if (threadIdx.x != 0 || blockIdx.x != 0) return;
    float s = 0.f, X = 0.f;
    for (int k = 0; k < nchk; ++k) {
        const float err = sqrtf(acc[2 * k] / fmaxf(acc[2 * k + 1], 1e-30f));
        const bool bad = !(err <= thr.t[k]);
        if (bad) { s = 0.1f * (float)(k + 1); X = 20.f + 100.f * fminf(err, 2.f); if (!(err == err)) X = 250.f; break; }
    }
    sx[0] = s; sx[1] = X;
}
__global__ void k_write_out_dbg(const float* __restrict__ H, float* __restrict__ out, const float* sx) {
    const size_t n = (size_t)nv::NB * nv::SEQ * nv::D; const float s = sx[0], X = sx[1];
    for (size_t i = (size_t)blockIdx.x * blockDim.x + threadIdx.x; i < n; i += (size_t)gridDim.x * blockDim.x) {
        const int d = (int)(i % nv::D); const size_t r = i / nv::D; const int sq = (int)(r % nv::SEQ), b = (int)(r / nv::SEQ);
        float v = H[((size_t)b * nv::L + nv::NM + sq) * nv::D + d] * (1.f + s);
        if (i == 0 && X != 0.f) v = X;
        out[i] = v;
    }
}
}

struct Region { unsigned char* base; size_t off, cap; };
static void* rtake(Region& r, size_t bytes) { void* p = r.base + r.off; r.off += (bytes + 255) & ~(size_t)255; return p; }

static void carve_fast(fx::Bufs& B, Region& r, float* out) {
    B.Hout = out;
    using namespace fx;
    B.ctl = (unsigned*)rtake(r, 65536);
    B.misc = (float*)rtake(r, 4096);
    B.Hside = (float*)rtake(r, (size_t)(NB * 64 + (MP - NB * LP) + 8) * D * 4);
    B.G1 = (bf16_t*)rtake(r, (size_t)MP * 1536 * 2);
    B.G2 = (bf16_t*)rtake(r, (size_t)MP * 512 * 2);
    B.G4 = (bf16_t*)rtake(r, (size_t)MP * 512 * 2);
    B.ODN = (bf16_t*)rtake(r, (size_t)2 * MP * 512 * 2);
    B.ACT = B.G1;
    B.WinT = (bf16_t*)rtake(r, (size_t)2 * 4096 * 1024 * 2);
    B.WuT = (bf16_t*)rtake(r, (size_t)2 * 2048 * 384 * 2);
    B.WoutT = (bf16_t*)rtake(r, (size_t)2 * 1024 * 1536 * 2);
    B.WguT = (bf16_t*)rtake(r, (size_t)5632 * 1024 * 2);
    B.WdT = (bf16_t*)rtake(r, (size_t)1024 * 2816 * 2);
    B.BG = (float*)rtake(r, (size_t)MP * 16 * 4);
    B.MLX = (bf16_t*)rtake(r, (size_t)MP * 2048 * 2);
    B.Ub = B.MLX;
    B.G3 = (bf16_t*)rtake(r, (size_t)MP * 1536 * 2);
    B.W1T = B.W2T = B.ACTM = B.YS1 = nullptr; B.LST = nullptr; B.GL = nullptr;
}
static void carve_moe_release(fx::Bufs& B, unsigned char* ws, size_t ws_size) {
    using namespace fx;
    unsigned char* a0 = (unsigned char*)B.G1; size_t o = 0;
    B.ACTM = (bf16_t*)(a0 + o); o += (size_t)136 * 256 * DFE * 2;
    B.YS1 = (bf16_t*)(a0 + o); o += (size_t)CAP * D * 2;
    if (a0 + o > (unsigned char*)B.MLX) fprintf(stderr, "moe overlay A too big\n");
    unsigned char* m0 = (unsigned char*)B.MLX + (size_t)MP * D * 2; o = 0;
    B.W2T = (bf16_t*)(m0 + o); o += (size_t)8 * D * DFE * 2;
    B.LST = (int*)(m0 + o); o += (size_t)NHALF * 8 * CAP * 4;
    B.GL = (float*)(m0 + o); o += (size_t)NHALF * 8 * CAP * 4;
    if (m0 + o > (unsigned char*)B.MLX + (size_t)MP * 2048 * 2) fprintf(stderr, "moe overlay MLX too big\n");
    B.W1T = (bf16_t*)B.G3;
    if ((unsigned char*)B.W1T + (size_t)8 * 2 * DFE * D * 2 > ws + ws_size) fprintf(stderr, "moe overlay W1T beyond workspace\n");
}

static int g_grid = 0;
static int fast_setup() {
    if (g_grid) return g_grid;
    int dev = 0, cus = 0, per_cu = 0;
    if (hipGetDevice(&dev) != hipSuccess || hipDeviceGetAttribute(&cus, hipDeviceAttributeMultiprocessorCount, dev) != hipSuccess) { g_grid = -1; return g_grid; }
    if (hipFuncSetAttribute((const void*)fx::mega, hipFuncAttributeMaxDynamicSharedMemorySize, fx::LDS_BYTES) != hipSuccess) { fprintf(stderr, "hipFuncSetAttribute failed\n"); g_grid = -1; return g_grid; }
    if (hipOccupancyMaxActiveBlocksPerMultiprocessor(&per_cu, (const void*)fx::mega, fx::NWG_THREADS, fx::LDS_BYTES) != hipSuccess || per_cu < 1) { fprintf(stderr, "occupancy query: %d\n", per_cu); (void)hipGetLastError(); g_grid = -1; return g_grid; }
    (void)hipGetLastError();
    g_grid = cus;
    return g_grid;
}
static void launch_phases(const fx::Params& p0, int lo, int hi, int fused, hipStream_t stream) {
    fx::Params p = p0; p.ph_lo = lo; p.ph_hi = hi; p.fused = fused; p.pad = 0;
    if (fused) hipMemsetAsync(p.b.ctl, 0, 65536, stream);
    hipLaunchKernelGGL(fx::mega, dim3(g_grid), dim3(fx::NWG_THREADS), fx::LDS_BYTES, stream, p);
}

extern "C" void kernel_launch(void* const* d_in, const int* in_sizes, int n_in, void* d_out, int out_size, void* d_ws, size_t ws_size, hipStream_t stream) {
    if (fast_setup() <= 0) return;
    fx::Params P{};
    for (int i = 0; i < 28; ++i) P.in[i] = (const float*)d_in[i];
    P.out = (float*)d_out;
#if !DEBUG_CHECK
    {
        Region r{(unsigned char*)d_ws, 0, ws_size};
        carve_fast(P.b, r, (float*)d_out);
        if (r.off > ws_size) { fprintf(stderr, "workspace too small: need %zu have %zu\n", r.off, ws_size); return; }
        carve_moe_release(P.b, (unsigned char*)d_ws, ws_size);
        launch_phases(P, 0, fx::PH_END, 1, stream);
    }
#else
    using namespace nv;
    const float* x = (const float*)d_in[0];
    const float* meta = (const float*)d_in[1];
    const float* rel_table = (const float*)d_in[2];
    const float* attn_norm_w = (const float*)d_in[3];
    const float* w_in = (const float*)d_in[4];
    const float* dn_conv_w = (const float*)d_in[5];
    const float* dn_a_log = (const float*)d_in[6];
    const float* dn_dt_bias = (const float*)d_in[7];
    const float* dn_norm_w = (const float*)d_in[8];
    const float* diff_q_norm_w = (const float*)d_in[9];
    const float* diff_k_norm_w = (const float*)d_in[10];
    const float* diff_lambda = (const float*)d_in[11];
    const float* diff_subln_w = (const float*)d_in[12];
    const float* mla_q_lat_norm_w = (const float*)d_in[13];
    const float* mla_w_uq = (const float*)d_in[14];
    const float* mla_kv_lat_norm_w = (const float*)d_in[15];
    const float* mla_w_ukv = (const float*)d_in[16];
    const float* mla_q_norm_w = (const float*)d_in[17];
    const float* mla_k_norm_w = (const float*)d_in[18];
    const float* w_out = (const float*)d_in[19];
    const float* ffn_norm_w = (const float*)d_in[20];
    const float* ffn_w_gate = (const float*)d_in[21];
    const float* ffn_w_up = (const float*)d_in[22];
    const float* ffn_w_down = (const float*)d_in[23];
    const float* router_w = (const float*)d_in[24];
    const float* moe_w_gate = (const float*)d_in[25];
    const float* moe_w_up = (const float*)d_in[26];
    const float* moe_w_down = (const float*)d_in[27];
    float* out = (float*)d_out;

    float* ws = (float*)d_ws; size_t off = 0;
    auto take = [&](size_t n) { float* p = ws + off; off += (n + 63) & ~(size_t)63; return p; };
    float* H = take((size_t)NB * L * D);
    float* U = take((size_t)L * D);
    float* PROJ = take((size_t)L * INC);
    float* QKVC = take((size_t)L * 1536);
    float* BETA = take((size_t)L * 8);
    float* GG = take((size_t)L * 8);
    float* ODN = take((size_t)2 * L * 512);
    float* Y = take((size_t)L * DMIX);
    float* DFQ = take((size_t)L * 512);
    float* DFK = take((size_t)L * 512);
    float* ODF = take((size_t)L * 512);
    float* CQN = take((size_t)L * 256);
    float* CKVN = take((size_t)L * 128);
    float* MLQ = take((size_t)L * 768);
    float* MLKV = take((size_t)L * 1024);
    float* QF = take((size_t)L * 768);
    float* KF = take((size_t)L * 768);
    float* LAM = take(64);
    float* GATE = take((size_t)L * 2);
    int* CNT = (int*)take(64);
    int* LIST = (int*)take((size_t)NE * L);
    float* CHK = take(256);
    float* THR = take(64);
    float* SX = take(64);
    float* S0 = take((size_t)L * L);
    float* S1 = take((size_t)L * L);
    float* FG = S0; float* FU = S1; float* XG = QKVC; float* YE = PROJ; float* YS = PROJ + (size_t)L * D;

    Region rf{(unsigned char*)d_out, (size_t)NBF * fx::SEQ * fx::D * 4, (size_t)out_size * 4};
    carve_fast(P.b, rf, (float*)d_out);
    if (rf.off > (size_t)out_size * 4) { fprintf(stderr, "debug carve too big: %zu\n", rf.off); return; }
    {
        unsigned char* a0 = (unsigned char*)U; size_t o = 0;
        P.b.W1T = (fx::bf16_t*)(a0 + o); o += (size_t)8 * 2 * fx::DFE * fx::D * 2;
        P.b.W2T = (fx::bf16_t*)(a0 + o); o += (size_t)8 * fx::D * fx::DFE * 2;
        if (a0 + o > (unsigned char*)LAM) fprintf(stderr, "debug moe weights overlay too big\n");
        unsigned char* s0 = (unsigned char*)S0; o = 0;
        P.b.ACTM = (fx::bf16_t*)(s0 + o); o += (size_t)48 * 256 * fx::DFE * 2;
        P.b.YS1 = (fx::bf16_t*)(s0 + o); o += (size_t)fx::CAP * fx::D * 2;
        P.b.LST = (int*)(s0 + o); o += (size_t)fx::NHALF * 8 * fx::CAP * 4;
        P.b.GL = (float*)(s0 + o); o += (size_t)fx::NHALF * 8 * fx::CAP * 4;
    }
    hipMemsetAsync(P.b.ctl, 0, 65536, stream);
    dbg::k_zero<<<1, 256, 0, stream>>>(CHK, 256);
    dbg::Thr h_thr{}; int nchk = 0;
    auto chk = [&](const void* fast, int is_bf16, int ldf, int colf, const float* ref, int ldr, int colr, int cols, float refscale, float thr) {
        dbg::k_cmp<<<512, 256, 0, stream>>>(fast, is_bf16, ldf, colf, ref, ldr, colr, cols, refscale, CHK + 2 * nchk, 48, 0, L);
        if (nchk < 127) { h_thr.t[nchk] = thr; ++nchk; }
    };
    auto chkH = [&](const float* Hb, float thr) {
        dbg::k_cmp<<<512, 256, 0, stream>>>(P.b.Hout, 0, 1024, 0, Hb, D, 0, D, 1.f, CHK + 2 * nchk, 0, NM, SEQ);
        if (nchk < 127) { h_thr.t[nchk] = thr; ++nchk; }
    };

    auto gemm = [&](bool tb, const float* A, int lda, const float* B, int ldb, float* C, int ldc, int M, int N, int K, const int* Mdev, int acc) {
        dim3 g((N + 63) / 64, (M + 63) / 64);
        if (tb) k_gemm<true><<<g, 256, 0, stream>>>(A, lda, B, ldb, C, ldc, M, N, K, Mdev, acc);
        else    k_gemm<false><<<g, 256, 0, stream>>>(A, lda, B, ldb, C, ldc, M, N, K, Mdev, acc);
    };
    auto rms = [&](const float* in, int in_ld, float* o, int out_ld, const float* w, int rows, int groups, int n, float scale) {
        const int waves = rows * groups; k_rmsnorm<<<(waves + 3) / 4, 256, 0, stream>>>(in, in_ld, o, out_ld, w, rows, groups, n, scale);
    };
    const int PB0 = fx::PH_LAYER0, PPL = fx::PH_PER_LAYER;
    const int DBG_MAXL = 1; const bool DBG_MOE = true;

    k_build_h<<<2048, 256, 0, stream>>>(x, meta, H);
    launch_phases(P, fx::PH_PROLOGUE, fx::PH_PROLOGUE + 1, 0, stream);
    for (int l = 0; l < 2; ++l) {
        const float lam_init = 0.8f - 0.6f * expf(-0.3f * (float)l);
        k_lam<<<1, 64, 0, stream>>>(diff_lambda + l * 256, lam_init, LAM);
        for (int b = 0; b < NB; ++b) {
            const bool T = (b == 0) && (l <= DBG_MAXL);
            const int pb = PB0 + l * PPL;
            float* Hb = H + (size_t)b * L * D;
            rms(Hb, D, U, D, attn_norm_w + l * D, L, 1, D, 1.f);
            if (T) { if (l > 0) launch_phases(P, pb + fx::PL_NORM1, pb + fx::PL_NORM1 + 1, 0, stream);
                     if (l == 0) chkH(Hb, 1e-5f);
                     chk(P.b.Ub, 1, 1024, 0, U, D, 0, D, 1.f, 0.01f); }
            gemm(false, U, D, w_in + (size_t)l * D * INC, INC, PROJ, INC, L, INC, D, nullptr, 0);
            if (T) { launch_phases(P, pb + fx::PL_INPROJ, pb + fx::PL_INPROJ + 1, 0, stream);
                     chk(P.b.G1, 1, 1536, 0, PROJ, INC, 0, 1536, 1.f, 0.02f);
                     chk(P.b.G2, 1, 512, 0, PROJ, INC, C_DNZ, 512, 1.f, 0.02f);
                     chk(P.b.G3, 1, 1536, 0, PROJ, INC, C_DFQ, 1536, 1.f, 0.02f);
                     chk(P.b.G4, 1, 512, 0, PROJ, INC, C_MLQ, 448, 1.f, 0.02f);
                     chk(P.b.G4, 1, 512, 448, PROJ, INC, C_DNB, 16, 1.f, 0.02f); }
            k_dn_conv<<<2048, 256, 0, stream>>>(PROJ, dn_conv_w + l * 5 * 1536, QKVC);
            k_dn_l2<<<(L * 8 + 3) / 4, 256, 0, stream>>>(QKVC);
            k_dn_bg<<<(L * 8 + 255) / 256, 256, 0, stream>>>(PROJ, dn_a_log + l * 8, dn_dt_bias + l * 8, BETA, GG);
            k_dn_scan<<<8, 128, 0, stream>>>(QKVC, BETA, GG, ODN);
            k_dn_out<<<(L * 4 + 3) / 4, 256, 0, stream>>>(ODN, PROJ, dn_norm_w + l * 128, Y);
            rms(PROJ + C_DFQ, INC, DFQ, 512, diff_q_norm_w + l * 64, L, 8, 64, 1.f);
            rms(PROJ + C_DFK, INC, DFK, 512, diff_k_norm_w + l * 64, L, 8, 64, 1.f);
            for (int h = 0; h < 4; ++h) {
                gemm(true, DFQ + h * 128, 512, DFK + h * 128, 512, S0, L, L, L, 64, nullptr, 0);
                gemm(true, DFQ + h * 128 + 64, 512, DFK + h * 128 + 64, 512, S1, L, L, L, 64, nullptr, 0);
                k_diff_softmax<<<L, 256, 0, stream>>>(S0, S1, rel_table, h, LAM);
                gemm(false, S0, L, PROJ + C_DFV + h * 128, INC, ODF + h * 128, 512, L, 128, L, nullptr, 0);
            }
            rms(ODF, 512, Y + 512, DMIX, diff_subln_w + l * 128, L, 4, 128, 1.f - lam_init);
            rms(PROJ + C_MLQ, INC, CQN, 256, mla_q_lat_norm_w + l * 256, L, 1, 256, 1.f);
            rms(PROJ + C_MLKV, INC, CKVN, 128, mla_kv_lat_norm_w + l * 128, L, 1, 128, 1.f);
            gemm(false, CQN, 256, mla_w_uq + (size_t)l * 256 * 768, 768, MLQ, 768, L, 768, 256, nullptr, 0);
            gemm(false, CKVN, 128, mla_w_ukv + (size_t)l * 128 * 1024, 1024, MLKV, 1024, L, 1024, 128, nullptr, 0);
            k_mla_prep<<<(L * 8 + 3) / 4, 256, 0, stream>>>(MLQ, MLKV, PROJ, mla_q_norm_w + l * 192, mla_k_norm_w + l * 192, QF, KF);
            if (T) {
                launch_phases(P, pb + fx::PL_PREP, pb + fx::PL_PREP + 1, 0, stream);
                chk(P.b.G3, 1, 1536, 0, DFQ, 512, 0, 512, fx::DIFF_QSCALE, 0.02f);
                chk(P.b.G3, 1, 1536, 512, DFK, 512, 0, 512, 1.f, 0.02f);
                chk(P.b.G4, 1, 512, 0, CQN, 256, 0, 256, 1.f, 0.02f);
                chk(P.b.G4, 1, 512, 256, CKVN, 128, 0, 128, 1.f, 0.02f);
                chk(P.b.BG, 0, 16, 0, BETA, 8, 0, 8, 1.f, 0.02f);
                chk(P.b.BG, 0, 16, 8, GG, 8, 0, 8, 1.f, 0.02f);
                launch_phases(P, pb + fx::PL_MLAUP, pb + fx::PL_MLAFIN + 1, 1, stream);
                for (int h = 0; h < 4; ++h) {
                    chk(P.b.MLX, 1, 2048, 256 * h, QF, 768, 192 * h, 192, fx::MLA_QSCALE, 0.03f);
                    chk(P.b.MLX, 1, 2048, 256 * h + 192, KF, 768, 192 * h + 128, 64, 1.f, 0.03f);
                    chk(P.b.MLX, 1, 2048, 1024 + 256 * h, KF, 768, 192 * h, 128, 1.f, 0.03f);
                    chk(P.b.MLX, 1, 2048, 1024 + 256 * h + 128, MLKV, 1024, 256 * h + 128, 128, 1.f, 0.03f);
                }
            }
            for (int h = 0; h < 4; ++h) {
                gemm(true, QF + h * 192, 768, KF + h * 192, 768, S0, L, L, L, 192, nullptr, 0);
                k_softmax<<<L, 256, 0, stream>>>(S0, 0.07216878364870322f);
                gemm(false, S0, L, MLKV + h * 256 + 128, 1024, Y + 1024 + h * 128, DMIX, L, 128, L, nullptr, 0);
            }
            if (T) {
                launch_phases(P, pb + fx::PL_MIXER, pb + fx::PL_MIXER + 1, 1, stream);
                chk(P.b.ODN, 1, 512, 0, ODN, 512, 0, 512, 1.f, 0.03f);
                chk(P.b.ODN + (size_t)fx::MP * 512, 1, 512, 0, ODN + (size_t)L * 512, 512, 0, 512, 1.f, 0.03f);
                chk(P.b.G3, 1, 1536, 0, ODF, 512, 0, 512, 1.f, 0.03f);
                for (int h = 0; h < 4; ++h) chk(P.b.MLX, 1, 2048, 256 * h, Y, DMIX, 1024 + 128 * h, 128, 1.f, 0.03f);
            }
            if (T) { launch_phases(P, pb + fx::PL_POST, pb + fx::PL_POST + 1, 0, stream);
                     chk(P.b.G1, 1, 1536, 0, Y, DMIX, 0, 512, 1.f, 0.03f); chk(P.b.G1, 1, 1536, 512, Y, DMIX, 512, 512, 1.f, 0.03f); chk(P.b.G1, 1, 1536, 1024, Y, DMIX, 1024, 512, 1.f, 0.03f); }
            gemm(false, Y, DMIX, w_out + (size_t)l * DMIX * D, D, Hb, D, L, D, DMIX, nullptr, 1);
            if (T) { launch_phases(P, pb + fx::PL_OUTPROJ, pb + fx::PL_OUTPROJ + 1, 0, stream); chkH(Hb, 0.01f); }
            rms(Hb, D, U, D, ffn_norm_w + l * D, L, 1, D, 1.f);
            if (l == 0) {
                gemm(false, U, D, ffn_w_gate, DFF, FG, DFF, L, DFF, D, nullptr, 0);
                gemm(false, U, D, ffn_w_up, DFF, FU, DFF, L, DFF, D, nullptr, 0);
                k_swiglu_act<<<2048, 256, 0, stream>>>(FG, FU, DFF, DFF, L, nullptr);
                if (T) { launch_phases(P, pb + fx::PL_NORM2, pb + fx::PL_FFN1 + 1, 1, stream); chk(P.b.ACT, 1, DFF, 0, FG, DFF, 0, DFF, 1.f, 0.03f); }
                gemm(false, FG, DFF, ffn_w_down, D, Hb, D, L, D, DFF, nullptr, 1);
                if (T) { launch_phases(P, pb + fx::PL_FFN2, pb + fx::PL_FFN2 + 1, 0, stream); chkH(Hb, 0.01f); }
            } else {
                k_zero_int<<<1, 64, 0, stream>>>(CNT, 64);
                k_router<<<(L + 3) / 4, 256, 0, stream>>>(U, router_w, CNT, LIST, GATE);
                for (int e = 0; e < NE; ++e) {
                    k_gather<<<1024, 256, 0, stream>>>(U, LIST + e * L, CNT + e, XG);
                    gemm(false, XG, D, moe_w_gate + (size_t)e * D * DFE, DFE, FG, DFE, L, DFE, D, CNT + e, 0);
                    gemm(false, XG, D, moe_w_up + (size_t)e * D * DFE, DFE, FU, DFE, L, DFE, D, CNT + e, 0);
                    k_swiglu_act<<<2048, 256, 0, stream>>>(FG, FU, DFE, DFE, L, CNT + e);
                    gemm(false, FG, DFE, moe_w_down + (size_t)e * DFE * D, D, YE, D, L, D, DFE, CNT + e, 0);
                    k_scatter<<<1024, 256, 0, stream>>>(YE, LIST + e * L, CNT + e, YS);
                }
                k_moe_combine<<<2048, 256, 0, stream>>>(Hb, YS, GATE);
                if (T && DBG_MOE) { launch_phases(P, pb + fx::PL_NORM2, pb + fx::PL_COMB + 1, 1, stream); chkH(Hb, 0.02f); }
            }
        }
    }
    dbg::k_encode<<<1, 64, 0, stream>>>(CHK, h_thr, nchk, SX);
    dbg::k_write_out_dbg<<<2048, 256, 0, stream>>>(H, out, SX);
#endif
}
```

```cpp
#include <hip/hip_runtime.h>
#include <stdint.h>
#include <stdio.h>

#ifndef DEBUG_CHECK
#define DEBUG_CHECK 0
#endif
#if DEBUG_CHECK
#define NBF 1
#else
#define NBF 8
#endif

#ifndef PROBE
#define PROBE 0
#endif
#ifndef PROBE_A
#define PROBE_A 0
#define PROBE_B 0
#define PROBE_C 0
#define PROBE_D 0
#endif

#ifndef ATT_EXPERIMENT
#define ATT_EXPERIMENT 0
#endif
namespace nv {
constexpr int NB = 8, SEQ = 4096, NM = 16, L = 4112, D = 1024, INC = 4048, DMIX = 1536, DFF = 2816, NE = 8, DFE = 3584;
constexpr int C_DNQ = 0, C_DNK = 512, C_DNV = 1024, C_DNZ = 1536, C_DNB = 2048, C_DNA = 2056, C_DFQ = 2064, C_DFK = 2576, C_DFV = 3088,
              C_MLQ = 3600, C_MLKV = 3856, C_MLKR = 3984;
constexpr float EPS = 1e-6f;

__device__ __forceinline__ float siluf(float x) { return x / (1.f + expf(-x)); }
__device__ __forceinline__ float wave_sum(float v) {
#pragma unroll
    for (int o = 32; o > 0; o >>= 1) v += __shfl_xor(v, o);
    return v;
}
__device__ __forceinline__ float wave_max(float v) {
#pragma unroll
    for (int o = 32; o > 0; o >>= 1) v = fmaxf(v, __shfl_xor(v, o));
    return v;
}

template <bool TB>
__global__ void __launch_bounds__(256) k_gemm(const float* __restrict__ A, int lda, const float* __restrict__ B, int ldb, float* __restrict__ C, int ldc,
                                              int M, int N, int K, const int* Mdev, int accumulate) {
    if (Mdev) M = *Mdev;
    const int bm = blockIdx.y * 64, bn = blockIdx.x * 64;
    if (bm >= M) return;
    __shared__ float As[16][65], Bs[16][65];
    const int tx = threadIdx.x & 15, ty = threadIdx.x >> 4;
    float acc[4][4];
#pragma unroll
    for (int i = 0; i < 4; ++i)
#pragma unroll
        for (int j = 0; j < 4; ++j) acc[i][j] = 0.f;
    for (int k0 = 0; k0 < K; k0 += 16) {
#pragma unroll
        for (int i = 0; i < 4; ++i) {
            const int idx = threadIdx.x + i * 256;
            { const int r = idx >> 4, kk = idx & 15; As[kk][r] = (bm + r < M && k0 + kk < K) ? A[(size_t)(bm + r) * lda + k0 + kk] : 0.f; }
            if (TB) { const int n = idx >> 4, kk = idx & 15; Bs[kk][n] = (bn + n < N && k0 + kk < K) ? B[(size_t)(bn + n) * ldb + k0 + kk] : 0.f; }
            else    { const int kk = idx >> 6, n = idx & 63; Bs[kk][n] = (bn + n < N && k0 + kk < K) ? B[(size_t)(k0 + kk) * ldb + bn + n] : 0.f; }
        }
        __syncthreads();
#pragma unroll
        for (int kk = 0; kk < 16; ++kk) {
            float a[4], b[4];
#pragma unroll
            for (int i = 0; i < 4; ++i) { a[i] = As[kk][ty * 4 + i]; b[i] = Bs[kk][tx * 4 + i]; }
#pragma unroll
            for (int i = 0; i < 4; ++i)
#pragma unroll
                for (int j = 0; j < 4; ++j) acc[i][j] = fmaf(a[i], b[j], acc[i][j]);
        }
        __syncthreads();
    }
#pragma unroll
    for (int i = 0; i < 4; ++i)
#pragma unroll
        for (int j = 0; j < 4; ++j) {
            const int r = bm + ty * 4 + i, c = bn + tx * 4 + j;
            if (r < M && c < N) { float* p = C + (size_t)r * ldc + c; *p = accumulate ? (*p + acc[i][j]) : acc[i][j]; }
        }
}

__global__ void k_build_h(const float* __restrict__ x, const float* __restrict__ meta, float* __restrict__ H) {
    const size_t n = (size_t)NB * L * D;
    for (size_t i = (size_t)blockIdx.x * blockDim.x + threadIdx.x; i < n; i += (size_t)gridDim.x * blockDim.x) {
        const int d = (int)(i % D); const size_t r = i / D; const int t = (int)(r % L), b = (int)(r / L);
        H[i] = t < NM ? meta[t * D + d] : x[((size_t)b * SEQ + (t - NM)) * D + d];
    }
}
__global__ void k_write_out(const float* __restrict__ H, float* __restrict__ out) {
    const size_t n = (size_t)NB * SEQ * D;
    for (size_t i = (size_t)blockIdx.x * blockDim.x + threadIdx.x; i < n; i += (size_t)gridDim.x * blockDim.x) {
        const int d = (int)(i % D); const size_t r = i / D; const int s = (int)(r % SEQ), b = (int)(r / SEQ);
        out[i] = H[((size_t)b * L + NM + s) * D + d];
    }
}

__global__ void __launch_bounds__(256) k_rmsnorm(const float* __restrict__ in, int in_ld, float* __restrict__ out, int out_ld, const float* __restrict__ w,
                                                 int rows, int groups, int n, float scale) {
    const int wid = (blockIdx.x * blockDim.x + threadIdx.x) >> 6, lane = threadIdx.x & 63;
    if (wid >= rows * groups) return;
    const int r = wid / groups, g = wid % groups;
    const float* p = in + (size_t)r * in_ld + g * n; float* q = out + (size_t)r * out_ld + g * n;
    float ss = 0.f;
    for (int i = lane; i < n; i += 64) { const float v = p[i]; ss += v * v; }
    ss = wave_sum(ss);
    const float rs = rsqrtf(ss / (float)n + EPS) * scale;
    for (int i = lane; i < n; i += 64) q[i] = p[i] * rs * w[i];
}

__global__ void k_dn_conv(const float* __restrict__ proj, const float* __restrict__ cw, float* __restrict__ qkvc) {
    const int n = L * 1536;
    for (int i = blockIdx.x * blockDim.x + threadIdx.x; i < n; i += gridDim.x * blockDim.x) {
        const int c = i % 1536, t = i / 1536; float a = 0.f;
#pragma unroll
        for (int j = 0; j < 5; ++j) { const int tt = t + j - 2; if (tt >= 0 && tt < L) a += proj[(size_t)tt * INC + c] * cw[j * 1536 + c]; }
        qkvc[i] = siluf(a);
    }
}
__global__ void __launch_bounds__(256) k_dn_l2(float* __restrict__ qkvc) {
    const int wid = (blockIdx.x * blockDim.x + threadIdx.x) >> 6, lane = threadIdx.x & 63;
    if (wid >= L * 8) return;
    const int t = wid / 8, g = wid % 8;
    float* p = qkvc + (size_t)t * 1536 + g * 128;
    const float a = p[lane], b = p[lane + 64];
    const float ss = wave_sum(a * a + b * b);
    const float rs = rsqrtf(ss + EPS) * (g < 4 ? 0.08838834764831845f : 1.f);
    p[lane] = a * rs; p[lane + 64] = b * rs;
}
__global__ void k_dn_bg(const float* __restrict__ proj, const float* __restrict__ a_log, const float* __restrict__ dt_bias, float* __restrict__ beta, float* __restrict__ g) {
    const int n = L * 8;
    for (int i = blockIdx.x * blockDim.x + threadIdx.x; i < n; i += gridDim.x * blockDim.x) {
        const int j = i % 8, t = i / 8;
        const float bl = proj[(size_t)t * INC + C_DNB + j], al = proj[(size_t)t * INC + C_DNA + j] + dt_bias[j];
        beta[i] = 1.f / (1.f + expf(-bl));
        const float sp = al > 20.f ? al : log1pf(expf(al));
        g[i] = -expf(a_log[j]) * sp;
    }
}
__global__ void __launch_bounds__(128) k_dn_scan(const float* __restrict__ qkvc, const float* __restrict__ beta, const float* __restrict__ g, float* __restrict__ odn) {
    const int j = blockIdx.x, dir = j >> 2, h = j & 3, e = threadIdx.x;
    __shared__ float sq[16][128], sk[16][128];
    __shared__ float sb[16], sg[16];
    float S[128];
#pragma unroll
    for (int d = 0; d < 128; ++d) S[d] = 0.f;
    float* o = odn + (size_t)dir * L * 512;
    for (int i0 = 0; i0 < L; i0 += 16) {
        __syncthreads();
        float vv[16];
#pragma unroll
        for (int s = 0; s < 16; ++s) {
            const int i = i0 + s; const int t = (dir == 0 || i < NM) ? i : (L + NM - 1 - i);
            sq[s][e] = qkvc[(size_t)t * 1536 + h * 128 + e];
            sk[s][e] = qkvc[(size_t)t * 1536 + 512 + h * 128 + e];
            vv[s] = qkvc[(size_t)t * 1536 + 1024 + h * 128 + e];
            if (e == 0) { sb[s] = beta[t * 8 + j]; sg[s] = g[t * 8 + j]; }
        }
        __syncthreads();
#pragma unroll
        for (int s = 0; s < 16; ++s) {
            const int i = i0 + s; const int t = (dir == 0 || i < NM) ? i : (L + NM - 1 - i);
            const float al = expf(sg[s]), be = sb[s];
            float r = 0.f;
#pragma unroll
            for (int d = 0; d < 128; ++d) { S[d] *= al; r = fmaf(sk[s][d], S[d], r); }
            const float vn = be * (vv[s] - r);
            float oo = 0.f;
#pragma unroll
            for (int d = 0; d < 128; ++d) { S[d] = fmaf(sk[s][d], vn, S[d]); oo = fmaf(sq[s][d], S[d], oo); }
            o[(size_t)t * 512 + h * 128 + e] = oo;
        }
    }
}
__global__ void __launch_bounds__(256) k_dn_out(const float* __restrict__ odn, const float* __restrict__ proj, const float* __restrict__ w, float* __restrict__ y) {
    const int wid = (blockIdx.x * blockDim.x + threadIdx.x) >> 6, lane = threadIdx.x & 63;
    if (wid >= L * 4) return;
    const int t = wid / 4, h = wid % 4;
    const size_t o = (size_t)t * 512 + h * 128;
    const float a = odn[o + lane] + odn[(size_t)L * 512 + o + lane], b = odn[o + lane + 64] + odn[(size_t)L * 512 + o + lane + 64];
    const float ss = wave_sum(a * a + b * b);
    const float rs = rsqrtf(ss / 128.f + EPS);
    const float z0 = proj[(size_t)t * INC + C_DNZ + h * 128 + lane], z1 = proj[(size_t)t * INC + C_DNZ + h * 128 + lane + 64];
    y[(size_t)t * DMIX + h * 128 + lane] = a * rs * w[lane] * siluf(z0);
    y[(size_t)t * DMIX + h * 128 + lane + 64] = b * rs * w[lane + 64] * siluf(z1);
}

__device__ __forceinline__ int t5_bucket(int rel) {
    const int n = rel < 0 ? -rel : rel;
    int f;
    if (n < 8) f = n; else if (n < 12) f = 8; else if (n < 16) f = 9; else if (n < 23) f = 10; else if (n < 32) f = 11;
    else if (n < 46) f = 12; else if (n < 64) f = 13; else if (n < 91) f = 14; else f = 15;
    return (rel > 0 ? 16 : 0) + f;
}
__global__ void k_lam(const float* __restrict__ lp, float lam_init, float* __restrict__ lam) {
    const int lane = threadIdx.x;
    const float a = wave_sum(lp[lane] * lp[64 + lane]), b = wave_sum(lp[128 + lane] * lp[192 + lane]);
    if (lane == 0) *lam = expf(a) - expf(b) + lam_init;
}
__device__ __forceinline__ float block_max(float v, float* sm) {
    v = wave_max(v); const int w = threadIdx.x >> 6;
    __syncthreads(); if ((threadIdx.x & 63) == 0) sm[w] = v; __syncthreads();
    return fmaxf(fmaxf(sm[0], sm[1]), fmaxf(sm[2], sm[3]));
}
__device__ __forceinline__ float block_sum(float v, float* sm) {
    v = wave_sum(v); const int w = threadIdx.x >> 6;
    __syncthreads(); if ((threadIdx.x & 63) == 0) sm[w] = v; __syncthreads();
    return sm[0] + sm[1] + sm[2] + sm[3];
}
__global__ void __launch_bounds__(256) k_diff_softmax(float* __restrict__ S0, const float* __restrict__ S1, const float* __restrict__ table, int h, const float* __restrict__ lamp) {
    __shared__ float sm[4];
    const int i = blockIdx.x; const float lam = *lamp;
    float* r0 = S0 + (size_t)i * L; const float* r1 = S1 + (size_t)i * L;
    float m0 = -3e38f, m1 = -3e38f;
    for (int jx = threadIdx.x; jx < L; jx += 256) { const float bz = table[t5_bucket(jx - i) * 4 + h]; m0 = fmaxf(m0, r0[jx] * 0.125f + bz); m1 = fmaxf(m1, r1[jx] * 0.125f + bz); }
    m0 = block_max(m0, sm); m1 = block_max(m1, sm);
    float s0 = 0.f, s1 = 0.f;
    for (int jx = threadIdx.x; jx < L; jx += 256) { const float bz = table[t5_bucket(jx - i) * 4 + h]; s0 += expf(r0[jx] * 0.125f + bz - m0); s1 += expf(r1[jx] * 0.125f + bz - m1); }
    s0 = block_sum(s0, sm); s1 = block_sum(s1, sm);
    const float i0 = 1.f / s0, i1 = 1.f / s1;
    for (int jx = threadIdx.x; jx < L; jx += 256) { const float bz = table[t5_bucket(jx - i) * 4 + h];
        r0[jx] = expf(r0[jx] * 0.125f + bz - m0) * i0 - lam * expf(r1[jx] * 0.125f + bz - m1) * i1; }
}
__global__ void __launch_bounds__(256) k_softmax(float* __restrict__ S0, float scale) {
    __shared__ float sm[4];
    float* r0 = S0 + (size_t)blockIdx.x * L;
    float m0 = -3e38f;
    for (int jx = threadIdx.x; jx < L; jx += 256) m0 = fmaxf(m0, r0[jx] * scale);
    m0 = block_max(m0, sm);
    float s0 = 0.f;
    for (int jx = threadIdx.x; jx < L; jx += 256) s0 += expf(r0[jx] * scale - m0);
    s0 = block_sum(s0, sm);
    const float i0 = 1.f / s0;
    for (int jx = threadIdx.x; jx < L; jx += 256) r0[jx] = expf(r0[jx] * scale - m0) * i0;
}
__global__ void __launch_bounds__(256) k_mla_prep(const float* __restrict__ mlq, const float* __restrict__ mlkv, const float* __restrict__ proj,
                                                  const float* __restrict__ qw, const float* __restrict__ kw, float* __restrict__ qf, float* __restrict__ kf) {
    const int wid = (blockIdx.x * blockDim.x + threadIdx.x) >> 6, lane = threadIdx.x & 63;
    if (wid >= L * 8) return;
    const int t = wid / 8, h = (wid % 8) >> 1, which = wid & 1;
    float v[3];
    if (which == 0) { v[0] = mlq[(size_t)t * 768 + h * 192 + lane]; v[1] = mlq[(size_t)t * 768 + h * 192 + 64 + lane]; v[2] = mlq[(size_t)t * 768 + h * 192 + 128 + lane]; }
    else { v[0] = mlkv[(size_t)t * 1024 + h * 256 + lane]; v[1] = mlkv[(size_t)t * 1024 + h * 256 + 64 + lane]; v[2] = proj[(size_t)t * INC + C_MLKR + lane]; }
    const float ss = wave_sum(v[0] * v[0] + v[1] * v[1] + v[2] * v[2]);
    const float rs = rsqrtf(ss / 192.f + EPS);
    const float* w = which == 0 ? qw : kw;
#pragma unroll
    for (int c = 0; c < 3; ++c) v[c] = v[c] * rs * w[c * 64 + lane];
    const int i = lane & 31;
    const float inv = 1.0f / powf(10000.0f, (float)i / 32.0f);
    const float ang = (float)t * inv;
    const float cs = cosf(ang), sn = sinf(ang);
    const float other = __shfl_xor(v[2], 32);
    const float rv = lane < 32 ? (v[2] * cs - other * sn) : (other * sn + v[2] * cs);
    float* o = (which == 0 ? qf : kf) + (size_t)t * 768 + h * 192;
    o[lane] = v[0]; o[64 + lane] = v[1]; o[128 + lane] = rv;
}

__global__ void k_swiglu_act(float* __restrict__ G, const float* __restrict__ U, int ld, int cols, int rows, const int* rowsdev) {
    if (rowsdev) rows = *rowsdev;
    const size_t n = (size_t)rows * cols;
    for (size_t i = (size_t)blockIdx.x * blockDim.x + threadIdx.x; i < n; i += (size_t)gridDim.x * blockDim.x) {
        const size_t r = i / cols, c = i % cols; const size_t o = r * ld + c;
        G[o] = siluf(G[o]) * U[o];
    }
}
__global__ void k_zero_int(int* p, int n) { const int i = blockIdx.x * blockDim.x + threadIdx.x; if (i < n) p[i] = 0; }
__global__ void __launch_bounds__(256) k_router(const float* __restrict__ U, const float* __restrict__ rw, int* __restrict__ cnt, int* __restrict__ list, float* __restrict__ gate) {
    const int t = (blockIdx.x * blockDim.x + threadIdx.x) >> 6, lane = threadIdx.x & 63;
    if (t >= L) return;
    float lg[NE];
#pragma unroll
    for (int e = 0; e < NE; ++e) lg[e] = 0.f;
    for (int d = lane; d < D; d += 64) { const float u = U[(size_t)t * D + d];
#pragma unroll
        for (int e = 0; e < NE; ++e) lg[e] = fmaf(u, rw[d * NE + e], lg[e]); }
#pragma unroll
    for (int e = 0; e < NE; ++e) lg[e] = wave_sum(lg[e]);
    if (lane == 0) {
        int i0 = 0; float v0 = lg[0];
#pragma unroll
        for (int e = 1; e < NE; ++e) if (lg[e] > v0) { v0 = lg[e]; i0 = e; }
        int i1 = -1; float v1 = -3e38f;
#pragma unroll
        for (int e = 0; e < NE; ++e) if (e != i0 && lg[e] > v1) { v1 = lg[e]; i1 = e; }
        const float e1 = expf(v1 - v0), g0 = 1.f / (1.f + e1), g1 = e1 / (1.f + e1);
        gate[t * 2] = g0; gate[t * 2 + 1] = g1;
        const int p0 = atomicAdd(&cnt[i0], 1); list[i0 * L + p0] = t * 2;
        const int p1 = atomicAdd(&cnt[i1], 1); list[i1 * L + p1] = t * 2 + 1;
    }
}
__global__ void k_gather(const float* __restrict__ U, const int* __restrict__ list, const int* __restrict__ cnt, float* __restrict__ X) {
    const int n = *cnt;
    for (size_t i = (size_t)blockIdx.x * blockDim.x + threadIdx.x; i < (size_t)n * D; i += (size_t)gridDim.x * blockDim.x) {
        const int r = (int)(i / D), d = (int)(i % D); X[i] = U[(size_t)(list[r] >> 1) * D + d];
    }
}
__global__ void k_scatter(const float* __restrict__ Y, const int* __restrict__ list, const int* __restrict__ cnt, float* __restrict__ YS) {
    const int n = *cnt;
    for (size_t i = (size_t)blockIdx.x * blockDim.x + threadIdx.x; i < (size_t)n * D; i += (size_t)gridDim.x * blockDim.x) {
        const int r = (int)(i / D), d = (int)(i % D); YS[(size_t)list[r] * D + d] = Y[i];
    }
}
__global__ void k_moe_combine(float* __restrict__ H, const float* __restrict__ YS, const float* __restrict__ gate) {
    const size_t n = (size_t)L * D;
    for (size_t i = (size_t)blockIdx.x * blockDim.x + threadIdx.x; i < n; i += (size_t)gridDim.x * blockDim.x) {
        const size_t t = i / D, d = i % D;
        H[i] = H[i] + (gate[t * 2] * YS[(t * 2) * D + d] + gate[t * 2 + 1] * YS[(t * 2 + 1) * D + d]);
    }
}
}
namespace fx {
typedef unsigned short bf16_t;
typedef short bf16x8 __attribute__((ext_vector_type(8)));
typedef short s16x4 __attribute__((ext_vector_type(4)));
typedef float f32x4 __attribute__((ext_vector_type(4)));
typedef float f32x16 __attribute__((ext_vector_type(16)));
typedef unsigned u32x4 __attribute__((ext_vector_type(4)));
typedef unsigned u32x2 __attribute__((ext_vector_type(2)));
#define LAS __attribute__((address_space(3)))

constexpr int NB = NBF, SEQ = 4096, NM = 16, L = 4112, LP = 4160, PADF = 48, D = 1024, DMIX = 1536, DFF = 2816, NE = 8, DFE = 3584;
constexpr int MP = ((NB * LP + 255) / 256) * 256;
constexpr int NWG_THREADS = 512;
constexpr int LDS_MISC_OFF = 160384;
constexpr float EPS = 1e-6f;

#define XB_TMO      128
#define XB_XCNT(j)  (256  + 64 * (j))
#define XB_XSUB(j)  (1280 + 64 * (j))
#define XB_XGEN(j)  (2304 + 64 * (j))
#define XB_TOP      3328
#define XB_TOPGEN   3392
#define XCD_BAR_WORDS 3456
#define XB_SPIN_CAP (1u << 18)
__device__ __forceinline__ unsigned xb_ld(unsigned* p)              { return __hip_atomic_load(p, __ATOMIC_RELAXED, __HIP_MEMORY_SCOPE_AGENT); }
__device__ __forceinline__ unsigned xb_add(unsigned* p, unsigned v) { return __hip_atomic_fetch_add(p, v, __ATOMIC_RELAXED, __HIP_MEMORY_SCOPE_AGENT); }
__device__ __forceinline__ unsigned xb_xcc_id() { return (unsigned)__builtin_amdgcn_s_getreg((3 << 11) | 20) & 0xFu; }
#define XB_SPIN(cond, bar) do { unsigned _sp = 0; while (cond) { __builtin_amdgcn_s_sleep(1); \
    if ((++_sp & 255u) == 0u) { if (xb_ld(&(bar)[XB_TMO])) break; if (_sp > XB_SPIN_CAP) { atomicAdd(&(bar)[XB_TMO], 1u); break; } } } } while (0)
struct XcdBarrier { unsigned* bar; unsigned x; volatile LAS unsigned* st; };
__device__ __forceinline__ XcdBarrier xcd_barrier_post(unsigned* bar, volatile LAS unsigned* st) {
    XcdBarrier b; b.bar = bar; b.x = xb_xcc_id(); b.st = st;
    if (threadIdx.x == 0) (void)xb_add(&bar[XB_XCNT(b.x)], 1u);
    return b;
}
__device__ __forceinline__ void xcd_barrier_complete(unsigned* bar, unsigned x, unsigned& nloc, unsigned& nx) {
    const unsigned G = gridDim.x * gridDim.y * gridDim.z;
    unsigned sum, cnt, mine, sp = 0u;
    for (;;) {
        sum = 0u; cnt = 0u; mine = 0u;
#pragma unroll
        for (unsigned j = 0; j < 16; ++j) { const unsigned c = xb_ld(&bar[XB_XCNT(j)]); sum += c; cnt += (c > 0u) ? 1u : 0u; mine = (j == x) ? c : mine; }
        if (sum == G) break;
        __builtin_amdgcn_s_sleep(1);
        if ((++sp & 255u) == 0u) { if (xb_ld(&bar[XB_TMO])) break; if (sp > XB_SPIN_CAP) { atomicAdd(&bar[XB_TMO], 1u); break; } }
    }
    nloc = mine > 0u ? mine : 1u; nx = cnt > 0u ? cnt : 1u;
}
__device__ __forceinline__ void xcd_barrier(const XcdBarrier& b) {
    asm volatile("s_waitcnt vmcnt(0)" ::: "memory");
    __syncthreads();
    if (threadIdx.x == 0) {
        unsigned* bar = b.bar;
        __builtin_amdgcn_s_waitcnt(0);
        unsigned nloc = b.st[0], nx = b.st[1];
        if (nloc == 0u) { xcd_barrier_complete(bar, b.x, nloc, nx); b.st[0] = nloc; b.st[1] = nx; }
        const unsigned old = xb_add(&bar[XB_XSUB(b.x)], 1u);
        const unsigned gen = old / nloc;
        if (old + 1u == (gen + 1u) * nloc) {
            __builtin_amdgcn_fence(__ATOMIC_RELEASE, "agent");
            asm volatile("s_waitcnt vmcnt(0)" ::: "memory");
            const unsigned og = xb_add(&bar[XB_TOP], 1u);
            const unsigned tg = og / nx;
            if (og + 1u == (tg + 1u) * nx) xb_add(&bar[XB_TOPGEN], 1u);
            else XB_SPIN(xb_ld(&bar[XB_TOPGEN]) == tg, bar);
            __builtin_amdgcn_fence(__ATOMIC_ACQUIRE, "agent");
            xb_add(&bar[XB_XGEN(b.x)], 1u);
            asm volatile("s_waitcnt vmcnt(0)" ::: "memory");
        } else {
            XB_SPIN(xb_ld(&bar[XB_XGEN(b.x)]) == gen, bar);
            __builtin_amdgcn_fence(__ATOMIC_ACQUIRE, "agent");
            asm volatile("s_waitcnt vmcnt(0)" ::: "memory");
        }
    }
    __syncthreads();
}

__device__ __forceinline__ int lane_id() { int l; asm volatile("v_mbcnt_lo_u32_b32 %0, -1, 0\n\tv_mbcnt_hi_u32_b32 %0, -1, %0" : "=v"(l)); return l; }
__device__ int g_dummy_never_used;
#define fresh_tid() (wave_idx_ * 64 + lane_id())
typedef __bf16 bf16x2_t __attribute__((ext_vector_type(2)));
typedef float f32x2_t __attribute__((ext_vector_type(2)));
__device__ __forceinline__ unsigned cvt_pk_bf16(float lo, float hi) { const f32x2_t v = {lo, hi}; const bf16x2_t b = __builtin_convertvector(v, bf16x2_t); return __builtin_bit_cast(unsigned, b); }
__device__ __forceinline__ bf16_t f2bf(float f) { return (bf16_t)(cvt_pk_bf16(f, 0.f) & 0xFFFFu); }
__device__ __forceinline__ float bf2f(bf16_t b) { return __uint_as_float(((unsigned)b) << 16); }
__device__ __forceinline__ float bflo(unsigned u) { return __uint_as_float(u << 16); }
__device__ __forceinline__ float bfhi(unsigned u) { return __uint_as_float(u & 0xFFFF0000u); }
__device__ __forceinline__ float siluf(float x) { return x / (1.f + __expf(-x)); }
template <int M> __device__ __forceinline__ float shx(float v) {
    if constexpr (M < 32) return __int_as_float(__builtin_amdgcn_ds_swizzle(__float_as_int(v), (M << 10) | 0x1f));
    else { const int l = lane_id(); return __int_as_float(__builtin_amdgcn_ds_bpermute((l ^ 32) << 2, __float_as_int(v))); }
}
__device__ __forceinline__ float wave_sum(float v) {
    v += shx<32>(v); v += shx<16>(v); v += shx<8>(v); v += shx<4>(v); v += shx<2>(v); v += shx<1>(v);
    return v;
}
__device__ __forceinline__ float* hf_row(float* Hout, float* Hside, int row) {
    if (row >= NB * LP) return Hside + (size_t)(NB * 64 + (row - NB * LP)) * D;
    const int b = row / LP, lp = row - b * LP;
    return lp >= 64 ? Hout + ((size_t)b * SEQ + (lp - 64)) * D : Hside + (size_t)(b * 64 + lp) * D;
}
__device__ __forceinline__ bool row_valid(int row) {
    const int lp = row % LP; return row < NB * LP && lp >= PADF;
}

struct Bufs {
    unsigned* ctl;
    float* Hout;
    float* Hside;
    bf16_t* Ub;
    bf16_t* G1;
    bf16_t* G2;
    bf16_t* G3;
    bf16_t* G4;
    bf16_t* MLX;
    bf16_t* ODN;
    float* BG;
    bf16_t* ACT;
    bf16_t* WinT;
    bf16_t* WuT;
    bf16_t* WoutT;
    bf16_t* WguT;
    bf16_t* WdT;
    float* misc;
    float* PART;
    bf16_t* W1T;
    bf16_t* W2T;
    bf16_t* ACTM;
    bf16_t* YS1;
    int* LST;
    float* GL;
    float* PK;
};
struct Params {
    const float* in[28];
    float* out;
    Bufs b;
    int ph_lo, ph_hi, fused, pad;
    int kcap, pad2;
    int nmm_out, nmm_ffn;
};
typedef const __attribute__((address_space(4))) Params CParams;
__device__ __forceinline__ CParams* opaque_params() {
    CParams* q = (CParams*)__builtin_amdgcn_kernarg_segment_ptr();
    asm volatile("" : "+s"(q));
    return q;
}

namespace pg8 {
constexpr int BM = 256, BK = 64, HALF = 128, HTB = HALF * BK * 2, STAGE_BYTES = 8 * HTB, NXCD = 8, WGM = 8;
__host__ __device__ __forceinline__ int lds_byte(int r, int c) { const int st = (r >> 4) * 2 + (c >> 5), rr = r & 15, cc = c & 31, ob = rr * 64 + cc * 2; return st * 1024 + (ob ^ (((ob >> 9) & 1) << 5)); }
__host__ __device__ __forceinline__ void stage_rc(int b, int& R, int& C) { const int st = b / 1024, sb = b % 1024, swz = sb ^ (((sb >> 9) & 1) << 5); R = (st >> 1) * 16 + swz / 64; C = (st & 1) * 32 + (swz % 64) / 2; }
__host__ __device__ __forceinline__ int perm32(int rho) { const int n = rho >> 4, i = rho & 15; return 8 * (i >> 2) + 4 * n + (i & 3); }

struct Unit { int pm, pn; const char* A; const char* B; const int* rows; const float* gates; int valid, orow0, nt, part, kw, kb, kf; };

struct StaticOrder {
    int nM, nN, nwg, G, c, ntk; const char* A; const char* B; size_t tstepA, tstepB;
    __device__ void init(int nM_, int nN_, int G_, int c_, const void* A_, int lda, const void* B_, int K) {
        nM = nM_; nN = nN_; nwg = nM * nN; G = G_; c = c_; ntk = K / BK; A = (const char*)A_; B = (const char*)B_; tstepA = (size_t)BM * lda * 2; tstepB = (size_t)BM * K * 2; }
    __device__ bool next(int i, Unit& u) const {
        const long Lx = (long)i * G + c; if (Lx >= nwg) return false;
        int wgid = (int)Lx; { const int q = nwg / NXCD, r = nwg % NXCD, xcd = wgid % NXCD, off = wgid / NXCD; wgid = (xcd < r ? xcd * (q + 1) : r * (q + 1) + (xcd - r) * q) + off; }
        const int nig = WGM * nN, gid = wgid / nig, fm = gid * WGM, gsz = (nM - fm) < WGM ? (nM - fm) : WGM;
        u.pm = fm + ((wgid % nig) % gsz); u.pn = (wgid % nig) / gsz; u.A = A + (size_t)u.pm * tstepA; u.B = B + (size_t)u.pn * tstepB; u.rows = nullptr; u.gates = nullptr; u.valid = BM; u.orow0 = u.pm * BM; u.nt = ntk; u.part = -1; return true;
    }
};


__host__ __device__ __forceinline__ int tail_main_tiles(int nM, int nN, int G, int ntk, int split) {
    if (nM * nN > G) { const int r = (nM * nN) % G, tm = (r + nN - 1) / nN; if (r > 0 && ((nM - tm) * nN) % G == 0 && ntk % split == 0 && (ntk / split) % 2 == 0) return nM - tm; }
    return nM;
}
struct TailOrder {
    int nMm, tailM, nN, G, c, ntk, SPLIT; const char* A; const char* B; size_t tstepA, tstepB;
    __device__ void init(int nM, int nN_, int G_, int c_, const void* A_, int lda, const void* B_, int K, int split, int nmm) {
        nN = nN_; G = G_; c = c_; ntk = K / BK; SPLIT = split; A = (const char*)A_; B = (const char*)B_; tstepA = (size_t)BM * lda * 2; tstepB = (size_t)BM * K * 2;
        nMm = nmm; tailM = nM - nMm;
    }
    __device__ bool next(int i, Unit& u) const {
        const int nmain = nMm * nN; const long Lx = (long)i * G + c;
        u.rows = nullptr; u.gates = nullptr; u.valid = BM;
        if (Lx < nmain) {
            int wgid = (int)Lx; { const int q = nmain / NXCD, r = nmain % NXCD, xcd = wgid % NXCD, off = wgid / NXCD; wgid = (xcd < r ? xcd * (q + 1) : r * (q + 1) + (xcd - r) * q) + off; }
            const int nig = WGM * nN, gid = wgid / nig, fm = gid * WGM, gsz = (nMm - fm) < WGM ? (nMm - fm) : WGM;
            u.pm = fm + ((wgid % nig) % gsz); u.pn = (wgid % nig) / gsz; u.A = A + (size_t)u.pm * tstepA; u.B = B + (size_t)u.pn * tstepB; u.nt = ntk; u.part = -1; u.orow0 = u.pm * BM; return true;
        }
        const int q = (int)(Lx - nmain); if (q >= tailM * nN * SPLIT) return false;
        const int tu = q / SPLIT, sp = q - tu * SPLIT, nts = ntk / SPLIT;
        u.pm = nMm + tu / nN; u.pn = tu % nN; u.nt = nts; u.part = q; u.orow0 = u.pm * BM;
        u.A = A + (size_t)u.pm * tstepA + (size_t)sp * nts * (BK * 2); u.B = B + (size_t)u.pn * tstepB + (size_t)sp * nts * (BK * 2);
        return true;
    }
};

template <class Epi, class Sched, bool GATHER>
__device__ __forceinline__ void gemm_phase(LAS unsigned char* lds, const int lda, const int K, const Sched& S, const Epi& E, const int wave_idx_) {
    int tid_ = fresh_tid(); asm volatile("" : "+v"(tid_));
    const int tid = tid_, wid = __builtin_amdgcn_readfirstlane(tid >> 6), lane = tid & 63, wr = wid >> 2, wc = wid & 3, fr = lane & 15, fq = lane >> 4;
    unsigned voffB[2];
#pragma unroll
    for (int i = 0; i < 2; ++i) { int R, C; stage_rc(tid * 16 + i * 8192, R, C); const int Rb = Epi::PERM ? ((R & ~31) + perm32(R & 31)) : R;
        voffB[i] = (unsigned)(Rb * K + C) * 2u; }
    const size_t kstep = (size_t)(BK * 2);
    const size_t hstepB = (size_t)HALF * K * 2;
    const unsigned ldsw = (unsigned)wid * 1024u;
    const int aoff = lds_byte(wr * 64 + fr, fq * 8), boff = lds_byte(wc * 32 + fr, fq * 8);
#define PG8_SA(b, h) (((b) * 2 + (h)) * HTB)
#define PG8_SB(b, h) ((4 + (b) * 2 + (h)) * HTB)
#define PG8_STAGE(bufoff, gbase, voff) do { _Pragma("unroll") for (int _i = 0; _i < 2; ++_i) \
        __builtin_amdgcn_global_load_lds((const unsigned*)((const char*)(gbase) + (voff)[_i]), (LAS unsigned*)(lds + (bufoff) + ldsw + _i * 8192), 16, 0, 0); } while (0)
#define PG8_LDA(dst, b, h) do { _Pragma("unroll") for (int m = 0; m < 4; ++m) _Pragma("unroll") for (int k = 0; k < 2; ++k) dst[m][k] = *(const LAS bf16x8*)(lds + PG8_SA(b, h) + aoff + m * 2048 + k * 1024); } while (0)
#define PG8_LDB(dst, b, h) do { _Pragma("unroll") for (int n = 0; n < 2; ++n) _Pragma("unroll") for (int k = 0; k < 2; ++k) dst[n][k] = *(const LAS bf16x8*)(lds + PG8_SB(b, h) + boff + n * 2048 + k * 1024); } while (0)
#define PG8_MMA(ai, bj, At, Bt) do { __builtin_amdgcn_s_setprio(1); _Pragma("unroll") for (int m = 0; m < 4; ++m) _Pragma("unroll") for (int n = 0; n < 2; ++n) _Pragma("unroll") for (int k = 0; k < 2; ++k) \
        acc[ai][bj][m][n] = __builtin_amdgcn_mfma_f32_16x16x32_bf16(Bt[n][k], At[m][k], acc[ai][bj][m][n], 0, 0, 0); __builtin_amdgcn_s_setprio(0); } while (0)
#define PG8_WAIT_V(n) asm volatile("s_waitcnt vmcnt(" #n ")" ::: "memory")
#define PG8_WAIT_L(n) asm volatile("s_waitcnt lgkmcnt(" #n ")" ::: "memory")
#define PG8_BAR __builtin_amdgcn_s_barrier()
#define PG8_SCHED __builtin_amdgcn_sched_barrier(0)
#define PG8_SETOFF(u, o0, o1) do { int t2_ = tid; asm volatile("" : "+v"(t2_)); _Pragma("unroll") for (int _i = 0; _i < 2; ++_i) { int R_, C_; stage_rc(t2_ * 16 + _i * 8192, R_, C_); \
        if (GATHER) { const int r0_ = R_ < (u).valid ? ((u).rows[R_] >> 1) : 0, r1_ = R_ + HALF < (u).valid ? ((u).rows[R_ + HALF] >> 1) : 0; \
            o0[_i] = (unsigned)r0_ * (unsigned)(lda * 2) + (unsigned)C_ * 2u; o1[_i] = (unsigned)r1_ * (unsigned)(lda * 2) + (unsigned)C_ * 2u; } \
        else { o0[_i] = (unsigned)(R_ * lda + C_) * 2u; o1[_i] = o0[_i] + (unsigned)(HALF * lda * 2); } } } while (0)
    Unit cur, nxt; int ui = 0;
    if (!S.next(0, cur)) return;
    f32x4 acc[2][2][4][2];
#pragma unroll
    for (int a = 0; a < 2; ++a)
#pragma unroll
        for (int b = 0; b < 2; ++b)
#pragma unroll
            for (int m = 0; m < 4; ++m)
#pragma unroll
                for (int n = 0; n < 2; ++n) acc[a][b][m][n] = (f32x4){0.f, 0.f, 0.f, 0.f};
    bf16x8 At[4][2], B0[2][2], B1[2][2];
    unsigned vA0[2], vA1[2];
    LAS unsigned* rowbuf = (LAS unsigned*)(lds + LDS_MISC_OFF + 1024);
    PG8_SETOFF(cur, vA0, vA1);
    const char* cA = cur.A; const char* cB = cur.B;
    PG8_STAGE(PG8_SB(0, 0), cB, voffB); PG8_STAGE(PG8_SA(0, 0), cA, vA0); PG8_STAGE(PG8_SB(0, 1), cB + hstepB, voffB); PG8_STAGE(PG8_SA(0, 1), cA, vA1);
    if (wr == 1) PG8_BAR;
    PG8_WAIT_V(4); PG8_BAR;
    PG8_STAGE(PG8_SB(1, 0), cB + kstep, voffB); PG8_STAGE(PG8_SA(1, 0), cA + kstep, vA0); PG8_STAGE(PG8_SB(1, 1), cB + hstepB + kstep, voffB);
    PG8_WAIT_V(6); PG8_BAR;
    for (;;) {
        const bool has_next = S.next(ui + 1, nxt);
        if (GATHER && has_next && wid < 4) {
            __builtin_amdgcn_global_load_lds((const unsigned*)(nxt.rows + lane + wid * 64), (LAS unsigned*)(rowbuf + wid * 64), 4, 0, 0); }
        const char* nA = has_next ? nxt.A : cA; const char* nB = has_next ? nxt.B : cB;
        const int nt = cur.nt;
        for (int t = 0; t < nt; t += 2) {
            const bool last = (t == nt - 2);
            const char* a1 = cA + (size_t)(t + 1) * kstep;
            const char* a2 = last ? nA : cA + (size_t)(t + 2) * kstep; const char* b2 = last ? nB : cB + (size_t)(t + 2) * kstep;
            const char* a3 = a2 + kstep; const char* b3 = b2 + kstep;
            PG8_LDB(B0, 0, 0); PG8_SCHED; PG8_LDA(At, 0, 0); PG8_STAGE(PG8_SA(1, 1), a1, vA1);
            PG8_WAIT_L(8); PG8_BAR; PG8_WAIT_L(0); PG8_MMA(0, 0, At, B0); PG8_BAR; PG8_SCHED;
            if (GATHER && last && has_next) {
                int t4_ = tid; asm volatile("" : "+v"(t4_));
                _Pragma("unroll") for (int _i = 0; _i < 2; ++_i) { int R_, C_; stage_rc(t4_ * 16 + _i * 8192, R_, C_); vA0[_i] = (R_ < nxt.valid ? (rowbuf[R_] >> 1) : 0u) * (unsigned)(lda * 2) + (unsigned)C_ * 2u; vA1[_i] = (R_ + HALF < nxt.valid ? (rowbuf[R_ + HALF] >> 1) : 0u) * (unsigned)(lda * 2) + (unsigned)C_ * 2u; }
            }
            PG8_LDB(B1, 0, 1); PG8_STAGE(PG8_SB(0, 0), b2, voffB);
            PG8_BAR; PG8_WAIT_L(0); PG8_MMA(0, 1, At, B1); PG8_BAR;
            PG8_LDA(At, 0, 1); PG8_STAGE(PG8_SA(0, 0), a2, vA0);
            PG8_BAR; PG8_WAIT_L(0); PG8_MMA(1, 0, At, B0); PG8_BAR; PG8_SCHED;
            PG8_STAGE(PG8_SB(0, 1), b2 + hstepB, voffB);
            PG8_WAIT_V(6); PG8_BAR; PG8_MMA(1, 1, At, B1); PG8_BAR;
            PG8_LDB(B0, 1, 0); PG8_SCHED; PG8_LDA(At, 1, 0); PG8_STAGE(PG8_SA(0, 1), a2, vA1);
            PG8_WAIT_L(8); PG8_BAR; PG8_WAIT_L(0); PG8_MMA(0, 0, At, B0); PG8_BAR; PG8_SCHED;
            PG8_LDB(B1, 1, 1); PG8_STAGE(PG8_SB(1, 0), b3, voffB);
            PG8_BAR; PG8_WAIT_L(0); PG8_MMA(0, 1, At, B1); PG8_BAR;
            PG8_LDA(At, 1, 1); PG8_STAGE(PG8_SA(1, 0), a3, vA0);
            PG8_BAR; PG8_WAIT_L(0); PG8_MMA(1, 0, At, B0); PG8_BAR; PG8_SCHED;
            PG8_STAGE(PG8_SB(1, 1), b3 + hstepB, voffB);
            PG8_WAIT_V(6); PG8_BAR; PG8_MMA(1, 1, At, B1); PG8_BAR;
        }
        E(acc, cur, wr, wc, fr, fq);
        if (!has_next) break;
#pragma unroll
        for (int a = 0; a < 2; ++a)
#pragma unroll
            for (int b = 0; b < 2; ++b)
#pragma unroll
                for (int m = 0; m < 4; ++m)
#pragma unroll
                    for (int n = 0; n < 2; ++n) acc[a][b][m][n] = (f32x4){0.f, 0.f, 0.f, 0.f};
        cur = nxt; cA = nA; cB = nB; ++ui;
    }
    PG8_WAIT_V(0);
    if (wr == 0) PG8_BAR;
    PG8_BAR;
#undef PG8_SA
#undef PG8_SB
#undef PG8_STAGE
#undef PG8_LDA
#undef PG8_LDB
#undef PG8_MMA
#undef PG8_WAIT_V
#undef PG8_WAIT_L
#undef PG8_BAR
#undef PG8_SCHED
#undef PG8_SETOFF
}

struct EpiBf16 {
    static constexpr bool PERM = true;
    bf16_t* O; int ldc;
    bf16_t* R[4]; int rld[4]; int rt0[5];
    int route;
    __device__ __forceinline__ void operator()(const f32x4 (&acc)[2][2][4][2], const Unit& u, int wr, int wc, int fr, int fq) const {
        asm volatile("" : "+v"(fr), "+v"(fq));
        const int row0 = u.pm * BM + wr * 64 + fr; bf16_t* base = O + (size_t)u.pn * BM; int ld = ldc;
        if (route) {
#pragma unroll
            for (int k = 0; k < 4; ++k) if (u.pn >= rt0[k] && u.pn < rt0[k + 1]) { base = R[k] + (size_t)(u.pn - rt0[k]) * BM; ld = rld[k]; }
        }
        const int col0 = wc * 32 + 8 * fq;
#pragma unroll
        for (int ai = 0; ai < 2; ++ai)
#pragma unroll
            for (int m = 0; m < 4; ++m) { bf16_t* rowp = base + (size_t)(row0 + ai * HALF + m * 16) * ld + col0;
#pragma unroll
                for (int bj = 0; bj < 2; ++bj) { const f32x4 v0 = acc[ai][bj][m][0], v1 = acc[ai][bj][m][1];
                    u32x4 w = {cvt_pk_bf16(v0[0], v0[1]), cvt_pk_bf16(v0[2], v0[3]), cvt_pk_bf16(v1[0], v1[1]), cvt_pk_bf16(v1[2], v1[3])};
                    *(u32x4*)(rowp + bj * HALF) = w; } }
    }
};
struct EpiResid {
    static constexpr bool PERM = false;
    float* Hout; float* Hside; float* PART;
    __device__ __forceinline__ void operator()(const f32x4 (&acc)[2][2][4][2], const Unit& u, int wr, int wc, int fr, int fq) const {
        asm volatile("" : "+v"(fr), "+v"(fq));
        if (u.part >= 0) {
            float* base = PART + (size_t)u.part * (BM * BM) + (size_t)(wr * 64 + fr) * BM + wc * 32 + 4 * fq;
#pragma unroll
            for (int ai = 0; ai < 2; ++ai)
#pragma unroll
                for (int m = 0; m < 4; ++m)
#pragma unroll
                    for (int bj = 0; bj < 2; ++bj)
#pragma unroll
                        for (int n = 0; n < 2; ++n) *(f32x4*)(base + (size_t)(ai * HALF + m * 16) * BM + bj * HALF + n * 16) = acc[ai][bj][m][n];
            return;
        }
        const int row0 = u.pm * BM + wr * 64 + fr, col0 = u.pn * BM + wc * 32 + 4 * fq;
#pragma unroll
        for (int ai = 0; ai < 2; ++ai)
#pragma unroll
            for (int m = 0; m < 4; ++m) { const int row = row0 + ai * HALF + m * 16; if (!row_valid(row)) continue;
                float* rowp = hf_row(Hout, Hside, row) + col0;
#pragma unroll
                for (int bj = 0; bj < 2; ++bj)
#pragma unroll
                    for (int n = 0; n < 2; ++n) { f32x4* p = (f32x4*)(rowp + bj * HALF + n * 16); *p = *p + acc[ai][bj][m][n]; } }
    }
};
struct EpiSwiglu {
    static constexpr bool PERM = true;
    bf16_t* O; int ldc;
    __device__ __forceinline__ void operator()(const f32x4 (&acc)[2][2][4][2], const Unit& u, int wr, int wc, int fr, int fq) const {
        asm volatile("" : "+v"(fr), "+v"(fq));
        const int row0 = u.orow0 + wr * 64 + fr, col0 = u.pn * HALF + wc * 32 + 8 * fq;
#pragma unroll
        for (int ai = 0; ai < 2; ++ai)
#pragma unroll
            for (int m = 0; m < 4; ++m) { bf16_t* rowp = O + (size_t)(row0 + ai * HALF + m * 16) * ldc + col0;
                float r[8];
#pragma unroll
                for (int n = 0; n < 2; ++n)
#pragma unroll
                    for (int j = 0; j < 4; ++j) r[n * 4 + j] = siluf(acc[ai][0][m][n][j]) * acc[ai][1][m][n][j];
                u32x4 w = {cvt_pk_bf16(r[0], r[1]), cvt_pk_bf16(r[2], r[3]), cvt_pk_bf16(r[4], r[5]), cvt_pk_bf16(r[6], r[7])};
                *(u32x4*)rowp = w; }
    }
};

struct MoeSched {
    int G, c, nN, cap, gather, ntk, kcap; unsigned pc[4], pt[2]; const char* A; const char* B; size_t tstepA, tstepB, estepB; const int* lst; const float* gl;
    __device__ void init(const unsigned* cntw, int nN_, int G_, int c_, const void* A_, int lda, const void* B_, int K, size_t estep_elems, const int* lst_, const float* gl_, int cap_, int gather_, int kcap_ = 0) {
        kcap = kcap_;
        { const unsigned c0 = cntw[0], c1 = cntw[64], c2 = cntw[128], c3 = cntw[192], c4 = cntw[256], c5 = cntw[320], c6 = cntw[384], c7 = cntw[448];
          const unsigned t1 = (c0 + 255) >> 8, t2 = t1 + ((c1 + 255) >> 8), t3 = t2 + ((c2 + 255) >> 8), t4 = t3 + ((c3 + 255) >> 8), t5 = t4 + ((c4 + 255) >> 8), t6 = t5 + ((c5 + 255) >> 8), t7 = t6 + ((c6 + 255) >> 8), nM = t7 + ((c7 + 255) >> 8);
          pc[0] = c0 | (c1 << 16); pc[1] = c2 | (c3 << 16); pc[2] = c4 | (c5 << 16); pc[3] = c6 | (c7 << 16);
          pt[0] = t1 | (t2 << 8) | (t3 << 16) | (t4 << 24); pt[1] = t5 | (t6 << 8) | (t7 << 16) | (nM << 24); } nN = nN_; G = G_; c = c_; ntk = K / BK; A = (const char*)A_; B = (const char*)B_; tstepA = (size_t)BM * lda * 2; tstepB = (size_t)BM * K * 2; estepB = estep_elems * 2; lst = lst_; gl = gl_; cap = cap_; gather = gather_;
    }
    __device__ bool next(int i, Unit& u) const {
        const int c0 = pc[0] & 0xFFFF, c1 = pc[0] >> 16, c2 = pc[1] & 0xFFFF, c3 = pc[1] >> 16, c4 = pc[2] & 0xFFFF, c5 = pc[2] >> 16, c6 = pc[3] & 0xFFFF, c7 = pc[3] >> 16;
        const int t1 = pt[0] & 255, t2 = (pt[0] >> 8) & 255, t3 = (pt[0] >> 16) & 255, t4 = pt[0] >> 24, t5 = pt[1] & 255, t6 = (pt[1] >> 8) & 255, t7 = (pt[1] >> 16) & 255, nM = pt[1] >> 24;
        const int nwg = nM * nN;
        int S = 1, full = 0, tail = 0;
        if (kcap > 0) { full = nwg / G; tail = nwg - full * G;
            if (tail > 0) { if (ntk % 14 == 0 && tail * 7 <= G && tail * 7 <= kcap) S = 7; else if (ntk % 8 == 0 && tail * 4 <= G && tail * 4 <= kcap) S = 4; else if (ntk % 4 == 0 && tail * 2 <= G && tail * 2 <= kcap) S = 2; } }
        long Lx; int sj = 0, st = 0;
        if (i < 0) { if (S == 1 || c >= tail) return false; st = c; Lx = (long)full * G + st; }
        else if (S == 1) { Lx = (long)i * G + c; if (Lx >= nwg) return false; }
        else if (i < full) Lx = (long)i * G + c;
        else if (i == full && c < tail * S) { st = c / S; sj = c - st * S; Lx = (long)full * G + st; }
        else return false;
        int wgid = (int)Lx; { const int q = nwg / NXCD, r = nwg % NXCD, xcd = wgid % NXCD, off = wgid / NXCD; wgid = (xcd < r ? xcd * (q + 1) : r * (q + 1) + (xcd - r) * q) + off; }
        const int nig = WGM * nN, gid = wgid / nig, fm = gid * WGM, gsz = (nM - fm) < WGM ? (nM - fm) : WGM;
        const int pm = fm + ((wgid % nig) % gsz), pn = (wgid % nig) / gsz;
        const int e = (pm >= t1) + (pm >= t2) + (pm >= t3) + (pm >= t4) + (pm >= t5) + (pm >= t6) + (pm >= t7);
        const int tb = e == 0 ? 0 : e == 1 ? t1 : e == 2 ? t2 : e == 3 ? t3 : e == 4 ? t4 : e == 5 ? t5 : e == 6 ? t6 : t7;
        const int ce = e == 0 ? c0 : e == 1 ? c1 : e == 2 ? c2 : e == 3 ? c3 : e == 4 ? c4 : e == 5 ? c5 : e == 6 ? c6 : c7;
        const int m = pm - tb, rem = ce - m * BM;
        u.pm = pm; u.pn = pn; u.valid = rem < BM ? rem : BM; u.orow0 = pm * BM;
        u.rows = lst + (size_t)e * cap + m * BM; u.gates = gl + (size_t)e * cap + m * BM;
        u.A = gather ? A : A + (size_t)pm * tstepA; u.B = B + (size_t)e * estepB + (size_t)pn * tstepB; u.nt = ntk; u.part = -1; u.kw = S; u.kb = tail;
        if (S > 1 && (i == full || i < 0)) { const int nts = ntk / S; const size_t ko = (size_t)sj * nts * (BK * 2); u.nt = nts; u.A += ko; u.B += ko; u.part = st * S + sj; }
        return true;
    }
};
struct EpiMoeDown {
    static constexpr bool PERM = false;
    float* Hout; float* Hside; bf16_t* YS1; int b0;
    float* PK;
    __device__ __forceinline__ void operator()(const f32x4 (&acc)[2][2][4][2], const Unit& u, int wr, int wc, int fr, int fq) const {
        asm volatile("" : "+v"(fr), "+v"(fq));
        if (u.part >= 0) {
            float* base = PK + (size_t)u.part * (BM * BM) + (size_t)(wr * 64 + fr) * BM + wc * 32 + 4 * fq;
#pragma unroll
            for (int ai = 0; ai < 2; ++ai)
#pragma unroll
                for (int m = 0; m < 4; ++m)
#pragma unroll
                    for (int bj = 0; bj < 2; ++bj)
#pragma unroll
                        for (int n = 0; n < 2; ++n) *(f32x4*)(base + (size_t)(ai * HALF + m * 16) * BM + bj * HALF + n * 16) = acc[ai][bj][m][n];
            return;
        }
        const int col0 = u.pn * BM + wc * 32 + 4 * fq;
#pragma unroll
        for (int ai = 0; ai < 2; ++ai)
#pragma unroll
            for (int m = 0; m < 4; ++m) { const int rl = ai * HALF + wr * 64 + m * 16 + fr; if (rl >= u.valid) continue;
                const int entry = u.rows[rl]; const float g = u.gates[rl]; const int row = entry >> 1;
                if ((entry & 1) == 0) { float* rowp = hf_row(Hout, Hside, row) + col0;
#pragma unroll
                    for (int bj = 0; bj < 2; ++bj)
#pragma unroll
                        for (int n = 0; n < 2; ++n) { f32x4* p = (f32x4*)(rowp + bj * HALF + n * 16); *p = *p + acc[ai][bj][m][n] * g; }
                } else { const int b = row / LP, lp = row - b * LP; bf16_t* rowp = YS1 + ((size_t)(b - b0) * L + (lp - PADF)) * D + col0;
#pragma unroll
                    for (int bj = 0; bj < 2; ++bj)
#pragma unroll
                        for (int n = 0; n < 2; ++n) { const f32x4 v = acc[ai][bj][m][n] * g; *(u32x2*)(rowp + bj * HALF + n * 16) = (u32x2){cvt_pk_bf16(v[0], v[1]), cvt_pk_bf16(v[2], v[3])}; }
                } }
    }
};
__device__ __forceinline__ void moe_tail_fixup(const MoeSched& S0, float* Hout, float* Hside, bf16_t* YS1, int b0, const float* PK, int bx, int G, const int wave_idx_) {
    const int tid = fresh_tid(), lane = tid & 63, wv = tid >> 6;
    MoeSched S = S0; S.c = 0; Unit u;
    if (!S.next(-1, u)) return;
    const int tail = u.kb, ns = u.kw, bpu = G / tail;
    const int t = bx / bpu, sl = bx - t * bpu; if (t >= tail) return;
    S.c = t; if (!S.next(-1, u)) return;
    const int rpb = (BM + bpu - 1) / bpu, r0 = sl * rpb, r1 = (r0 + rpb < u.valid) ? r0 + rpb : u.valid;
    const float* pk = PK + (size_t)(t * ns) * (BM * BM);
    for (int rl = r0 + wv; rl < r1; rl += 8) {
        f32x4 v = *(const f32x4*)(pk + (size_t)rl * BM + 4 * lane);
        for (int s = 1; s < ns; ++s) v += *(const f32x4*)(pk + (size_t)s * (BM * BM) + (size_t)rl * BM + 4 * lane);
        const int entry = u.rows[rl]; const float g = u.gates[rl]; const int row = entry >> 1; v = v * g;
        if ((entry & 1) == 0) { f32x4* p = (f32x4*)(hf_row(Hout, Hside, row) + u.pn * BM + 4 * lane); *p = *p + v; }
        else { const int b = row / LP, lp = row - b * LP; *(u32x2*)(YS1 + ((size_t)(b - b0) * L + (lp - PADF)) * D + u.pn * BM + 4 * lane) = (u32x2){cvt_pk_bf16(v[0], v[1]), cvt_pk_bf16(v[2], v[3])}; }
    }
}
}

__device__ __forceinline__ int inproj_src_col(int n) {
    if (n < 2048) return n;
    if (n < 3584) return 2064 + (n - 2048);
    if (n < 3840) return 3600 + (n - 3584);
    if (n < 3968) return 3856 + (n - 3840);
    if (n < 4032) return 3984 + (n - 3968);
    if (n < 4048) return 2048 + (n - 4032);
    return -1;
}
__device__ __forceinline__ void xpose_tile(const int MODE, LAS bf16_t* tile, const int tid, const float* __restrict__ src, int ldsrc, int N, bf16_t* __restrict__ dst, int lddst, int n0, int k0) {
    {
        const int kp = tid >> 3, nn = (tid & 7) * 8;
        const int n = n0 + nn;
        int sc = n; if (MODE == 1) sc = inproj_src_col(n);
        f32x4 a0 = {0.f, 0.f, 0.f, 0.f}, a1 = a0, b0 = a0, b1 = a0;
        if (sc >= 0 && n < N) { const float* p0 = src + (size_t)(k0 + 2 * kp) * ldsrc + sc;
            a0 = *(const f32x4*)p0; a1 = *(const f32x4*)(p0 + 4); b0 = *(const f32x4*)(p0 + ldsrc); b1 = *(const f32x4*)(p0 + ldsrc + 4); }
#pragma unroll
        for (int j = 0; j < 4; ++j) { *(LAS unsigned*)(tile + (nn + j) * 136 + 2 * kp) = cvt_pk_bf16(a0[j], b0[j]); *(LAS unsigned*)(tile + (nn + 4 + j) * 136 + 2 * kp) = cvt_pk_bf16(a1[j], b1[j]); }
    }
    __syncthreads();
    {
        const int nn = tid >> 3, kc = (tid & 7) * 16; const int n = n0 + nn;
        if (n < N || MODE == 1) {
            int dr = n; if (MODE == 2) dr = (n >> 7) * 256 + (n & 127); if (MODE == 3) dr = (n >> 7) * 256 + 128 + (n & 127);
            const u32x4 w0 = *(const LAS u32x4*)(tile + nn * 136 + kc), w1 = *(const LAS u32x4*)(tile + nn * 136 + kc + 8);
            bf16_t* q = dst + (size_t)dr * lddst + k0 + kc;
            *(u32x4*)q = w0; *(u32x4*)(q + 8) = w1;
        }
    }
    __syncthreads();
}
__device__ __forceinline__ void xpose_convert(const int MODE, LAS unsigned char* lds, const float* __restrict__ src, int ldsrc, int K, int N, bf16_t* __restrict__ dst, int lddst, int wg, int nwg, const int wave_idx_) {
    LAS bf16_t* tile = (LAS bf16_t*)lds;
    int tid_ = fresh_tid(); asm volatile("" : "+v"(tid_));
    const int tid = tid_, ntn = (N + 63) / 64, ntk = K / 128, ntiles = ntn * ntk;
    for (int t = wg; t < ntiles; t += nwg) xpose_tile(MODE, tile, tid, src, ldsrc, N, dst, lddst, (t % ntn) * 64, (t / ntn) * 128);
}
__device__ __forceinline__ void moe_convert_queue(CParams& p, LAS unsigned char* lds, volatile LAS unsigned* misc, const int wave_idx_) {
    auto& B = p.b;
    LAS bf16_t* tile = (LAS bf16_t*)lds;
    int tid_ = fresh_tid(); asm volatile("" : "+v"(tid_));
    const int tid = tid_;
    constexpr int TOTAL = 24 * 448, BATCH = 4;
    for (;;) {
        __syncthreads();
        if (tid == 0) misc[17] = __hip_atomic_fetch_add(B.ctl + 9216, (unsigned)BATCH, __ATOMIC_RELAXED, __HIP_MEMORY_SCOPE_AGENT);
        __syncthreads();
        const int t0 = (int)misc[17];
        if (t0 >= TOTAL) break;
        for (int t = t0; t < t0 + BATCH && t < TOTAL; ++t) {
            const int job = t / 448, tl = t - job * 448, e = job / 3, kind = job - 3 * e;
            if (kind == 0)      xpose_tile(2, tile, tid, p.in[25] + (size_t)e * D * DFE, DFE, DFE, B.W1T + (size_t)e * 2 * DFE * D, D, (tl % 56) * 64, (tl / 56) * 128);
            else if (kind == 1) xpose_tile(3, tile, tid, p.in[26] + (size_t)e * D * DFE, DFE, DFE, B.W1T + (size_t)e * 2 * DFE * D, D, (tl % 56) * 64, (tl / 56) * 128);
            else                xpose_tile(0, tile, tid, p.in[27] + (size_t)e * DFE * D, D, D, B.W2T + (size_t)e * D * DFE, DFE, (tl % 16) * 64, (tl / 16) * 128);
        }
    }
}

__device__ __forceinline__ void norm_rows(float* Hout, float* Hside, const float* __restrict__ w, bf16_t* __restrict__ Ub, int wg, int nwg, const float* PART, int nMm, int SPLIT, const int wave_idx_) {
    int tid_ = fresh_tid(); asm volatile("" : "+v"(tid_));
    const int lane = tid_ & 63, wv = tid_ >> 6;
    for (int row = wg * 8 + wv; row < MP; row += nwg * 8) {
        float* p = hf_row(Hout, Hside, row); f32x4 v[4]; float ss = 0.f;
        const bool fix = SPLIT > 0 && row >= nMm * 256 && row_valid(row);
#pragma unroll
        for (int j = 0; j < 4; ++j) { v[j] = *(const f32x4*)(p + j * 256 + lane * 4);
            if (fix) { const float* pp = PART + ((size_t)((row / 256 - nMm) * 4 + j) * SPLIT) * 65536 + (size_t)(row % 256) * 256 + lane * 4;
                for (int sp = 0; sp < SPLIT; ++sp) v[j] += *(const f32x4*)(pp + (size_t)sp * 65536);
                *(f32x4*)(p + j * 256 + lane * 4) = v[j]; }
            ss += v[j][0] * v[j][0] + v[j][1] * v[j][1] + v[j][2] * v[j][2] + v[j][3] * v[j][3]; }
        ss = wave_sum(ss);
        const float rs = rsqrtf(ss * (1.f / D) + EPS);
#pragma unroll
        for (int j = 0; j < 4; ++j) { const f32x4 g = *(const f32x4*)(w + j * 256 + lane * 4);
            u32x2 o = {cvt_pk_bf16(v[j][0] * rs * g[0], v[j][1] * rs * g[1]), cvt_pk_bf16(v[j][2] * rs * g[2], v[j][3] * rs * g[3])};
            *(u32x2*)(Ub + (size_t)row * D + j * 256 + lane * 4) = o; }
    }
}
__device__ __forceinline__ void build_rows(const float* __restrict__ x, const float* __restrict__ meta, const float* __restrict__ w, float* Hout, float* Hside, bf16_t* __restrict__ Ub, int wg, int nwg, const int wave_idx_) {
    int tid_ = fresh_tid(); asm volatile("" : "+v"(tid_));
    const int lane = tid_ & 63, wv = tid_ >> 6;
    for (int row = wg * 8 + wv; row < MP; row += nwg * 8) {
        const int b = row / LP, lp = row % LP;
        const float* p = nullptr;
        if (row < NB * LP && lp >= PADF) p = lp < PADF + NM ? meta + (size_t)(lp - PADF) * D : x + ((size_t)b * SEQ + (lp - PADF - NM)) * D;
        f32x4 v[4]; float ss = 0.f;
#pragma unroll
        for (int j = 0; j < 4; ++j) { v[j] = p ? *(const f32x4*)(p + j * 256 + lane * 4) : (f32x4){0.f, 0.f, 0.f, 0.f}; ss += v[j][0] * v[j][0] + v[j][1] * v[j][1] + v[j][2] * v[j][2] + v[j][3] * v[j][3]; }
        ss = wave_sum(ss);
        const float rs = rsqrtf(ss * (1.f / D) + EPS);
#pragma unroll
        for (int j = 0; j < 4; ++j) { const f32x4 g = *(const f32x4*)(w + j * 256 + lane * 4);
            *(f32x4*)(hf_row(Hout, Hside, row) + j * 256 + lane * 4) = v[j];
            u32x2 o = {cvt_pk_bf16(v[j][0] * rs * g[0], v[j][1] * rs * g[1]), cvt_pk_bf16(v[j][2] * rs * g[2], v[j][3] * rs * g[3])};
            *(u32x2*)(Ub + (size_t)row * D + j * 256 + lane * 4) = o; }
    }
}
constexpr float LOG2E = 1.4426950408889634f;
constexpr float DIFF_QSCALE = 0.125f * LOG2E;
constexpr float MLA_QSCALE = 0.07216878364870322f * LOG2E;

__device__ __forceinline__ void unpack8(const u32x4 w, float (&v)[8]) {
    v[0] = bflo(w[0]); v[1] = bfhi(w[0]); v[2] = bflo(w[1]); v[3] = bfhi(w[1]); v[4] = bflo(w[2]); v[5] = bfhi(w[2]); v[6] = bflo(w[3]); v[7] = bfhi(w[3]);
}
__device__ __forceinline__ u32x4 pack8(const float (&v)[8]) { return (u32x4){cvt_pk_bf16(v[0], v[1]), cvt_pk_bf16(v[2], v[3]), cvt_pk_bf16(v[4], v[5]), cvt_pk_bf16(v[6], v[7])}; }

__device__ __forceinline__ void prep_rows(CParams& p, int l, int wg, int nwg, const int wave_idx_) {
    auto& B = p.b;
    int tid_ = fresh_tid(); asm volatile("" : "+v"(tid_));
    const int lane = tid_ & 63, wv = tid_ >> 6;
    const float* qw = p.in[9] + l * 64; const float* kw = p.in[10] + l * 64;
    const float* cqw = p.in[13] + l * 256; const float* ckvw = p.in[15] + l * 128;
    const float* a_log = p.in[6] + l * 8; const float* dt_bias = p.in[7] + l * 8;
    float gq[8], gk[8];
#pragma unroll
    for (int j = 0; j < 8; ++j) { gq[j] = qw[(lane & 7) * 8 + j] * DIFF_QSCALE; gk[j] = kw[(lane & 7) * 8 + j]; }
    float gcq[4], gckv[2];
#pragma unroll
    for (int j = 0; j < 4; ++j) gcq[j] = cqw[lane * 4 + j];
    gckv[0] = ckvw[lane * 2]; gckv[1] = ckvw[lane * 2 + 1];
    for (int row = wg * 8 + wv; row < MP; row += nwg * 8) {
        bf16_t* g3 = B.G3 + (size_t)row * 1536;
        {
            float v[8];
            u32x4 w = *(const u32x4*)(g3 + lane * 8); unpack8(w, v);
            float ss = 0.f;
#pragma unroll
            for (int j = 0; j < 8; ++j) ss += v[j] * v[j];
            ss += shx<1>(ss); ss += shx<2>(ss); ss += shx<4>(ss);
            float rs = rsqrtf(ss * (1.f / 64.f) + EPS);
#pragma unroll
            for (int j = 0; j < 8; ++j) v[j] = v[j] * rs * gq[j];
            *(u32x4*)(g3 + lane * 8) = pack8(v);
            w = *(const u32x4*)(g3 + 512 + lane * 8); unpack8(w, v);
            ss = 0.f;
#pragma unroll
            for (int j = 0; j < 8; ++j) ss += v[j] * v[j];
            ss += shx<1>(ss); ss += shx<2>(ss); ss += shx<4>(ss);
            rs = rsqrtf(ss * (1.f / 64.f) + EPS);
#pragma unroll
            for (int j = 0; j < 8; ++j) v[j] = v[j] * rs * gk[j];
            *(u32x4*)(g3 + 512 + lane * 8) = pack8(v);
        }
        bf16_t* g4 = B.G4 + (size_t)row * 512;
        {
            const u32x2 w = *(const u32x2*)(g4 + lane * 4);
            float a0 = bflo(w[0]), a1 = bfhi(w[0]), a2 = bflo(w[1]), a3 = bfhi(w[1]);
            float ss = wave_sum(a0 * a0 + a1 * a1 + a2 * a2 + a3 * a3);
            float rs = rsqrtf(ss * (1.f / 256.f) + EPS);
            *(u32x2*)(g4 + lane * 4) = (u32x2){cvt_pk_bf16(a0 * rs * gcq[0], a1 * rs * gcq[1]), cvt_pk_bf16(a2 * rs * gcq[2], a3 * rs * gcq[3])};
            const unsigned w2 = *(const unsigned*)(g4 + 256 + lane * 2);
            a0 = bflo(w2); a1 = bfhi(w2);
            ss = wave_sum(a0 * a0 + a1 * a1);
            rs = rsqrtf(ss * (1.f / 128.f) + EPS);
            *(unsigned*)(g4 + 256 + lane * 2) = cvt_pk_bf16(a0 * rs * gckv[0], a1 * rs * gckv[1]);
        }
        if (lane < 8) {
            const float bl = bf2f(g4[448 + lane]), al = bf2f(g4[456 + lane]) + dt_bias[lane];
            const float sp = al > 20.f ? al : __logf(1.f + __expf(al));
            B.BG[(size_t)row * 16 + lane] = 1.f / (1.f + __expf(-bl));
            B.BG[(size_t)row * 16 + 8 + lane] = -__expf(a_log[lane]) * sp;
        }
    }
}

__device__ __forceinline__ void build_wu(CParams& p, int wg, int nwg, const int wave_idx_) {
    const size_t n = (size_t)2 * 2048 * 384;
    int tid_ = fresh_tid(); asm volatile("" : "+v"(tid_));
    for (size_t i = (size_t)wg * NWG_THREADS + tid_; i < n; i += (size_t)nwg * NWG_THREADS) {
        const int k = (int)(i % 384); const int nn = (int)((i / 384) % 2048); const int l = (int)(i / (384 * 2048));
        float v = 0.f;
        if (nn < 1024) { const int h = nn >> 8, j = nn & 255; if (j < 192 && k < 256) v = p.in[14][((size_t)l * 256 + k) * 768 + h * 192 + j]; }
        else { const int h = (nn - 1024) >> 8, j = nn & 255; if (k >= 256) v = p.in[16][((size_t)l * 128 + (k - 256)) * 1024 + h * 256 + j]; }
        p.b.WuT[i] = f2bf(v);
    }
}

__device__ __forceinline__ void mla_finalize(CParams& p, int l, int wg, int nwg, const int wave_idx_) {
    auto& B = p.b;
    int tid_ = fresh_tid(); asm volatile("" : "+v"(tid_));
    const int lane = tid_ & 63, wv = tid_ >> 6;
    const float* qw = p.in[17] + l * 192; const float* kw = p.in[18] + l * 192;
    float gq[4] = {0.f, 0.f, 0.f, 0.f}, gk[4] = {0.f, 0.f, 0.f, 0.f};
    if (lane < 48) {
#pragma unroll
        for (int j = 0; j < 4; ++j) { gq[j] = qw[lane * 4 + j] * MLA_QSCALE; gk[j] = kw[lane * 4 + j]; }
    }
    const int ibase = (lane >= 40 ? lane - 40 : lane - 32) * 4;
    float invf[4];
#pragma unroll
    for (int j = 0; j < 4; ++j) invf[j] = __builtin_amdgcn_exp2f(-(float)(ibase + j) * (13.287712379549449f / 32.0f)) * 0.15915494309189535f;
    for (int row = wg * 8 + wv; row < MP; row += nwg * 8) {
        const int lp = row % LP; const float pos = (float)(lp - PADF);
        float cs[4], sn[4];
        if (lane >= 32 && lane < 48) {
#pragma unroll
            for (int j = 0; j < 4; ++j) { const float th = pos * invf[j], k = rintf(th), fr = fmaf(pos, invf[j], -k);
                cs[j] = __builtin_amdgcn_cosf(fr); sn[j] = __builtin_amdgcn_sinf(fr); }
        } else {
#pragma unroll
            for (int j = 0; j < 4; ++j) { cs[j] = 1.f; sn[j] = 0.f; }
        }
        bf16_t* mx = B.MLX + (size_t)row * 2048;
        const bf16_t* g4 = B.G4 + (size_t)row * 512;
        float v[8][4], ss[8];
#pragma unroll
        for (int hw = 0; hw < 8; ++hw) { const int h = hw >> 1, which = hw & 1;
            v[hw][0] = v[hw][1] = v[hw][2] = v[hw][3] = 0.f;
            if (lane < 48) {
                const bf16_t* src = which == 0 ? mx + 256 * h + lane * 4 : (lane < 32 ? mx + 1024 + 256 * h + lane * 4 : g4 + 384 + (lane - 32) * 4);
                const u32x2 w = *(const u32x2*)src;
                v[hw][0] = bflo(w[0]); v[hw][1] = bfhi(w[0]); v[hw][2] = bflo(w[1]); v[hw][3] = bfhi(w[1]);
            }
            ss[hw] = v[hw][0] * v[hw][0] + v[hw][1] * v[hw][1] + v[hw][2] * v[hw][2] + v[hw][3] * v[hw][3]; }
#pragma unroll
        for (int hw = 0; hw < 8; ++hw) ss[hw] += shx<32>(ss[hw]);
#pragma unroll
        for (int hw = 0; hw < 8; ++hw) ss[hw] += shx<16>(ss[hw]);
#pragma unroll
        for (int hw = 0; hw < 8; ++hw) ss[hw] += shx<8>(ss[hw]);
#pragma unroll
        for (int hw = 0; hw < 8; ++hw) ss[hw] += shx<4>(ss[hw]);
#pragma unroll
        for (int hw = 0; hw < 8; ++hw) ss[hw] += shx<2>(ss[hw]);
#pragma unroll
        for (int hw = 0; hw < 8; ++hw) ss[hw] += shx<1>(ss[hw]);
#pragma unroll
        for (int hw = 0; hw < 8; ++hw) { const int h = hw >> 1, which = hw & 1;
            const float rs = rsqrtf(ss[hw] * (1.f / 192.f) + EPS);
            float o4[4];
#pragma unroll
            for (int j = 0; j < 4; ++j) { const float x = v[hw][j] * rs * (which == 0 ? gq[j] : gk[j]); const float other = shx<8>(x);
                o4[j] = lane < 32 ? x : (lane < 40 ? x * cs[j] - other * sn[j] : other * sn[j] + x * cs[j]); }
            if (lane < 48) {
                bf16_t* dst = which == 0 ? mx + 256 * h + lane * 4 : (lane < 32 ? mx + 1024 + 256 * h + lane * 4 : mx + 256 * h + 192 + (lane - 32) * 4);
                *(u32x2*)dst = (u32x2){cvt_pk_bf16(o4[0], o4[1]), cvt_pk_bf16(o4[2], o4[3])};
            }
        }
    }
}

__device__ __forceinline__ void post_mixer(CParams& p, int l, int wg, int nwg, const int wave_idx_) {
    auto& B = p.b;
    int tid_ = fresh_tid(); asm volatile("" : "+v"(tid_));
    const int lane = tid_ & 63, wv = tid_ >> 6;
    const float* dnw = p.in[8] + l * 128; const float* slw = p.in[12] + l * 128;
    const float lam_scale = 1.f - (0.8f - 0.6f * __expf(-0.3f * (float)l));
    float g1[8], g2[8];
#pragma unroll
    for (int j = 0; j < 8; ++j) { g1[j] = dnw[(lane & 15) * 8 + j]; g2[j] = slw[(lane & 15) * 8 + j] * lam_scale; }
    bf16_t* Y = B.G1;
    for (int row = wg * 8 + wv; row < MP; row += nwg * 8) {
        float a[8], c[8], z[8];
        unpack8(*(const u32x4*)(B.ODN + (size_t)row * 512 + lane * 8), a);
        unpack8(*(const u32x4*)(B.ODN + (size_t)MP * 512 + (size_t)row * 512 + lane * 8), c);
        unpack8(*(const u32x4*)(B.G2 + (size_t)row * 512 + lane * 8), z);
        float ss = 0.f;
#pragma unroll
        for (int j = 0; j < 8; ++j) { a[j] += c[j]; ss += a[j] * a[j]; }
        ss += shx<1>(ss); ss += shx<2>(ss); ss += shx<4>(ss); ss += shx<8>(ss);
        float rs = rsqrtf(ss * (1.f / 128.f) + EPS);
#pragma unroll
        for (int j = 0; j < 8; ++j) a[j] = a[j] * rs * g1[j] * siluf(z[j]);
        const u32x4 y0 = pack8(a);
        unpack8(*(const u32x4*)(B.G3 + (size_t)row * 1536 + lane * 8), a);
        ss = 0.f;
#pragma unroll
        for (int j = 0; j < 8; ++j) ss += a[j] * a[j];
        ss += shx<1>(ss); ss += shx<2>(ss); ss += shx<4>(ss); ss += shx<8>(ss);
        rs = rsqrtf(ss * (1.f / 128.f) + EPS);
#pragma unroll
        for (int j = 0; j < 8; ++j) a[j] = a[j] * rs * g2[j];
        const u32x4 y1 = pack8(a);
        const u32x4 y2 = *(const u32x4*)(B.MLX + (size_t)row * 2048 + (lane >> 4) * 256 + (lane & 15) * 8);
        *(u32x4*)(Y + (size_t)row * 1536 + lane * 8) = y0;
        *(u32x4*)(Y + (size_t)row * 1536 + 512 + lane * 8) = y1;
        *(u32x4*)(Y + (size_t)row * 1536 + 1024 + lane * 8) = y2;
    }
}
namespace att {
constexpr int NT = LP / 64;
constexpr int SHM_V = 64 * 128 * 2;
__device__ __forceinline__ int crow(int r, int hi) { return (r & 3) + 8 * (r >> 2) + 4 * hi; }
__device__ __forceinline__ int v_st(int k, int c) { const int kk = (k & ~0xC) | ((k & 4) << 1) | ((k & 8) >> 1); return ((kk >> 3) * 4 + (c >> 5)) * 512 + ((kk & 7) * 32 + (c & 31)) * 2; }
__device__ __forceinline__ int v_rd_base(int lane) { return ((lane & 3) << 3) | (((lane >> 2) & 3) << 6) | (((lane >> 4) & 1) << 5) | (((lane >> 5) & 1) << 8); }
constexpr int v_rd_off(int d0, int ks, int half) { return d0 * 512 + ks * 4096 + half * 2048; }
template <int OFF> __device__ __forceinline__ s16x4 tr_read(int vb) {
    s16x4 r; asm volatile("ds_read_b64_tr_b16 %0, %1 offset:%2" : "=&v"(r) : "v"(vb), "i"(OFF) : "memory"); return r;
}
#define PVPK(Lx, Hx) (bf16x8){Lx[0], Lx[1], Lx[2], Lx[3], Hx[0], Hx[1], Hx[2], Hx[3]}
template <int D0> __device__ __forceinline__ void pv_reads(s16x4 (&v)[8], int vb) {
    v[0] = tr_read<v_rd_off(D0, 0, 0)>(vb); v[1] = tr_read<v_rd_off(D0, 0, 1)>(vb); v[2] = tr_read<v_rd_off(D0, 1, 0)>(vb); v[3] = tr_read<v_rd_off(D0, 1, 1)>(vb);
    v[4] = tr_read<v_rd_off(D0, 2, 0)>(vb); v[5] = tr_read<v_rd_off(D0, 2, 1)>(vb); v[6] = tr_read<v_rd_off(D0, 3, 0)>(vb); v[7] = tr_read<v_rd_off(D0, 3, 1)>(vb);
}
__device__ __forceinline__ void pv_mma(f32x16& od, const s16x4 (&v)[8], bf16x8 pa0, bf16x8 pa1, bf16x8 pa2, bf16x8 pa3) {
    od = __builtin_amdgcn_mfma_f32_32x32x16_bf16(pa0, PVPK(v[0], v[1]), od, 0, 0, 0);
    od = __builtin_amdgcn_mfma_f32_32x32x16_bf16(pa1, PVPK(v[2], v[3]), od, 0, 0, 0);
    od = __builtin_amdgcn_mfma_f32_32x32x16_bf16(pa2, PVPK(v[4], v[5]), od, 0, 0, 0);
    od = __builtin_amdgcn_mfma_f32_32x32x16_bf16(pa3, PVPK(v[6], v[7]), od, 0, 0, 0);
}
__device__ __forceinline__ void pv_all(f32x16 (&o)[4], int vb, bf16x8 pa0, bf16x8 pa1, bf16x8 pa2, bf16x8 pa3) {
    s16x4 va[8], vbb[8];
    pv_reads<0>(va, vb);
    pv_reads<1>(vbb, vb);
    asm volatile("s_waitcnt lgkmcnt(8)" ::: "memory"); __builtin_amdgcn_sched_barrier(0);
    pv_mma(o[0], va, pa0, pa1, pa2, pa3); __builtin_amdgcn_sched_barrier(0);
    pv_reads<2>(va, vb);
    asm volatile("s_waitcnt lgkmcnt(8)" ::: "memory"); __builtin_amdgcn_sched_barrier(0);
    pv_mma(o[1], vbb, pa0, pa1, pa2, pa3); __builtin_amdgcn_sched_barrier(0);
    pv_reads<3>(vbb, vb);
    asm volatile("s_waitcnt lgkmcnt(8)" ::: "memory"); __builtin_amdgcn_sched_barrier(0);
    pv_mma(o[2], va, pa0, pa1, pa2, pa3); __builtin_amdgcn_sched_barrier(0);
    asm volatile("s_waitcnt lgkmcnt(0)" ::: "memory"); __builtin_amdgcn_sched_barrier(0);
    pv_mma(o[3], vbb, pa0, pa1, pa2, pa3);
}
template <int ROWB> __device__ __forceinline__ int kswz(int row, int colB) { return row * ROWB + (colB ^ (((row >> 1) & 7) << 4)); }

struct KVSrc {
    const bf16_t* k0; int ldk;
    const bf16_t* k1;
    const bf16_t* v; int ldv;
};

template <int DQK, int KSPLIT, bool BIAS, int ATT_X = 0>
__device__ __forceinline__ void attn_pass(const bf16x8 (&qr)[DQK / 16], const KVSrc& S, LAS unsigned char* lds, int qpos0, const LAS float* bias_tab, float bias_neg, float bias_pos, f32x16 (&o)[4], const bool active, const int wave_idx_) {
    constexpr int ROWB = DQK * 2, SHM_K = 64 * ROWB, NKC = DQK / 8, NKP = (64 * NKC) / 512;
    static_assert((64 * NKC) % 512 == 0, "K tile pieces");
    int tid_ = fresh_tid(); asm volatile("" : "+v"(tid_));
    const int tid = tid_, wid = tid >> 6, lane = tid & 63, r32 = lane & 31, hi = lane >> 5;
    LAS unsigned char* V_lds = lds; LAS unsigned char* K_lds = lds + 4 * SHM_V;
    LAS float* wsl = (LAS float*)(lds + 4 * SHM_V + 3 * SHM_K) + wid * 64; LAS float* li_l = wsl; LAS float* al_l = wsl + 32;
    float m_reg = -1e30f, l_reg = 0.f;
#pragma unroll
    for (int d = 0; d < 4; ++d)
#pragma unroll
        for (int r = 0; r < 16; ++r) o[d][r] = 0.f;
    unsigned voffs[2], koffs[NKP];
#pragma unroll
    for (int i = 0; i < 2; ++i) { const int P = i * 512 + tid, sub = P >> 5, kk = (sub >> 2) * 8 + ((P & 31) >> 2), c = (sub & 3) * 32 + (P & 3) * 8;
        const int k = (kk & ~0xC) | ((kk & 4) << 1) | ((kk & 8) >> 1); voffs[i] = (unsigned)(k * S.ldv + c); }
#pragma unroll
    for (int i = 0; i < NKP; ++i) { const int P = i * 512 + tid, row = P / NKC, cs = P % NKC, ch = cs ^ ((row >> 1) & 7); const int col = ch * 8;
        koffs[i] = (unsigned)(row * S.ldk + (col < KSPLIT ? col : col - KSPLIT)) | (col < KSPLIT ? 0u : 0x80000000u); }
    const unsigned ldsw = (unsigned)__builtin_amdgcn_readfirstlane(wid) * 1024u;
#define SDMA(t, bb, vv) do { const size_t kr_ = (size_t)(t) * 64; \
        _Pragma("unroll") for (int i_ = 0; i_ < 2; ++i_) __builtin_amdgcn_global_load_lds((const unsigned*)(S.v + kr_ * S.ldv + voffs[i_]), (LAS unsigned*)(V_lds + (vv) * SHM_V + i_ * 8192 + ldsw), 16, 0, 0); \
        _Pragma("unroll") for (int i_ = 0; i_ < NKP; ++i_) { const bf16_t* kb_ = (koffs[i_] & 0x80000000u) ? S.k1 : S.k0; \
            __builtin_amdgcn_global_load_lds((const unsigned*)(kb_ + kr_ * S.ldk + (koffs[i_] & 0x7FFFFFFFu)), (LAS unsigned*)(K_lds + (bb) * SHM_K + i_ * 8192 + ldsw), 16, 0, 0); } } while (0)
    const int vb0 = (int)(uintptr_t)V_lds + v_rd_base(lane);
    bf16x8 pa0, pa1, pa2, pa3;
    pa0 = pa1 = pa2 = pa3 = (bf16x8){0, 0, 0, 0, 0, 0, 0, 0};
    constexpr int PER = 2 + NKP;
    asm volatile("s_waitcnt vmcnt(0)" ::: "memory");
    SDMA(0, 0, 0); SDMA(1, 1, 1);
    asm volatile("s_waitcnt vmcnt(%0)" :: "n"(PER) : "memory");
    __syncthreads();
#define SB __builtin_amdgcn_sched_barrier(0)
#define PVM(D, PA, VL, VH) o[D] = __builtin_amdgcn_mfma_f32_32x32x16_bf16(PA, PVPK(VL, VH), o[D], 0, 0, 0)
    for (int j = 0; j < NT; ++j) {
        const int b = j % 3;
        if (j + 2 < NT) SDMA(j + 2, (j + 2) % 3, (j + 2) & 3);
        if (active) {
        f32x16 p0, p1;
#pragma unroll
        for (int r = 0; r < 16; ++r) { p0[r] = 0.f; p1[r] = 0.f; }
        {
            const LAS unsigned char* Kb = K_lds + b * SHM_K;
            constexpr int NG = DQK / 32;
            bf16x8 kf[2][4];
#define KLOAD(g, buf) do { _Pragma("unroll") for (int dd_ = 0; dd_ < 2; ++dd_) { const int cb_ = (((g) * 2 + dd_) * 16 + hi * 8) * 2; \
                kf[buf][2 * dd_] = *(const LAS bf16x8*)(Kb + kswz<ROWB>(r32, cb_)); kf[buf][2 * dd_ + 1] = *(const LAS bf16x8*)(Kb + kswz<ROWB>(32 + r32, cb_)); } } while (0)
            KLOAD(0, 0);
#pragma unroll
            for (int g = 0; g < NG; ++g) {
                if (g + 1 < NG) { KLOAD(g + 1, (g + 1) & 1); }
                SB;
#pragma unroll
                for (int dd = 0; dd < 2; ++dd) {
                    p0 = __builtin_amdgcn_mfma_f32_32x32x16_bf16(kf[g & 1][2 * dd], qr[g * 2 + dd], p0, 0, 0, 0);
                    p1 = __builtin_amdgcn_mfma_f32_32x32x16_bf16(kf[g & 1][2 * dd + 1], qr[g * 2 + dd], p1, 0, 0, 0); }
                SB;
            }
#undef KLOAD
        }
        float boff = 0.f;
        if (BIAS) {
            const int kpos0 = j * 64 - PADF;
            const int rel_min = kpos0 - (qpos0 + 31), rel_max = kpos0 + 63 - qpos0;
            if (rel_min >= 91) boff = bias_pos;
            else if (rel_max <= -91) boff = bias_neg;
            else {
                const int base = kpos0 - (qpos0 + r32) + 128;
#pragma unroll
                for (int r = 0; r < 16; ++r) { int i0 = base + crow(r, hi), i1 = i0 + 32;
                    i0 = i0 < 0 ? 0 : (i0 > 255 ? 255 : i0); i1 = i1 < 0 ? 0 : (i1 > 255 ? 255 : i1);
                    p0[r] += bias_tab[i0]; p1[r] += bias_tab[i1]; }
            }
        }
        if (j == 0) {
#pragma unroll
            for (int r = 0; r < 16; ++r) p0[r] = -1e30f;
#pragma unroll
            for (int r = 0; r < 8; ++r) p1[r] = -1e30f;
        }
        const int vb = vb0 + (j == 0 ? 0 : (j - 1) & 3) * SHM_V;
        s16x4 va[8], vbb[8];
        asm volatile("s_waitcnt lgkmcnt(0)" ::: "memory"); SB;
        pv_reads<0>(va, vb); pv_reads<1>(vbb, vb);
        asm volatile("s_waitcnt lgkmcnt(8)" ::: "memory"); SB;
        float pmax = p0[0];
        PVM(0, pa0, va[0], va[1]); SB;
#pragma unroll
        for (int r = 1; r < 8; ++r) pmax = fmaxf(pmax, p0[r]);
        SB; PVM(0, pa1, va[2], va[3]); SB;
#pragma unroll
        for (int r = 8; r < 16; ++r) pmax = fmaxf(pmax, p0[r]);
        SB; PVM(0, pa2, va[4], va[5]); SB;
#pragma unroll
        for (int r = 0; r < 8; ++r) pmax = fmaxf(pmax, p1[r]);
        SB; PVM(0, pa3, va[6], va[7]); SB;
#pragma unroll
        for (int r = 8; r < 16; ++r) pmax = fmaxf(pmax, p1[r]);
        { auto rr = __builtin_amdgcn_permlane32_swap(__float_as_uint(pmax), __float_as_uint(pmax), false, false);
          pmax = fmaxf(__uint_as_float(rr[0]), __uint_as_float(rr[1])) + boff; }
        float alpha = 1.f, mn = m_reg;
        const bool need = !__all(pmax - m_reg <= 8.f);
        if (need) { mn = fmaxf(m_reg, pmax); alpha = __builtin_amdgcn_exp2f(m_reg - mn); m_reg = mn; }
        float ps = 0.f;
        const float mnb = mn - boff;
        SB;
        pv_reads<2>(va, vb);
        asm volatile("s_waitcnt lgkmcnt(8)" ::: "memory"); SB;
#define EX(P, R) do { P[R] = __builtin_amdgcn_exp2f(P[R] - mnb); ps += P[R]; } while (0)
        PVM(1, pa0, vbb[0], vbb[1]); SB; EX(p0, 0); EX(p0, 1); EX(p0, 2); SB;
        PVM(1, pa1, vbb[2], vbb[3]); SB; EX(p0, 3); EX(p0, 4); EX(p0, 5); SB;
        PVM(1, pa2, vbb[4], vbb[5]); SB; EX(p0, 6); EX(p0, 7); EX(p0, 8); SB;
        PVM(1, pa3, vbb[6], vbb[7]); SB; EX(p0, 9); EX(p0, 10); EX(p0, 11); SB;
        pv_reads<3>(vbb, vb);
        asm volatile("s_waitcnt lgkmcnt(8)" ::: "memory"); SB;
        PVM(2, pa0, va[0], va[1]); SB; EX(p0, 12); EX(p0, 13); EX(p0, 14); SB;
        PVM(2, pa1, va[2], va[3]); SB; EX(p0, 15); EX(p1, 0); EX(p1, 1); SB;
        PVM(2, pa2, va[4], va[5]); SB; EX(p1, 2); EX(p1, 3); SB;
        PVM(2, pa3, va[6], va[7]); SB; EX(p1, 4); EX(p1, 5); SB;
        asm volatile("s_waitcnt lgkmcnt(0)" ::: "memory"); SB;
        PVM(3, pa0, vbb[0], vbb[1]); SB; EX(p1, 6); EX(p1, 7); EX(p1, 8); SB;
        PVM(3, pa1, vbb[2], vbb[3]); SB; EX(p1, 9); EX(p1, 10); EX(p1, 11); SB;
        PVM(3, pa2, vbb[4], vbb[5]); SB; EX(p1, 12); EX(p1, 13); SB;
        PVM(3, pa3, vbb[6], vbb[7]); SB; EX(p1, 14); EX(p1, 15); SB;
#undef EX
        l_reg = l_reg * alpha + ps;
#define PK4(P, BASE, OUT) do { unsigned a0 = cvt_pk_bf16(P[BASE + 0], P[BASE + 1]), a1 = cvt_pk_bf16(P[BASE + 2], P[BASE + 3]);   \
        unsigned b0_ = cvt_pk_bf16(P[BASE + 4], P[BASE + 5]), b1_ = cvt_pk_bf16(P[BASE + 6], P[BASE + 7]);                              \
        auto r0 = __builtin_amdgcn_permlane32_swap(a0, b0_, false, false); auto r1 = __builtin_amdgcn_permlane32_swap(a1, b1_, false, false); \
        u32x4 w = {r0[0], r1[0], r0[1], r1[1]}; OUT = *reinterpret_cast<bf16x8*>(&w); } while (0)
        PK4(p0, 0, pa0); PK4(p0, 8, pa1); PK4(p1, 0, pa2); PK4(p1, 8, pa3);
#undef PK4
        if (need) {
            if (hi == 0) al_l[r32] = alpha;
            asm volatile("s_waitcnt lgkmcnt(0)" ::: "memory");
#pragma unroll
            for (int r = 0; r < 16; ++r) { const float a = al_l[crow(r, hi)];
#pragma unroll
                for (int d = 0; d < 4; ++d) o[d][r] *= a; }
        }
        }
        if (j + 2 < NT) asm volatile("s_waitcnt vmcnt(%0)" :: "n"(PER) : "memory"); else asm volatile("s_waitcnt vmcnt(0)" ::: "memory");
        __syncthreads();
    }
#undef PVM
#undef SB
    if (active) {
        const int vb = vb0 + ((NT - 1) & 3) * SHM_V;
        pv_all(o, vb, pa0, pa1, pa2, pa3);
    }
    { auto rr = __builtin_amdgcn_permlane32_swap(__float_as_uint(l_reg), __float_as_uint(l_reg), false, false);
      l_reg = __uint_as_float(rr[0]) + __uint_as_float(rr[1]); }
    if (hi == 0) li_l[r32] = l_reg;
    asm volatile("s_waitcnt lgkmcnt(0)" ::: "memory");
#pragma unroll
    for (int r = 0; r < 16; ++r) { const float il = __builtin_amdgcn_rcpf(li_l[crow(r, hi)]);
#pragma unroll
        for (int d = 0; d < 4; ++d) o[d][r] *= il; }
    __syncthreads();
#undef SDMA
}
}

__device__ __forceinline__ int t5_bucket(int rel) {
    const int n = rel < 0 ? -rel : rel;
    int f;
    if (n < 8) f = n; else if (n < 12) f = 8; else if (n < 16) f = 9; else if (n < 23) f = 10; else if (n < 32) f = 11;
    else if (n < 46) f = 12; else if (n < 64) f = 13; else if (n < 91) f = 14; else f = 15;
    return (rel > 0 ? 16 : 0) + f;
}

__device__ __forceinline__ void diff_unit(CParams& p, int l, int b, int h, int qb, LAS unsigned char* lds, const int wave_idx_) {
    auto& B = p.b;
    int tid_ = fresh_tid(); asm volatile("" : "+v"(tid_));
    const int tid = tid_, wid = tid >> 6, lane = tid & 63, r32 = lane & 31, hi = lane >> 5;
    constexpr int LDS_TAB = 4 * att::SHM_V + 3 * 64 * 128 + 8 * 64 * 4;
    LAS float* tab = (LAS float*)(lds + LDS_TAB);
    const float* table = p.in[2];
    if (tid < 256) { const int rel = tid - 128; tab[tid] = table[t5_bucket(rel) * 4 + h] * LOG2E; }
    const float bias_neg = table[15 * 4 + h] * LOG2E, bias_pos = table[31 * 4 + h] * LOG2E;
    const float lam = p.b.misc[l];
    const size_t row0 = (size_t)b * LP;
    const int qrow = qb * 256 + wid * 32 + r32;
    const bool valid = qrow < LP;
    const size_t qr_g = row0 + (valid ? qrow : LP - 1);
    bf16x8 q0[4];
    const bf16_t* qp = B.G3 + qr_g * 1536 + h * 128 + hi * 8;
#pragma unroll
    for (int d0 = 0; d0 < 4; ++d0) q0[d0] = *(const bf16x8*)(qp + d0 * 16);
    __syncthreads();
    att::KVSrc S; S.ldk = 1536; S.ldv = 1536; S.v = B.G3 + row0 * 1536 + 1024 + h * 128;
    const int qpos0 = qb * 256 + wid * 32 - PADF;
    const int wrow0 = qb * 256 + wid * 32;
    f32x16 o[4];
    S.k0 = B.G3 + row0 * 1536 + 512 + h * 128; S.k1 = S.k0;
    att::attn_pass<64, 64, true>(q0, S, lds, qpos0, tab, bias_neg, bias_pos, o, wrow0 < LP, wave_idx_);
#if PROBE
    if (false && blockIdx.x == 100 && qb == 0) {
        f32x16 od[4];
        __syncthreads();
        if (tid == 0) ((volatile unsigned long long*)(p.b.ctl + 12288))[52] = wall_clock64();
        att::attn_pass<64, 64, true, ATT_EXPERIMENT>(q0, S, lds, qpos0, tab, bias_neg, bias_pos, od, wrow0 < LP, wave_idx_);
        if (tid == 0) ((volatile unsigned long long*)(p.b.ctl + 12288))[53] = wall_clock64();
        if (od[0][0] == 12345.f) p.b.misc[40] = od[1][1];
    }
#endif
#pragma unroll
    for (int d0 = 0; d0 < 4; ++d0) q0[d0] = *(const bf16x8*)(qp + 64 + d0 * 16);
    asm volatile("s_waitcnt vmcnt(0)" ::: "memory");
#pragma unroll
    for (int r = 0; r < 16; ++r) { const int lr = wrow0 + att::crow(r, hi);
        if (lr < LP) { bf16_t* op = B.G3 + (row0 + lr) * 1536 + h * 128 + r32;
#pragma unroll
            for (int d = 0; d < 4; ++d) op[d * 32] = f2bf(o[d][r]); } }
    S.k0 = B.G3 + row0 * 1536 + 512 + h * 128 + 64; S.k1 = S.k0;
    att::attn_pass<64, 64, true>(q0, S, lds, qpos0, tab, bias_neg, bias_pos, o, wrow0 < LP, wave_idx_);
#pragma unroll
    for (int r = 0; r < 16; ++r) { const int lr = wrow0 + att::crow(r, hi);
        if (lr < LP) { bf16_t* op = B.G3 + (row0 + lr) * 1536 + h * 128 + r32;
#pragma unroll
            for (int d = 0; d < 4; ++d) { const float a = bf2f(op[d * 32]); op[d * 32] = f2bf(a - lam * o[d][r]); } } }
}

__device__ __forceinline__ void mla_unit(CParams& p, int b, int h, int qb, LAS unsigned char* lds, const int wave_idx_) {
    auto& B = p.b;
    int tid_ = fresh_tid(); asm volatile("" : "+v"(tid_));
    const int tid = tid_, wid = tid >> 6, lane = tid & 63, r32 = lane & 31, hi = lane >> 5;
    const size_t row0 = (size_t)b * LP;
    const int qrow = qb * 256 + wid * 32 + r32;
    const bool valid = qrow < LP;
    const size_t qr_g = row0 + (valid ? qrow : LP - 1);
    bf16x8 q[12];
    const bf16_t* qp = B.MLX + qr_g * 2048 + h * 256 + hi * 8;
#pragma unroll
    for (int d0 = 0; d0 < 12; ++d0) q[d0] = *(const bf16x8*)(qp + d0 * 16);
    att::KVSrc S; S.ldk = 2048; S.ldv = 2048;
    S.k0 = B.MLX + row0 * 2048 + 1024 + h * 256; S.k1 = B.MLX + row0 * 2048 + h * 256 + 192; S.v = B.MLX + row0 * 2048 + 1024 + h * 256 + 128;
    f32x16 o[4];
    att::attn_pass<192, 128, false>(q, S, lds, 0, nullptr, 0.f, 0.f, o, qb * 256 + wid * 32 < LP, wave_idx_);
    const int wrow0 = qb * 256 + wid * 32;
#pragma unroll
    for (int r = 0; r < 16; ++r) { const int lr = wrow0 + att::crow(r, hi);
        if (lr < LP) { bf16_t* op = B.MLX + (row0 + lr) * 2048 + h * 256 + r32;
#pragma unroll
            for (int d = 0; d < 4; ++d) op[d * 32] = f2bf(o[d][r]); } }
}
namespace dn {
#ifndef DN_PREFETCH
#define DN_PREFETCH 1
#endif
constexpr int RS = 272;
constexpr int QS = 136;
constexpr int LD = 65;
constexpr int O_Q = 0, O_K = 17408, O_VB = O_K  , O_KB = 2 * 17408, O_KT = 3 * 17408, O_KG = 4 * 17408, O_VT = 5 * 17408,
              O_QK = 6 * 17408, O_TI = O_QK + 8704, O_A = O_TI + 8704, O_T = O_A + 64 * LD * 4, O_P = O_T + 64 * LD * 4, O_TAB = O_P + 4224, O_END = O_TAB + 1024, O_TAB2 = 160384 + 2048;
__device__ __forceinline__ int crow32(int r, int hi) { return (r & 3) + 8 * (r >> 2) + 4 * hi; }
typedef short bf16x4 __attribute__((ext_vector_type(4)));
__device__ __forceinline__ bf16x8 cat4(bf16x4 a, bf16x4 b) { return (bf16x8){a[0], a[1], a[2], a[3], b[0], b[1], b[2], b[3]}; }

template <int CTRL, int ROWMASK> __device__ __forceinline__ float dpp_f(float v) {
    return __int_as_float(__builtin_amdgcn_update_dpp(0, __float_as_int(v), CTRL, ROWMASK, 0xf, ROWMASK == 0xf)); }
__device__ __forceinline__ float wave_scan_incl(float v) {
    v += dpp_f<0x111, 0xf>(v); v += dpp_f<0x112, 0xf>(v); v += dpp_f<0x114, 0xf>(v); v += dpp_f<0x118, 0xf>(v);
    v += dpp_f<0x142, 0xa>(v);
    v += dpp_f<0x143, 0xc>(v);
    return v; }
template <int M> __device__ __forceinline__ float swz_xor(float v) {
    return __int_as_float(__builtin_amdgcn_ds_swizzle(__float_as_int(v), (M << 10) | 0x1f)); }
#ifndef DN_SWAP
#define DN_SWAP 0
#endif
__device__ __forceinline__ void dn_item(CParams& p, int l, int b, int h, int dir, int c_lo, int c_hi, float* stbuf, LAS unsigned char* lds, const int wave_idx_) {
    auto& B = p.b;
    int tid_ = fresh_tid(); asm volatile("" : "+v"(tid_));
    const int tid0 = tid_, w = __builtin_amdgcn_readfirstlane(tid0 >> 6), lane0 = tid0 & 63;
    LAS float* Amat = (LAS float*)(lds + O_A);
    LAS float* Tmat = (LAS float*)(lds + O_T);
    LAS float* Pmat = (LAS float*)(lds + O_P);
    const size_t row0 = (size_t)b * LP;
    const bf16_t* G1 = B.G1 + row0 * 1536;
    const float* BGb = B.BG + row0 * 16;
    const int jb = dir * 4 + h;
    f32x4 St[8];
#pragma unroll
    for (int t = 0; t < 8; ++t) St[t] = (f32x4){0.f, 0.f, 0.f, 0.f};
    if (c_lo > 0) {
        int tl = tid0; asm volatile("" : "+v"(tl)); const float* sp = stbuf + tl;
#pragma unroll
        for (int t = 0; t < 8; ++t)
#pragma unroll
            for (int r = 0; r < 4; ++r) St[t][r] = sp[(t * 4 + r) * NWG_THREADS];
    }
    bf16_t* outp0 = B.ODN + (size_t)dir * MP * 512 + row0 * 512 + h * 128 + 16 * w;
    for (int i = tid0; i < 64 * LD; i += NWG_THREADS) Tmat[i] = 0.f;
    for (int i = tid0; i < 8704 / 4; i += NWG_THREADS) ((LAS unsigned*)(lds + O_TI))[i] = 0u;

    unsigned cwp2[3][5];
    { const float* cwp = p.in[5] + (size_t)l * 5 * 1536 + h * 128 + 2 * lane0;
#pragma unroll
      for (int t = 0; t < 3; ++t)
#pragma unroll
        for (int j = 0; j < 5; ++j) { const float2 c2 = *(const float2*)(cwp + j * 1536 + t * 512); cwp2[t][j] = cvt_pk_bf16(c2.x, c2.y); } }
    float g_nx = 0.f, be_nx = 0.f;
#define DN_LOAD_BG(cc) do { const bool rv_ = (dir == 1 && (cc) > 0); int lpp_ = rv_ ? (4223 - 64 * (cc) - lane0) : (64 * (cc) + lane0); asm volatile("" : "+v"(lpp_)); \
        const bool ok_ = !((cc) == 0 && lane0 < PADF); g_nx = ok_ ? BGb[(size_t)lpp_ * 16 + 8 + jb] : 0.f; be_nx = ok_ ? BGb[(size_t)lpp_ * 16 + jb] : 0.f; } while (0)
    unsigned xr[3][12];
#define DN_LOAD_RAW_T(cc, tt) do { const bool rv_ = (dir == 1 && (cc) > 0); int lpl_ = rv_ ? (4223 - 64 * (cc) - 8 * w - 7) : (64 * (cc) + 8 * w); asm volatile("" : "+v"(lpl_)); \
        const bf16_t* gp_ = G1 + (ptrdiff_t)(lpl_ - 2) * 1536 + h * 128 + 2 * lane0 + (tt) * 512; \
        _Pragma("unroll") for (int rr_ = 0; rr_ < 12; ++rr_) { const int lp_ = lpl_ - 2 + rr_; const bool ok_ = (lp_ >= PADF) && (lp_ < LP); \
            unsigned u_ = 0u; if (ok_) u_ = *(const unsigned*)(gp_ + rr_ * 1536); xr[tt][rr_] = u_; } } while (0)
#define DN_LOAD_RAW(cc) do { const bool rv_ = (dir == 1 && (cc) > 0); int lpl_ = rv_ ? (4223 - 64 * (cc) - 8 * w - 7) : (64 * (cc) + 8 * w); asm volatile("" : "+v"(lpl_)); \
        const bf16_t* gp_ = G1 + (ptrdiff_t)(lpl_ - 2) * 1536 + h * 128 + 2 * lane0; \
        _Pragma("unroll") for (int rr_ = 0; rr_ < 12; ++rr_) { const int lp_ = lpl_ - 2 + rr_; const bool ok_ = (lp_ >= PADF) && (lp_ < LP); \
            _Pragma("unroll") for (int t_ = 0; t_ < 3; ++t_) { unsigned u_ = 0u; if (ok_) u_ = *(const unsigned*)(gp_ + rr_ * 1536 + t_ * 512); xr[t_][rr_] = u_; } } } while (0)

    unsigned iq[8], ik[8], ikg[2][4], ivt[2][4];
#define DN_CONV_(t_, yy_) do { unsigned cq_[5]; _Pragma("unroll") for (int j_ = 0; j_ < 5; ++j_) { cq_[j_] = cwp2[t_][j_]; asm volatile("" : "+v"(cq_[j_])); } \
          _Pragma("unroll") for (int m_ = 0; m_ < 8; ++m_) _Pragma("unroll") for (int e_ = 0; e_ < 2; ++e_) { float a_ = 0.f; \
            _Pragma("unroll") for (int j_ = 0; j_ < 5; ++j_) a_ = fmaf(e_ ? bfhi(xr[t_][m_ + j_]) : bflo(xr[t_][m_ + j_]), e_ ? bfhi(cq_[j_]) : bflo(cq_[j_]), a_); \
            yy_[m_][e_] = zero_wave_ ? 0.f : a_ * __builtin_amdgcn_rcpf(1.f + __builtin_amdgcn_exp2f(-a_ * LOG2E)); } } while (0)
#define DN_S1_COMPUTE(cc) do { \
        int lane = lane0; asm volatile("" : "+v"(lane)); \
        const bool zero_wave_ = ((cc) == 0 && w < 6), rev_ = (dir == 1 && (cc) > 0); \
        const float be_c = be_nx, gc_c = wave_scan_incl(g_nx), egc_c = __expf(gc_c); \
        if (w == 0) { LAS float* tw_ = (LAS float*)(lds + (((cc) & 1) ? O_TAB2 : O_TAB)); const float gl_ = __int_as_float(__builtin_amdgcn_readlane(__float_as_int(gc_c), 63)); \
            tw_[lane] = gc_c; tw_[64 + lane] = egc_c; tw_[128 + lane] = __expf(gl_ - gc_c); tw_[192 + lane] = be_c; } \
        float be8_[8], beg8_[8]; \
        _Pragma("unroll") for (int m_ = 0; m_ < 8; ++m_) { const int i_ = 8 * w + (rev_ ? 7 - m_ : m_); \
            be8_[m_] = __int_as_float(__builtin_amdgcn_readlane(__float_as_int(be_c), i_)); beg8_[m_] = be8_[m_] * __int_as_float(__builtin_amdgcn_readlane(__float_as_int(egc_c), i_)); } \
        { float yq_[8][2], yk_[8][2]; \
          DN_CONV_(0, yq_); DN_CONV_(1, yk_); \
          float v_[16]; \
          _Pragma("unroll") for (int m_ = 0; m_ < 8; ++m_) { v_[m_] = yq_[m_][0] * yq_[m_][0] + yq_[m_][1] * yq_[m_][1]; v_[8 + m_] = yk_[m_][0] * yk_[m_][0] + yk_[m_][1] * yk_[m_][1]; } \
          { const int a32_ = (lane ^ 32) << 2; const bool up_ = (lane & 32) != 0; \
            _Pragma("unroll") for (int j_ = 0; j_ < 8; ++j_) { const float send_ = up_ ? v_[j_] : v_[j_ + 8], keep_ = up_ ? v_[j_ + 8] : v_[j_]; v_[j_] = keep_ + __int_as_float(__builtin_amdgcn_ds_bpermute(a32_, __float_as_int(send_))); } } \
          { const bool up_ = (lane & 16) != 0; \
            _Pragma("unroll") for (int j_ = 0; j_ < 4; ++j_) { const float send_ = up_ ? v_[j_] : v_[j_ + 4], keep_ = up_ ? v_[j_ + 4] : v_[j_]; v_[j_] = keep_ + swz_xor<16>(send_); } } \
          { const bool up_ = (lane & 8) != 0; \
            _Pragma("unroll") for (int j_ = 0; j_ < 2; ++j_) { const float send_ = up_ ? v_[j_] : v_[j_ + 2], keep_ = up_ ? v_[j_ + 2] : v_[j_]; v_[j_] = keep_ + swz_xor<8>(send_); } } \
          { const bool up_ = (lane & 4) != 0; const float send_ = up_ ? v_[0] : v_[1], keep_ = up_ ? v_[1] : v_[0]; v_[0] = keep_ + swz_xor<4>(send_); } \
          v_[0] += swz_xor<2>(v_[0]); v_[0] += swz_xor<1>(v_[0]); \
          _Pragma("unroll") for (int m_ = 0; m_ < 8; ++m_) { \
            const float sq_ = __int_as_float(__builtin_amdgcn_readlane(__float_as_int(v_[0]), ((m_ >> 2) & 1) * 16 + ((m_ >> 1) & 1) * 8 + (m_ & 1) * 4)); \
            const float sk_ = __int_as_float(__builtin_amdgcn_readlane(__float_as_int(v_[0]), 32 + ((m_ >> 2) & 1) * 16 + ((m_ >> 1) & 1) * 8 + (m_ & 1) * 4)); \
            const float rq_ = rsqrtf(sq_ + EPS) * 0.08838834764831845f, rk_ = rsqrtf(sk_ + EPS); \
            yk_[m_][0] *= rk_; yk_[m_][1] *= rk_; \
            yq_[m_][0] *= rq_; yq_[m_][1] *= rq_; } \
          _Pragma("unroll") for (int r_ = 0; r_ < 8; ++r_) { \
            iq[r_] = rev_ ? cvt_pk_bf16(yq_[7 - r_][0], yq_[7 - r_][1]) : cvt_pk_bf16(yq_[r_][0], yq_[r_][1]); ik[r_] = rev_ ? cvt_pk_bf16(yk_[7 - r_][0], yk_[7 - r_][1]) : cvt_pk_bf16(yk_[r_][0], yk_[r_][1]); } \
          _Pragma("unroll") for (int e_ = 0; e_ < 2; ++e_) _Pragma("unroll") for (int mm_ = 0; mm_ < 4; ++mm_) { \
            const int m0_ = rev_ ? 7 - 2 * mm_ : 2 * mm_, m1_ = rev_ ? 6 - 2 * mm_ : 2 * mm_ + 1; \
            const float k0_ = rev_ ? yk_[7 - 2 * mm_][e_] : yk_[2 * mm_][e_], k1_ = rev_ ? yk_[6 - 2 * mm_][e_] : yk_[2 * mm_ + 1][e_]; \
            const float b0_ = rev_ ? beg8_[7 - 2 * mm_] : beg8_[2 * mm_], b1_ = rev_ ? beg8_[6 - 2 * mm_] : beg8_[2 * mm_ + 1]; (void)m0_; (void)m1_; \
            ikg[e_][mm_] = cvt_pk_bf16(k0_ * b0_, k1_ * b1_); } } \
        asm volatile("" ::: "memory"); \
        { float yv_[8][2]; DN_CONV_(2, yv_); \
          _Pragma("unroll") for (int e_ = 0; e_ < 2; ++e_) _Pragma("unroll") for (int mm_ = 0; mm_ < 4; ++mm_) { \
            const float v0_ = rev_ ? yv_[7 - 2 * mm_][e_] * be8_[7 - 2 * mm_] : yv_[2 * mm_][e_] * be8_[2 * mm_], v1_ = rev_ ? yv_[6 - 2 * mm_][e_] * be8_[6 - 2 * mm_] : yv_[2 * mm_ + 1][e_] * be8_[2 * mm_ + 1]; \
            ivt[e_][mm_] = cvt_pk_bf16(v0_, v1_); } } } while (0)
    DN_LOAD_RAW(c_lo);
    DN_LOAD_BG(c_lo);
    DN_S1_COMPUTE(c_lo);
    __syncthreads();
    for (int c = c_lo; c < c_hi; ++c) {
        const bool rev = (dir == 1 && c > 0);
        LAS float* tab = (LAS float*)(lds + ((c & 1) ? O_TAB2 : O_TAB));

#if PROBE
        if (c == 32 && b == 0 && h == 0 && dir == 0 && tid0 == 0) ((volatile unsigned long long*)(B.ctl + 12288))[42] = wall_clock64();
#endif
        {
            int lane = lane0; asm volatile("" : "+v"(lane));
            if (c + 1 < c_hi) DN_LOAD_BG(c + 1);
#pragma unroll
            for (int r = 0; r < 8; ++r) { const int i = 8 * w + r;
                *(LAS unsigned*)(lds + O_Q + i * RS + 4 * lane) = iq[r];
                *(LAS unsigned*)(lds + O_K + i * RS + 4 * lane) = ik[r]; }
#pragma unroll
            for (int mm = 0; mm < 4; ++mm) { const int off = (2 * lane) * QS + (8 * w + 2 * mm) * 2;
                *(LAS unsigned*)(lds + O_KT + off) = (ik[2 * mm] & 0xFFFFu) | (ik[2 * mm + 1] << 16);
                *(LAS unsigned*)(lds + O_KT + off + QS) = (ik[2 * mm] >> 16) | (ik[2 * mm + 1] & 0xFFFF0000u);
                *(LAS unsigned*)(lds + O_KG + off) = ikg[0][mm]; *(LAS unsigned*)(lds + O_KG + off + QS) = ikg[1][mm];
                *(LAS unsigned*)(lds + O_VT + off) = ivt[0][mm]; *(LAS unsigned*)(lds + O_VT + off + QS) = ivt[1][mm]; }
        }
        __syncthreads();

#if PROBE
        if (c == 32 && b == 0 && h == 0 && dir == 0 && tid0 == 0) ((volatile unsigned long long*)(B.ctl + 12288))[43] = wall_clock64();
#endif
#if DN_PREFETCH == 1
        if (c + 1 < c_hi) DN_LOAD_RAW_T(c + 1, 0);
#endif
        {
            int lane = lane0; asm volatile("" : "+v"(lane));
            const int tsel = w >> 2, a = (w >> 1) & 1, bc = w & 1, r32 = lane & 31, hi = lane >> 5;
            if (tsel != 0) {} else if (!(a == 0 && bc == 1)) {
                f32x16 acc;
#pragma unroll
                for (int r = 0; r < 16; ++r) acc[r] = 0.f;
                const LAS unsigned char* Ai = lds + (tsel ? O_Q : O_K) + (32 * a + r32) * RS + hi * 16;
                const LAS unsigned char* Bi = lds + O_K + (32 * bc + r32) * RS + hi * 16;
#pragma unroll
                for (int s = 0; s < 8; ++s) { const bf16x8 af = *(const LAS bf16x8*)(Ai + s * 32), bf = *(const LAS bf16x8*)(Bi + s * 32);
                    acc = __builtin_amdgcn_mfma_f32_32x32x16_bf16(af, bf, acc, 0, 0, 0); }
                const int j = 32 * bc + r32; const float gcj = tab[j];
#pragma unroll
                for (int r = 0; r < 16; ++r) { const int i = 32 * a + crow32(r, hi); const float gci = tab[i];
                    const bool keep = tsel ? (j <= i) : (j < i);
                    float v = keep ? acc[r] * __expf(gci - gcj) : 0.f;
                    if (tsel == 0) Amat[i * LD + j] = v * tab[192 + i]; else *(LAS bf16_t*)(lds + O_QK + i * QS + j * 2) = f2bf(v); }
            } else {
                const int j = 32 + (lane & 31);
#pragma unroll
                for (int r = 0; r < 16; ++r) { const int i = crow32(r, lane >> 5);
                    if (tsel == 0) Amat[i * LD + j] = 0.f; else *(LAS bf16_t*)(lds + O_QK + i * QS + j * 2) = (bf16_t)0; }
            }
        }
        __syncthreads();

#if PROBE
        if (c == 32 && b == 0 && h == 0 && dir == 0 && tid0 == 0) ((volatile unsigned long long*)(B.ctl + 12288))[44] = wall_clock64();
#endif
        int tid = tid0; asm volatile("" : "+v"(tid));
        if (tid < 64) {
            const int k = tid >> 4, cc = tid & 15, r0 = 16 * k;
            float x[16];
#pragma unroll
            for (int i = 0; i < 16; ++i) { float a0 = (i == cc) ? 1.f : 0.f, a1 = 0.f;
#pragma unroll
                for (int j = 0; j < i; ++j) { const float av = Amat[(r0 + i) * LD + r0 + j]; if (j & 1) a1 = fmaf(-av, x[j], a1); else a0 = fmaf(-av, x[j], a0); }
                x[i] = a0 + a1;
                Tmat[(r0 + i) * LD + r0 + cc] = x[i]; *(LAS bf16_t*)(lds + O_TI + (r0 + i) * QS + (r0 + cc) * 2) = f2bf(x[i]); }
        }
        {
            int lane = lane0; asm volatile("" : "+v"(lane));
            const int tsel = w >> 2, a = (w >> 1) & 1, bc = w & 1, r32 = lane & 31, hi = lane >> 5;
            if (tsel != 1) {} else if (!(a == 0 && bc == 1)) {
                f32x16 acc;
#pragma unroll
                for (int r = 0; r < 16; ++r) acc[r] = 0.f;
                const LAS unsigned char* Ai = lds + (tsel ? O_Q : O_K) + (32 * a + r32) * RS + hi * 16;
                const LAS unsigned char* Bi = lds + O_K + (32 * bc + r32) * RS + hi * 16;
#pragma unroll
                for (int s = 0; s < 8; ++s) { const bf16x8 af = *(const LAS bf16x8*)(Ai + s * 32), bf = *(const LAS bf16x8*)(Bi + s * 32);
                    acc = __builtin_amdgcn_mfma_f32_32x32x16_bf16(af, bf, acc, 0, 0, 0); }
                const int j = 32 * bc + r32; const float gcj = tab[j];
#pragma unroll
                for (int r = 0; r < 16; ++r) { const int i = 32 * a + crow32(r, hi); const float gci = tab[i];
                    const bool keep = tsel ? (j <= i) : (j < i);
                    float v = keep ? acc[r] * __expf(gci - gcj) : 0.f;
                    if (tsel == 0) Amat[i * LD + j] = v * tab[192 + i]; else *(LAS bf16_t*)(lds + O_QK + i * QS + j * 2) = f2bf(v); }
            } else {
                const int j = 32 + (lane & 31);
#pragma unroll
                for (int r = 0; r < 16; ++r) { const int i = crow32(r, lane >> 5);
                    if (tsel == 0) Amat[i * LD + j] = 0.f; else *(LAS bf16_t*)(lds + O_QK + i * QS + j * 2) = (bf16_t)0; }
            }
        }
        __syncthreads();

#if PROBE
        if (c == 32 && b == 0 && h == 0 && dir == 0 && tid0 == 0) ((volatile unsigned long long*)(B.ctl + 12288))[45] = wall_clock64();
#endif
#if DN_PREFETCH == 1
        if (c + 1 < c_hi) DN_LOAD_RAW_T(c + 1, 1);
#endif
        {
            const int which = tid >> 8, i = (tid >> 4) & 15, cc = tid & 15, r0 = which * 32;
            float a0 = 0.f, a1 = 0.f;
#pragma unroll
            for (int j = 0; j < 16; j += 2) { a0 = fmaf(Amat[(r0 + 16 + i) * LD + r0 + j], Tmat[(r0 + j) * LD + r0 + cc], a0); a1 = fmaf(Amat[(r0 + 16 + i) * LD + r0 + j + 1], Tmat[(r0 + j + 1) * LD + r0 + cc], a1); }
            Pmat[(which * 16 + i) * 17 + cc] = a0 + a1;
        }
        __syncthreads();
        {
            const int which = tid >> 8, i = (tid >> 4) & 15, cc = tid & 15, r0 = which * 32;
            float a0 = 0.f, a1 = 0.f;
#pragma unroll
            for (int j = 0; j < 16; j += 2) { a0 = fmaf(Tmat[(r0 + 16 + i) * LD + r0 + 16 + j], Pmat[(which * 16 + j) * 17 + cc], a0); a1 = fmaf(Tmat[(r0 + 16 + i) * LD + r0 + 16 + j + 1], Pmat[(which * 16 + j + 1) * 17 + cc], a1); }
            const float v = -(a0 + a1);
            Tmat[(r0 + 16 + i) * LD + r0 + cc] = v; *(LAS bf16_t*)(lds + O_TI + (r0 + 16 + i) * QS + (r0 + cc) * 2) = f2bf(v);
        }
        __syncthreads();
        {
            const int i = tid >> 4, c0 = (tid & 15) * 2;
            float a0 = 0.f, a1 = 0.f;
#pragma unroll
            for (int j = 0; j < 32; ++j) { const float av = Amat[(32 + i) * LD + j]; a0 = fmaf(av, Tmat[j * LD + c0], a0); a1 = fmaf(av, Tmat[j * LD + c0 + 1], a1); }
            Pmat[i * 33 + c0] = a0; Pmat[i * 33 + c0 + 1] = a1;
        }
        __syncthreads();
        {
            const int i = tid >> 4, c0 = (tid & 15) * 2;
            float a0 = 0.f, a1 = 0.f;
#pragma unroll
            for (int j = 0; j < 32; ++j) { const float tv = Tmat[(32 + i) * LD + 32 + j]; a0 = fmaf(tv, Pmat[j * 33 + c0], a0); a1 = fmaf(tv, Pmat[j * 33 + c0 + 1], a1); }
            Tmat[(32 + i) * LD + c0] = -a0; Tmat[(32 + i) * LD + c0 + 1] = -a1;
            *(LAS unsigned*)(lds + O_TI + (32 + i) * QS + c0 * 2) = cvt_pk_bf16(-a0, -a1);
        }
        __syncthreads();

#if PROBE
        if (c == 32 && b == 0 && h == 0 && dir == 0 && tid0 == 0) ((volatile unsigned long long*)(B.ctl + 12288))[46] = wall_clock64();
#endif
#if DN_PREFETCH == 1
        if (c + 1 < c_hi) DN_LOAD_RAW_T(c + 1, 2);
#endif
        {
            int lane = lane0; asm volatile("" : "+v"(lane)); const int n16 = lane & 15, q4 = lane >> 4;
#pragma unroll
            for (int tt = 0; tt < 2; ++tt) {
                const int t = 2 * w + tt;
                const LAS unsigned char* arow = lds + (t < 8 ? O_KG + (16 * t + n16) * QS : O_VT + (16 * (t - 8) + n16) * QS) + q4 * 16;
                bf16x8 af[2];
#pragma unroll
                for (int s = 0; s < 2; ++s) af[s] = cat4(*(const LAS bf16x4*)(arow + s * 64), *(const LAS bf16x4*)(arow + s * 64 + 8));
#pragma unroll
                for (int it = 0; it < 4; ++it) {
                    f32x4 acc = (f32x4){0.f, 0.f, 0.f, 0.f};
                    const LAS unsigned char* brow = lds + O_TI + (16 * it + n16) * QS + q4 * 16;
#pragma unroll
                    for (int s = 0; s < 2; ++s) { const bf16x8 bf = cat4(*(const LAS bf16x4*)(brow + s * 64), *(const LAS bf16x4*)(brow + s * 64 + 8));
                        acc = __builtin_amdgcn_mfma_f32_16x16x32_bf16(af[s], bf, acc, 0, 0, 0); }
                    LAS unsigned char* dst = lds + (t < 8 ? O_KB + (16 * it + n16) * RS + (16 * t + 4 * q4) * 2 : O_VB + (16 * it + n16) * RS + (16 * (t - 8) + 4 * q4) * 2);
                    *(LAS u32x2*)dst = (u32x2){cvt_pk_bf16(acc[0], acc[1]), cvt_pk_bf16(acc[2], acc[3])};
                }
            }
        }
        __syncthreads();

#if PROBE
        if (c == 32 && b == 0 && h == 0 && dir == 0 && tid0 == 0) ((volatile unsigned long long*)(B.ctl + 12288))[47] = wall_clock64();
#endif
        auto s4_stage = [&]() __attribute__((always_inline)) {
            int lane = lane0; asm volatile("" : "+v"(lane)); const int n16 = lane & 15, q4 = lane >> 4;
            bf16x8 Sb[4];
#pragma unroll
            for (int s = 0; s < 4; ++s) { const u32x4 wv = {cvt_pk_bf16(St[2 * s][0], St[2 * s][1]), cvt_pk_bf16(St[2 * s][2], St[2 * s][3]), cvt_pk_bf16(St[2 * s + 1][0], St[2 * s + 1][1]), cvt_pk_bf16(St[2 * s + 1][2], St[2 * s + 1][3])};
                Sb[s] = *reinterpret_cast<const bf16x8*>(&wv); }
            f32x4 U[4], Q[4];
#pragma unroll
            for (int a = 0; a < 4; ++a) { U[a] = (f32x4){0.f, 0.f, 0.f, 0.f}; Q[a] = (f32x4){0.f, 0.f, 0.f, 0.f}; }
#pragma unroll
            for (int a = 0; a < 4; ++a)
#pragma unroll
                for (int s = 0; s < 4; ++s) {
                    const LAS unsigned char* pk = lds + O_KB + (16 * a + n16) * RS + (32 * s + 4 * q4) * 2;
                    const LAS unsigned char* pq = lds + O_Q + (16 * a + n16) * RS + (32 * s + 4 * q4) * 2;
                    const bf16x8 ak = cat4(*(const LAS bf16x4*)pk, *(const LAS bf16x4*)(pk + 32));
                    const bf16x8 aq = cat4(*(const LAS bf16x4*)pq, *(const LAS bf16x4*)(pq + 32));
                    U[a] = __builtin_amdgcn_mfma_f32_16x16x32_bf16(ak, Sb[s], U[a], 0, 0, 0);
                    Q[a] = __builtin_amdgcn_mfma_f32_16x16x32_bf16(aq, Sb[s], Q[a], 0, 0, 0);
                }
            f32x4 Vn[4];
#pragma unroll
            for (int a = 0; a < 4; ++a)
#pragma unroll
                for (int r = 0; r < 4; ++r) { const int i = 16 * a + 4 * q4 + r;
                    const float val = bf2f(*(const LAS bf16_t*)(lds + O_VB + i * RS + (16 * w + n16) * 2));
                    Vn[a][r] = val - U[a][r]; Q[a][r] *= tab[64 + i]; }
            bf16x8 Vb[2], Vs[2];
#pragma unroll
            for (int s = 0; s < 2; ++s) {
                float e0[4], e1[4];
#pragma unroll
                for (int r = 0; r < 4; ++r) { e0[r] = tab[128 + 32 * s + 4 * q4 + r]; e1[r] = tab[128 + 32 * s + 16 + 4 * q4 + r]; }
                const u32x4 w0 = {cvt_pk_bf16(Vn[2 * s][0], Vn[2 * s][1]), cvt_pk_bf16(Vn[2 * s][2], Vn[2 * s][3]), cvt_pk_bf16(Vn[2 * s + 1][0], Vn[2 * s + 1][1]), cvt_pk_bf16(Vn[2 * s + 1][2], Vn[2 * s + 1][3])};
                const u32x4 w1 = {cvt_pk_bf16(Vn[2 * s][0] * e0[0], Vn[2 * s][1] * e0[1]), cvt_pk_bf16(Vn[2 * s][2] * e0[2], Vn[2 * s][3] * e0[3]),
                                  cvt_pk_bf16(Vn[2 * s + 1][0] * e1[0], Vn[2 * s + 1][1] * e1[1]), cvt_pk_bf16(Vn[2 * s + 1][2] * e1[2], Vn[2 * s + 1][3] * e1[3])};
                Vb[s] = *reinterpret_cast<const bf16x8*>(&w0); Vs[s] = *reinterpret_cast<const bf16x8*>(&w1);
            }
#pragma unroll
            for (int a = 0; a < 4; ++a)
#pragma unroll
                for (int s = 0; s < 2; ++s) {
                    const LAS unsigned char* pa = lds + O_QK + (16 * a + n16) * QS + (32 * s + 4 * q4) * 2;
                    const bf16x8 af = cat4(*(const LAS bf16x4*)pa, *(const LAS bf16x4*)(pa + 32));
                    Q[a] = __builtin_amdgcn_mfma_f32_16x16x32_bf16(af, Vb[s], Q[a], 0, 0, 0);
                }
            const float egl = tab[64 + 63];
#pragma unroll
            for (int t = 0; t < 8; ++t) {
                St[t] *= egl;
#pragma unroll
                for (int s = 0; s < 2; ++s) {
                    const LAS unsigned char* pa = lds + O_KT + (16 * t + n16) * QS + (32 * s + 4 * q4) * 2;
                    const bf16x8 af = cat4(*(const LAS bf16x4*)pa, *(const LAS bf16x4*)(pa + 32));
                    St[t] = __builtin_amdgcn_mfma_f32_16x16x32_bf16(af, Vs[s], St[t], 0, 0, 0);
                }
            }
#pragma unroll
            for (int a = 0; a < 4; ++a)
#pragma unroll
                for (int r = 0; r < 4; ++r) { const int i = 16 * a + 4 * q4 + r; const int lp = rev ? (4223 - 64 * c - i) : (64 * c + i);
                    outp0[(size_t)lp * 512 + n16] = f2bf(Q[a][r]); }
        };
#if DN_SWAP
        if (w < 4) { s4_stage(); if (c + 1 < c_hi) DN_S1_COMPUTE(c + 1); }
        else       { if (c + 1 < c_hi) DN_S1_COMPUTE(c + 1); s4_stage(); }
#else
        s4_stage(); if (c + 1 < c_hi) DN_S1_COMPUTE(c + 1);
#endif
        __syncthreads();
#if PROBE
        if (c == 32 && b == 0 && h == 0 && dir == 0 && tid0 == 0) ((volatile unsigned long long*)(B.ctl + 12288))[48] = wall_clock64();
#endif
    }
    if (c_hi < 65) {
        int tl = tid0; asm volatile("" : "+v"(tl)); float* sp = stbuf + tl;
#pragma unroll
        for (int t = 0; t < 8; ++t)
#pragma unroll
            for (int r = 0; r < 4; ++r) sp[(t * 4 + r) * NWG_THREADS] = St[t][r];
    }
#undef DN_LOAD_RAW
#undef DN_LOAD_RAW_T
#undef DN_LOAD_BG
}
}
constexpr int NHALF = NB >= 2 ? 2 : 1, BPH = NB / NHALF, CAP = BPH * L;
constexpr int CW_MOECNT = 8192, CW_KFLAG = 10240;

__device__ __forceinline__ void norm_router_rows(CParams& p, int wg, int nwg, LAS unsigned char* lds, int nMm, int SPLIT, const int wave_idx_) {
    auto& B = p.b;
    int tid_ = fresh_tid(); asm volatile("" : "+v"(tid_));
    const int tid = tid_, lane = tid & 63, wv = tid >> 6;
    LAS float* Wr = (LAS float*)lds;
    { const float* rw = p.in[24];
      for (int i = tid; i < 8192; i += NWG_THREADS) { const int d = i >> 3, e = i & 7; Wr[e * 1024 + d] = rw[i]; } }
    __syncthreads();
    const float* w = p.in[20] + D;
    int kr = 0, ke0 = 0, ke1 = 0; float kg0 = 0.f, kg1 = 0.f; int nk = 0;
    for (int row = wg * 8 + wv; row < MP; row += nwg * 8) {
        float* hp = hf_row(B.Hout, B.Hside, row); f32x4 v[4]; float ss = 0.f;
        const bool fix = SPLIT > 0 && row >= nMm * 256 && row_valid(row);
#pragma unroll
        for (int j = 0; j < 4; ++j) { v[j] = *(const f32x4*)(hp + j * 256 + lane * 4);
            if (fix) { const float* pp = B.PART + ((size_t)((row / 256 - nMm) * 4 + j) * SPLIT) * 65536 + (size_t)(row % 256) * 256 + lane * 4;
                for (int sp = 0; sp < SPLIT; ++sp) v[j] += *(const f32x4*)(pp + (size_t)sp * 65536);
                *(f32x4*)(hp + j * 256 + lane * 4) = v[j]; }
            ss += v[j][0] * v[j][0] + v[j][1] * v[j][1] + v[j][2] * v[j][2] + v[j][3] * v[j][3]; }
        ss = wave_sum(ss);
        const float rs = rsqrtf(ss * (1.f / D) + EPS);
        float lg[8];
#pragma unroll
        for (int e = 0; e < 8; ++e) lg[e] = 0.f;
#pragma unroll
        for (int j = 0; j < 4; ++j) { const f32x4 g = *(const f32x4*)(w + j * 256 + lane * 4);
            f32x4 u; u[0] = v[j][0] * rs * g[0]; u[1] = v[j][1] * rs * g[1]; u[2] = v[j][2] * rs * g[2]; u[3] = v[j][3] * rs * g[3];
            *(u32x2*)(B.Ub + (size_t)row * D + j * 256 + lane * 4) = (u32x2){cvt_pk_bf16(u[0], u[1]), cvt_pk_bf16(u[2], u[3])};
#pragma unroll
            for (int e = 0; e < 8; ++e) { const f32x4 wr4 = *(const LAS f32x4*)(Wr + e * 1024 + j * 256 + lane * 4);
                lg[e] += u[0] * wr4[0] + u[1] * wr4[1] + u[2] * wr4[2] + u[3] * wr4[3]; } }
#pragma unroll
        for (int e = 0; e < 8; ++e) lg[e] = wave_sum(lg[e]);
        int i0 = 0; float v0 = lg[0];
#pragma unroll
        for (int e = 1; e < 8; ++e) if (lg[e] > v0) { v0 = lg[e]; i0 = e; }
        int i1 = -1; float v1 = -3e38f;
#pragma unroll
        for (int e = 0; e < 8; ++e) if (e != i0 && lg[e] > v1) { v1 = lg[e]; i1 = e; }
        const float e1 = __expf(v1 - v0), g0 = 1.f / (1.f + e1), g1 = e1 / (1.f + e1);
        if (row_valid(row)) { if (lane == nk) { kr = row; ke0 = i0; ke1 = i1; kg0 = g0; kg1 = g1; } ++nk; }
    }
    const bool have = lane < nk; const int hfl = have ? (kr / LP) / BPH : -1;
    const unsigned long long lt = (1ull << lane) - 1ull;
#pragma unroll
    for (int hf = 0; hf < NHALF; ++hf)
#pragma unroll
        for (int e = 0; e < 8; ++e) {
            const bool m0 = have && hfl == hf && ke0 == e, m1 = have && hfl == hf && ke1 == e;
            const unsigned long long b0 = __ballot(m0), b1 = __ballot(m1);
            const int n0 = __popcll(b0), n = n0 + __popcll(b1);
            if (n) {
                unsigned base = 0u;
                if (lane == 0) base = __hip_atomic_fetch_add(B.ctl + CW_MOECNT + (hf * 8 + e) * 64, (unsigned)n, __ATOMIC_RELAXED, __HIP_MEMORY_SCOPE_AGENT);
                base = (unsigned)__builtin_amdgcn_readfirstlane((int)base);
                if (m0) { const size_t pos = (size_t)(hf * 8 + e) * CAP + base + __popcll(b0 & lt); B.LST[pos] = kr * 2; B.GL[pos] = kg0; }
                if (m1) { const size_t pos = (size_t)(hf * 8 + e) * CAP + base + n0 + __popcll(b1 & lt); B.LST[pos] = kr * 2 + 1; B.GL[pos] = kg1; }
            }
        }
}
__device__ __forceinline__ void moe_combine(CParams& p, int hf, int wg, int nwg, const int wave_idx_) {
    auto& B = p.b;
    int tid_ = fresh_tid(); asm volatile("" : "+v"(tid_));
    const int lane = tid_ & 63, wv = tid_ >> 6;
    for (int t = wg * 8 + wv; t < CAP; t += nwg * 8) {
        const int bl = t / L, pos = t - bl * L; const int row = (hf * BPH + bl) * LP + PADF + pos;
        float* hp = hf_row(B.Hout, B.Hside, row); const bf16_t* yp = B.YS1 + (size_t)t * D;
#pragma unroll
        for (int j = 0; j < 2; ++j) { float y[8]; unpack8(*(const u32x4*)(yp + j * 512 + lane * 8), y);
            f32x4* h0 = (f32x4*)(hp + j * 512 + lane * 8); f32x4 a = h0[0], c = h0[1];
            a[0] += y[0]; a[1] += y[1]; a[2] += y[2]; a[3] += y[3]; c[0] += y[4]; c[1] += y[5]; c[2] += y[6]; c[3] += y[7];
            h0[0] = a; h0[1] = c; }
    }
}
constexpr int LDS_STAGE = 131072, MISC_OFF = LDS_MISC_OFF, LDS_BYTES = MISC_OFF + 2048 + 1024;
static_assert(dn::O_END <= MISC_OFF && dn::O_TAB2 + 1024 <= LDS_BYTES && pg8::STAGE_BYTES <= MISC_OFF && LDS_BYTES <= 163840, "LDS map");
constexpr int PH_PROLOGUE = 0, PH_LAYER0 = 1, PH_PER_LAYER = 16, PH_FINAL = PH_LAYER0 + 2 * PH_PER_LAYER, PH_END = PH_FINAL + 1;
constexpr int DN_C1 = 5, DN_C2 = 5; constexpr bool DN_SKIP_MLA = true;
constexpr int PL_NORM1 = 0, PL_INPROJ = 1, PL_PREP = 2, PL_MLAUP = 3, PL_MLAFIN = 4, PL_MIXER = 5, PL_POST = 6, PL_OUTPROJ = 7, PL_NORM2 = 8, PL_FFN1 = 9, PL_FFN2 = 10, PL_COMB = 11, PL_FFN1B = 12, PL_FFN2B = 13, PL_COMBB = 14;

__device__ __forceinline__ int opq(int v) { asm volatile("" : "+s"(v)); return v; }
__device__ __forceinline__ bool in_phase(int lo, int hi, int k) { asm volatile("" : "+s"(lo), "+s"(hi)); return lo <= k && k < hi; }
__global__ void __launch_bounds__(NWG_THREADS, 2) mega(Params p_) {
    extern __shared__ __attribute__((aligned(16))) unsigned char lds_raw[];
    LAS unsigned char* lds = (LAS unsigned char*)lds_raw;
    volatile LAS unsigned* misc = (volatile LAS unsigned*)(lds + MISC_OFF);
    const int wave_idx_ = __builtin_amdgcn_readfirstlane((int)threadIdx.x >> 6);
    const int tid = fresh_tid();
    if (tid < 64) misc[tid] = 0u;
    __syncthreads();
#if PROBE
    if ((tid & 63) == 0) misc[24 + (tid >> 6)] = (unsigned)__builtin_amdgcn_s_getreg(((2 - 1) << 11) | (4 << 6) | 4);
    __syncthreads();
#endif
    const int G0 = gridDim.x; const int bx0 = blockIdx.x;
    XcdBarrier bar; bar.bar = p_.b.ctl; bar.x = 0; bar.st = misc + 8;
    const int fused = p_.fused;
    if (fused) bar = xcd_barrier_post(p_.b.ctl, misc + 8);
    const int lo = p_.ph_lo, hi = p_.ph_hi;
#if PROBE
    if (bx0 == 0 && fresh_tid() == 0) ((volatile unsigned long long*)(p_.b.ctl + 12288))[0] = wall_clock64();
#endif
#define IN(k) in_phase(lo, hi, (k))
#if PROBE
#define SEAM(k) do { if (fused && IN((k) + 1)) xcd_barrier(bar); if (bx0 == 0 && fresh_tid() == 0) ((volatile unsigned long long*)(p_.b.ctl + 12288))[(k) + 1] = wall_clock64(); } while (0)
#else
#define SEAM(k) do { if (fused && IN((k) + 1)) xcd_barrier(bar); } while (0)
#endif

    if (IN(PH_PROLOGUE)) { CParams& p = *opaque_params(); auto& B = p.b; const int bx = opq(bx0), G = opq(G0); (void)B; (void)bx; (void)G;
        for (int job = 0; job < 7; ++job) {
            int mode, ldsrc, K, N, lddst; const float* src; bf16_t* dst;
            if (job < 2)      { mode = 1; src = p.in[4] + (size_t)job * D * 4048; ldsrc = 4048; K = D; N = 4096; dst = B.WinT + (size_t)job * 4096 * D; lddst = D; }
            else if (job < 4) { mode = 0; src = p.in[19] + (size_t)(job - 2) * DMIX * D; ldsrc = D; K = DMIX; N = D; dst = B.WoutT + (size_t)(job - 2) * D * DMIX; lddst = DMIX; }
            else if (job == 4) { mode = 2; src = p.in[21]; ldsrc = DFF; K = D; N = DFF; dst = B.WguT; lddst = D; }
            else if (job == 5) { mode = 3; src = p.in[22]; ldsrc = DFF; K = D; N = DFF; dst = B.WguT; lddst = D; }
            else               { mode = 0; src = p.in[23]; ldsrc = D; K = DFF; N = D; dst = B.WdT; lddst = DFF; }
            xpose_convert(mode, lds, src, ldsrc, K, N, dst, lddst, bx, G, wave_idx_);
        }
        build_wu(p, bx, G, wave_idx_);
        if (bx == 0 && tid < 64) {
            for (int l = 0; l < 2; ++l) { const float* lp = p.in[11] + l * 256;
                const float a = wave_sum(lp[tid] * lp[64 + tid]), c = wave_sum(lp[128 + tid] * lp[192 + tid]);
                if (tid == 0) B.misc[l] = __expf(a) - __expf(c) + (0.8f - 0.6f * __expf(-0.3f * (float)l)); }
        }
        build_rows(p.in[0], p.in[1], p.in[3], B.Hout, B.Hside, B.Ub, bx, G, wave_idx_);
        SEAM(PH_PROLOGUE);
    }
    for (int l = 0; l < 2; ++l) {
        const int pb = PH_LAYER0 + l * PH_PER_LAYER;
        if (l > 0 && IN(pb + PL_NORM1)) { CParams& p = *opaque_params(); auto& B = p.b; const int bx = opq(bx0), G = opq(G0); (void)B; (void)bx; (void)G;
            norm_rows(B.Hout, B.Hside, p.in[3] + (size_t)l * D, B.Ub, bx, G, B.PART, p.nmm_ffn, p.nmm_ffn < MP / 256 ? 2 : 0, wave_idx_);
            SEAM(pb + PL_NORM1);
        }
        if (IN(pb + PL_INPROJ)) { CParams& p = *opaque_params(); auto& B = p.b; const int bx = opq(bx0), G = opq(G0); (void)B; (void)bx; (void)G;
            pg8::StaticOrder S; S.init(MP / 256, 16, G, bx, B.Ub, D, B.WinT + (size_t)l * 4096 * D, D);
            pg8::EpiBf16 E; E.O = B.G1; E.ldc = 1536; E.route = 1;
            E.R[0] = B.G1; E.rld[0] = 1536; E.R[1] = B.G2; E.rld[1] = 512; E.R[2] = B.G3; E.rld[2] = 1536; E.R[3] = B.G4; E.rld[3] = 512;
            E.rt0[0] = 0; E.rt0[1] = 6; E.rt0[2] = 8; E.rt0[3] = 14; E.rt0[4] = 16;
            pg8::gemm_phase<pg8::EpiBf16, pg8::StaticOrder, false>(lds, D, D, S, E, wave_idx_);
            SEAM(pb + PL_INPROJ);
        }
        if (IN(pb + PL_PREP)) { CParams& p = *opaque_params(); auto& B = p.b; const int bx = opq(bx0), G = opq(G0); (void)B; (void)bx; (void)G; prep_rows(p, l, bx, G, wave_idx_); SEAM(pb + PL_PREP); }
        for (int sp_ = PL_MLAUP; sp_ <= PL_MIXER; ++sp_) { const int sp = opq(sp_); if (!IN(pb + sp)) continue;
            CParams& p = *opaque_params(); auto& B = p.b; const int bx = opq(bx0), G = opq(G0); (void)B; (void)bx; (void)G;
            const bool split = G >= 2 * NB * 8;
            { int c_lo = 0, c_hi = (sp == PL_MIXER) ? 65 : 0;
              if (split) { c_lo = sp == PL_MLAUP ? 0 : sp == PL_MLAFIN ? DN_C1 : DN_C2; c_hi = sp == PL_MLAUP ? DN_C1 : sp == PL_MLAFIN ? DN_C2 : 65; }
              if (c_hi > c_lo) for (int it = bx; it < NB * 8; it += G) dn::dn_item(p, l, it >> 3, (it >> 1) & 3, it & 1, c_lo, c_hi, B.PART + (size_t)it * 32 * NWG_THREADS, lds, wave_idx_); }
            const bool dnph = split && (sp == PL_MLAUP ? DN_C1 > 0 : DN_C2 > DN_C1);
            const bool worker = !dnph || bx >= NB * 8; const int wb = dnph ? bx - NB * 8 : bx, wG = dnph ? G - NB * 8 : G;
            if (sp == PL_MLAUP) { if (worker) {
                pg8::StaticOrder S; S.init(MP / 256, 8, wG, wb, B.G4, 512, B.WuT + (size_t)l * 2048 * 384, 384);
                pg8::EpiBf16 E; E.O = B.MLX; E.ldc = 2048; E.route = 0;
                E.R[0] = E.R[1] = E.R[2] = E.R[3] = B.MLX; E.rld[0] = E.rld[1] = E.rld[2] = E.rld[3] = 2048; E.rt0[0] = E.rt0[1] = E.rt0[2] = E.rt0[3] = E.rt0[4] = 0;
                pg8::gemm_phase<pg8::EpiBf16, pg8::StaticOrder, false>(lds, 512, 384, S, E, wave_idx_); }
            } else if (sp == PL_MLAFIN) { if (worker) mla_finalize(p, l, wb, wG, wave_idx_);
            } else {
            unsigned* qctr = B.ctl + 4096 + l * 256;
            const int n_att = NB * 4 * 17;
#if PROBE
            if (l == 0 && bx0 == 0 && fresh_tid() == 0) ((volatile unsigned long long*)(p_.b.ctl + 12288))[40] = wall_clock64();
#endif
#if PROBE
            if (l == 0 && bx0 == 100 && fresh_tid() == 0) ((volatile unsigned long long*)(p_.b.ctl + 12288))[54] = wall_clock64();
#endif
            for (;;) {
                __syncthreads();
                if (tid == 0) misc[16] = atomicAdd(qctr, 1u);
                __syncthreads();
                const int u = (int)misc[16];
                if (u >= n_att) break;
                int qb, bh; if (u < NB * 4 * 16) { qb = u & 15; bh = u >> 4; } else { qb = 16; bh = u - NB * 4 * 16; }
                const int h = bh & 3, b = bh >> 2;
                diff_unit(p, l, b, h, qb, lds, wave_idx_);
            }
#if PROBE
            if (l == 0 && bx0 == 100 && fresh_tid() == 0) ((volatile unsigned long long*)(p_.b.ctl + 12288))[55] = wall_clock64();
#endif
            if (!(split && bx < NB * 8 && DN_SKIP_MLA))
            for (;;) {
                __syncthreads();
                if (tid == 0) misc[16] = atomicAdd(qctr + 64, 1u);
                __syncthreads();
                const int u = (int)misc[16];
                if (u >= n_att) break;
                int qb, bh; if (u < NB * 4 * 16) { qb = u & 15; bh = u >> 4; } else { qb = 16; bh = u - NB * 4 * 16; }
                const int h = bh & 3, b = bh >> 2;
                mla_unit(p, b, h, qb, lds, wave_idx_);
            }
#if PROBE
            if (l == 0 && bx0 == 100 && fresh_tid() == 0) ((volatile unsigned long long*)(p_.b.ctl + 12288))[41] = wall_clock64();
#endif
            }
            SEAM(pb + sp);
        }
        if (IN(pb + PL_POST)) { CParams& p = *opaque_params(); auto& B = p.b; const int bx = opq(bx0), G = opq(G0); (void)B; (void)bx; (void)G; post_mixer(p, l, bx, G, wave_idx_); SEAM(pb + PL_POST); }
        if (IN(pb + PL_OUTPROJ)) { CParams& p = *opaque_params(); auto& B = p.b; const int bx = opq(bx0), G = opq(G0); (void)B; (void)bx; (void)G;
            pg8::TailOrder S; S.init(MP / 256, 4, G, bx, B.G1, DMIX, B.WoutT + (size_t)l * D * DMIX, DMIX, 4, p.nmm_out);
            pg8::EpiResid E; E.Hout = B.Hout; E.Hside = B.Hside; E.PART = B.PART;
            pg8::gemm_phase<pg8::EpiResid, pg8::TailOrder, false>(lds, DMIX, DMIX, S, E, wave_idx_);
            if (l == 1 && !DEBUG_CHECK) moe_convert_queue(p, lds, misc, wave_idx_);
            SEAM(pb + PL_OUTPROJ);
        }
        if (IN(pb + PL_NORM2)) { CParams& p = *opaque_params(); auto& B = p.b; const int bx = opq(bx0), G = opq(G0); (void)B; (void)bx; (void)G;
            if (l == 0) norm_rows(B.Hout, B.Hside, p.in[20], B.Ub, bx, G, B.PART, p.nmm_out, p.nmm_out < MP / 256 ? 4 : 0, wave_idx_);
            else {
                moe_convert_queue(p, lds, misc, wave_idx_);
                __syncthreads();
                norm_router_rows(p, bx, G, lds, p.nmm_out, p.nmm_out < MP / 256 ? 4 : 0, wave_idx_);
            }
            SEAM(pb + PL_NORM2); }
        if (l == 0) {
            if (IN(pb + PL_FFN1)) { CParams& p = *opaque_params(); auto& B = p.b; const int bx = opq(bx0), G = opq(G0); (void)B; (void)bx; (void)G;
                pg8::StaticOrder S; S.init(MP / 256, DFF / 128, G, bx, B.Ub, D, B.WguT, D);
                pg8::EpiSwiglu E; E.O = B.ACT; E.ldc = DFF;
                pg8::gemm_phase<pg8::EpiSwiglu, pg8::StaticOrder, false>(lds, D, D, S, E, wave_idx_);
                SEAM(pb + PL_FFN1);
            }
            if (IN(pb + PL_FFN2)) { CParams& p = *opaque_params(); auto& B = p.b; const int bx = opq(bx0), G = opq(G0); (void)B; (void)bx; (void)G;
                pg8::TailOrder S; S.init(MP / 256, 4, G, bx, B.ACT, DFF, B.WdT, DFF, 2, p.nmm_ffn);
                pg8::EpiResid E; E.Hout = B.Hout; E.Hside = B.Hside; E.PART = B.PART;
                pg8::gemm_phase<pg8::EpiResid, pg8::TailOrder, false>(lds, DFF, DFF, S, E, wave_idx_);
                SEAM(pb + PL_FFN2);
            }
        } else {
            for (int hf = 0; hf < NHALF; ++hf) {
                const int po = pb + (hf == 0 ? PL_FFN1 : PL_FFN1B);
                if (IN(po)) { CParams& p = *opaque_params(); auto& B = p.b; const int bx = opq(bx0), G = opq(G0); (void)B; (void)bx; (void)G;
                    pg8::MoeSched S; S.init(B.ctl + CW_MOECNT + hf * 8 * 64, 2 * DFE / 256, G, bx, B.Ub, D, B.W1T, D, (size_t)2 * DFE * D, B.LST + (size_t)hf * 8 * CAP, B.GL + (size_t)hf * 8 * CAP, CAP, 1);
                    pg8::EpiSwiglu E; E.O = B.ACTM; E.ldc = DFE;
                    pg8::gemm_phase<pg8::EpiSwiglu, pg8::MoeSched, true>(lds, D, D, S, E, wave_idx_);
                    SEAM(po);
                }
                if (IN(po + 1)) { CParams& p = *opaque_params(); auto& B = p.b; const int bx = opq(bx0), G = opq(G0); (void)B; (void)bx; (void)G;
                    pg8::MoeSched S; S.init(B.ctl + CW_MOECNT + hf * 8 * 64, D / 256, G, bx, B.ACTM, DFE, B.W2T, DFE, (size_t)D * DFE, B.LST + (size_t)hf * 8 * CAP, B.GL + (size_t)hf * 8 * CAP, CAP, 0, p.kcap);
                    pg8::EpiMoeDown E; E.Hout = B.Hout; E.Hside = B.Hside; E.YS1 = B.YS1; E.b0 = hf * BPH; E.PK = B.PK;
                    pg8::gemm_phase<pg8::EpiMoeDown, pg8::MoeSched, false>(lds, DFE, DFE, S, E, wave_idx_);
                    SEAM(po + 1);
                }
                if (IN(po + 2)) { CParams& p = *opaque_params(); const int bx = opq(bx0), G = opq(G0);
                    if (p.kcap > 0) { auto& B = p.b;
                        pg8::MoeSched S; S.init(B.ctl + CW_MOECNT + hf * 8 * 64, D / 256, G, bx, B.ACTM, DFE, B.W2T, DFE, (size_t)D * DFE, B.LST + (size_t)hf * 8 * CAP, B.GL + (size_t)hf * 8 * CAP, CAP, 0, p.kcap);
                        pg8::moe_tail_fixup(S, B.Hout, B.Hside, B.YS1, hf * BPH, B.PK, bx, G, wave_idx_);
                        if (fused) xcd_barrier(bar); }
                    moe_combine(p, hf, bx, G, wave_idx_); SEAM(po + 2); }
            }
        }
    }
#if PROBE
    {
        xcd_barrier(bar);
        if (bx0 == 0 && fresh_tid() == 0) {
            const volatile unsigned long long* ts = (const volatile unsigned long long*)(p_.b.ctl + 12288);
            const unsigned long long d = (ts[PROBE_B + 1] - ts[PROBE_A]) * (unsigned long long)PROBE_C, t0 = wall_clock64();
            while (wall_clock64() - t0 < d) __builtin_amdgcn_s_sleep(32);
#if PROBE_D >= 1
            if (misc[24] == misc[24 + PROBE_D]) { const unsigned long long t1 = wall_clock64(); while (wall_clock64() - t1 < 200000ull) __builtin_amdgcn_s_sleep(32); }
#endif
        }
    }
#endif
#undef IN
#undef SEAM
}
}
namespace dbg {
__global__ void __launch_bounds__(256) k_cmp(const void* fast, int is_bf16, int ldf, int colf, const float* ref, int ldr, int colr, int cols, float refscale, float* acc, int frow0, int rrow0, int nrows) {
    __shared__ float s0[4], s1[4];
    float d2 = 0.f, r2 = 0.f;
    const size_t n = (size_t)nrows * cols;
    for (size_t i = (size_t)blockIdx.x * blockDim.x + threadIdx.x; i < n; i += (size_t)gridDim.x * blockDim.x) {
        const int pos = (int)(i / cols), c = (int)(i % cols);
        const size_t fo = (size_t)(frow0 + pos) * ldf + colf + c;
        const float a = is_bf16 ? fx::bf2f(((const fx::bf16_t*)fast)[fo]) : ((const float*)fast)[fo];
        const float b = ref[(size_t)(rrow0 + pos) * ldr + colr + c] * refscale;
        d2 += (a - b) * (a - b); r2 += b * b;
    }
    d2 = nv::wave_sum(d2); r2 = nv::wave_sum(r2);
    if ((threadIdx.x & 63) == 0) { s0[threadIdx.x >> 6] = d2; s1[threadIdx.x >> 6] = r2; }
    __syncthreads();
    if (threadIdx.x == 0) { atomicAdd(acc, s0[0] + s0[1] + s0[2] + s0[3]); atomicAdd(acc + 1, s1[0] + s1[1] + s1[2] + s1[3]); }
}
__global__ void k_setchk(float* acc, const float* v) { const float e = 1.f + log10f(fabsf(v[0]) + 1e-9f) * 0.25f; acc[0] = e * e; acc[1] = 1.f; }
__global__ void k_zero(float* p, int n) { const int i = blockIdx.x * blockDim.x + threadIdx.x; if (i < n) p[i] = 0.f; }
struct Thr { float t[128]; };
__global__ void k_encode(const float* acc, Thr thr, int nchk, float* sx) {
    if (threadIdx.x != 0 || blockIdx.x != 0) return;
    float s = 0.f, X = 0.f;
    for (int k = 0; k < nchk; ++k) {
        const float err = sqrtf(acc[2 * k] / fmaxf(acc[2 * k + 1], 1e-30f));
        const bool bad = !(err <= thr.t[k]);
        if (bad) { s = 0.1f * (float)(k + 1); X = 20.f + 100.f * fminf(err, 2.f); if (!(err == err)) X = 250.f; break; }
    }
    sx[0] = s; sx[1] = X;
}
__global__ void k_write_out_dbg(const float* __restrict__ H, float* __restrict__ out, const float* sx) {
    const size_t n = (size_t)nv::NB * nv::SEQ * nv::D; const float s = sx[0], X = sx[1];
    for (size_t i = (size_t)blockIdx.x * blockDim.x + threadIdx.x; i < n; i += (size_t)gridDim.x * blockDim.x) {
        const int d = (int)(i % nv::D); const size_t r = i / nv::D; const int sq = (int)(r % nv::SEQ), b = (int)(r / nv::SEQ);
        float v = H[((size_t)b * nv::L + nv::NM + sq) * nv::D + d] * (1.f + s);
        if (i == 0 && X != 0.f) v = X;
        out[i] = v;
    }
}
}

struct Region { unsigned char* base; size_t off, cap; };
static void* rtake(Region& r, size_t bytes) { void* p = r.base + r.off; r.off += (bytes + 255) & ~(size_t)255; return p; }

static void carve_fast(fx::Bufs& B, Region& r, float* out) {
    B.Hout = out;
    using namespace fx;
    B.ctl = (unsigned*)rtake(r, 65536);
    B.misc = (float*)rtake(r, 4096);
    B.PART = (float*)rtake(r, (size_t)32 * 256 * 256 * 4);
    B.Hside = (float*)rtake(r, (size_t)(NB * 64 + (MP - NB * LP) + 8) * D * 4);
    B.G1 = (bf16_t*)rtake(r, (size_t)MP * 1536 * 2);
    B.G2 = (bf16_t*)rtake(r, (size_t)MP * 512 * 2);
    B.G4 = (bf16_t*)rtake(r, (size_t)MP * 512 * 2);
    B.ODN = (bf16_t*)rtake(r, (size_t)2 * MP * 512 * 2);
    B.ACT = B.G1;
    B.WinT = (bf16_t*)rtake(r, (size_t)2 * 4096 * 1024 * 2);
    B.WuT = (bf16_t*)rtake(r, (size_t)2 * 2048 * 384 * 2);
    B.WoutT = (bf16_t*)rtake(r, (size_t)2 * 1024 * 1536 * 2);
    B.WguT = (bf16_t*)rtake(r, (size_t)5632 * 1024 * 2);
    B.WdT = (bf16_t*)rtake(r, (size_t)1024 * 2816 * 2);
    B.BG = (float*)rtake(r, (size_t)MP * 16 * 4);
    B.MLX = (bf16_t*)rtake(r, (size_t)MP * 2048 * 2);
    B.Ub = B.MLX;
    B.G3 = (bf16_t*)rtake(r, (size_t)MP * 1536 * 2);
    B.W1T = B.W2T = B.ACTM = B.YS1 = nullptr; B.LST = nullptr; B.GL = nullptr;
}
static int g_kcap = 0;
static void carve_moe_release(fx::Bufs& B, unsigned char* ws, size_t ws_size) {
    using namespace fx;
    unsigned char* a0 = (unsigned char*)B.G1; size_t o = 0;
    B.ACTM = (bf16_t*)(a0 + o); o += (size_t)136 * 256 * DFE * 2;
    B.YS1 = (bf16_t*)(a0 + o); o += (size_t)CAP * D * 2;
    if (a0 + o > (unsigned char*)B.MLX) fprintf(stderr, "moe overlay A too big\n");
    unsigned char* m0 = (unsigned char*)B.MLX + (size_t)MP * D * 2; o = 0;
    B.W2T = (bf16_t*)(m0 + o); o += (size_t)8 * D * DFE * 2;
    B.LST = (int*)(m0 + o); o += (size_t)NHALF * 8 * CAP * 4;
    B.GL = (float*)(m0 + o); o += (size_t)NHALF * 8 * CAP * 4;
    if (m0 + o > (unsigned char*)B.MLX + (size_t)MP * 2048 * 2) fprintf(stderr, "moe overlay MLX too big\n");
    B.W1T = (bf16_t*)B.G3;
    if ((unsigned char*)B.W1T + (size_t)8 * 2 * DFE * D * 2 > ws + ws_size) fprintf(stderr, "moe overlay W1T beyond workspace\n");
    unsigned char* k0 = (unsigned char*)B.W1T + (size_t)8 * 2 * DFE * D * 2; k0 += (256 - ((size_t)k0 & 255)) & 255;
    long long room = (long long)((ws + ws_size) - k0) / (256 * 256 * 4); if (room < 0) room = 0; if (room > 128) room = 128;
    B.PK = (float*)k0; g_kcap = (int)room;
}

static int g_grid = 0;
static int fast_setup() {
    if (g_grid) return g_grid;
    int dev = 0, cus = 0, per_cu = 0;
    if (hipGetDevice(&dev) != hipSuccess || hipDeviceGetAttribute(&cus, hipDeviceAttributeMultiprocessorCount, dev) != hipSuccess) { g_grid = -1; return g_grid; }
    if (hipFuncSetAttribute((const void*)fx::mega, hipFuncAttributeMaxDynamicSharedMemorySize, fx::LDS_BYTES) != hipSuccess) { fprintf(stderr, "hipFuncSetAttribute failed\n"); g_grid = -1; return g_grid; }
    if (hipOccupancyMaxActiveBlocksPerMultiprocessor(&per_cu, (const void*)fx::mega, fx::NWG_THREADS, fx::LDS_BYTES) != hipSuccess || per_cu < 1) { fprintf(stderr, "occupancy query: %d\n", per_cu); (void)hipGetLastError(); g_grid = -1; return g_grid; }
    (void)hipGetLastError();
    g_grid = cus;
    return g_grid;
}
static void launch_phases(const fx::Params& p0, int lo, int hi, int fused, hipStream_t stream) {
    fx::Params p = p0; p.ph_lo = lo; p.ph_hi = hi; p.fused = fused; p.pad = 0; p.kcap = g_kcap; p.pad2 = 0;
    p.nmm_out = fx::pg8::tail_main_tiles(fx::MP / 256, 4, g_grid, fx::DMIX / 64, 4); p.nmm_ffn = fx::pg8::tail_main_tiles(fx::MP / 256, 4, g_grid, fx::DFF / 64, 2);
    if (fused) hipMemsetAsync(p.b.ctl, 0, 65536, stream);
    hipLaunchKernelGGL(fx::mega, dim3(g_grid), dim3(fx::NWG_THREADS), fx::LDS_BYTES, stream, p);
}

extern "C" void kernel_launch(void* const* d_in, const int* in_sizes, int n_in, void* d_out, int out_size, void* d_ws, size_t ws_size, hipStream_t stream) {
    if (fast_setup() <= 0) return;
    fx::Params P{};
    for (int i = 0; i < 28; ++i) P.in[i] = (const float*)d_in[i];
    P.out = (float*)d_out;
#if !DEBUG_CHECK
    {
        Region r{(unsigned char*)d_ws, 0, ws_size};
        carve_fast(P.b, r, (float*)d_out);
        if (r.off > ws_size) { fprintf(stderr, "workspace too small: need %zu have %zu\n", r.off, ws_size); return; }
        carve_moe_release(P.b, (unsigned char*)d_ws, ws_size);
        launch_phases(P, 0, fx::PH_END, 1, stream);
    }
#else
    using namespace nv;
    const float* x = (const float*)d_in[0];
    const float* meta = (const float*)d_in[1];
    const float* rel_table = (const float*)d_in[2];
    const float* attn_norm_w = (const float*)d_in[3];
    const float* w_in = (const float*)d_in[4];
    const float* dn_conv_w = (const float*)d_in[5];
    const float* dn_a_log = (const float*)d_in[6];
    const float* dn_dt_bias = (const float*)d_in[7];
    const float* dn_norm_w = (const float*)d_in[8];
    const float* diff_q_norm_w = (const float*)d_in[9];
    const float* diff_k_norm_w = (const float*)d_in[10];
    const float* diff_lambda = (const float*)d_in[11];
    const float* diff_subln_w = (const float*)d_in[12];
    const float* mla_q_lat_norm_w = (const float*)d_in[13];
    const float* mla_w_uq = (const float*)d_in[14];
    const float* mla_kv_lat_norm_w = (const float*)d_in[15];
    const float* mla_w_ukv = (const float*)d_in[16];
    const float* mla_q_norm_w = (const float*)d_in[17];
    const float* mla_k_norm_w = (const float*)d_in[18];
    const float* w_out = (const float*)d_in[19];
    const float* ffn_norm_w = (const float*)d_in[20];
    const float* ffn_w_gate = (const float*)d_in[21];
    const float* ffn_w_up = (const float*)d_in[22];
    const float* ffn_w_down = (const float*)d_in[23];
    const float* router_w = (const float*)d_in[24];
    const float* moe_w_gate = (const float*)d_in[25];
    const float* moe_w_up = (const float*)d_in[26];
    const float* moe_w_down = (const float*)d_in[27];
    float* out = (float*)d_out;

    float* ws = (float*)d_ws; size_t off = 0;
    auto take = [&](size_t n) { float* p = ws + off; off += (n + 63) & ~(size_t)63; return p; };
    float* H = take((size_t)NB * L * D);
    float* U = take((size_t)L * D);
    float* PROJ = take((size_t)L * INC);
    float* QKVC = take((size_t)L * 1536);
    float* BETA = take((size_t)L * 8);
    float* GG = take((size_t)L * 8);
    float* ODN = take((size_t)2 * L * 512);
    float* Y = take((size_t)L * DMIX);
    float* DFQ = take((size_t)L * 512);
    float* DFK = take((size_t)L * 512);
    float* ODF = take((size_t)L * 512);
    float* CQN = take((size_t)L * 256);
    float* CKVN = take((size_t)L * 128);
    float* MLQ = take((size_t)L * 768);
    float* MLKV = take((size_t)L * 1024);
    float* QF = take((size_t)L * 768);
    float* KF = take((size_t)L * 768);
    float* LAM = take(64);
    float* GATE = take((size_t)L * 2);
    int* CNT = (int*)take(64);
    int* LIST = (int*)take((size_t)NE * L);
    float* CHK = take(256);
    float* THR = take(64);
    float* SX = take(64);
    float* S0 = take((size_t)L * L);
    float* S1 = take((size_t)L * L);
    float* FG = S0; float* FU = S1; float* XG = QKVC; float* YE = PROJ; float* YS = PROJ + (size_t)L * D;

    Region rf{(unsigned char*)d_out, (size_t)NBF * fx::SEQ * fx::D * 4, (size_t)out_size * 4};
    carve_fast(P.b, rf, (float*)d_out);
    if (rf.off > (size_t)out_size * 4) { fprintf(stderr, "debug carve too big: %zu\n", rf.off); return; }
    {
        unsigned char* a0 = (unsigned char*)U; size_t o = 0;
        P.b.W1T = (fx::bf16_t*)(a0 + o); o += (size_t)8 * 2 * fx::DFE * fx::D * 2;
        P.b.W2T = (fx::bf16_t*)(a0 + o); o += (size_t)8 * fx::D * fx::DFE * 2;
        if (a0 + o > (unsigned char*)LAM) fprintf(stderr, "debug moe weights overlay too big\n");
        unsigned char* s0 = (unsigned char*)S0; o = 0;
        P.b.ACTM = (fx::bf16_t*)(s0 + o); o += (size_t)48 * 256 * fx::DFE * 2;
        P.b.YS1 = (fx::bf16_t*)(s0 + o); o += (size_t)fx::CAP * fx::D * 2;
        P.b.LST = (int*)(s0 + o); o += (size_t)fx::NHALF * 8 * fx::CAP * 4;
        P.b.GL = (float*)(s0 + o); o += (size_t)fx::NHALF * 8 * fx::CAP * 4;
    }
    hipMemsetAsync(P.b.ctl, 0, 65536, stream);
    dbg::k_zero<<<1, 256, 0, stream>>>(CHK, 256);
    dbg::Thr h_thr{}; int nchk = 0;
    auto chk = [&](const void* fast, int is_bf16, int ldf, int colf, const float* ref, int ldr, int colr, int cols, float refscale, float thr) {
        dbg::k_cmp<<<512, 256, 0, stream>>>(fast, is_bf16, ldf, colf, ref, ldr, colr, cols, refscale, CHK + 2 * nchk, 48, 0, L);
        if (nchk < 127) { h_thr.t[nchk] = thr; ++nchk; }
    };
    auto chkH = [&](const float* Hb, float thr) {
        dbg::k_cmp<<<512, 256, 0, stream>>>(P.b.Hout, 0, 1024, 0, Hb, D, 0, D, 1.f, CHK + 2 * nchk, 0, NM, SEQ);
        if (nchk < 127) { h_thr.t[nchk] = thr; ++nchk; }
    };

    auto gemm = [&](bool tb, const float* A, int lda, const float* B, int ldb, float* C, int ldc, int M, int N, int K, const int* Mdev, int acc) {
        dim3 g((N + 63) / 64, (M + 63) / 64);
        if (tb) k_gemm<true><<<g, 256, 0, stream>>>(A, lda, B, ldb, C, ldc, M, N, K, Mdev, acc);
        else    k_gemm<false><<<g, 256, 0, stream>>>(A, lda, B, ldb, C, ldc, M, N, K, Mdev, acc);
    };
    auto rms = [&](const float* in, int in_ld, float* o, int out_ld, const float* w, int rows, int groups, int n, float scale) {
        const int waves = rows * groups; k_rmsnorm<<<(waves + 3) / 4, 256, 0, stream>>>(in, in_ld, o, out_ld, w, rows, groups, n, scale);
    };
    const int PB0 = fx::PH_LAYER0, PPL = fx::PH_PER_LAYER;
    const int DBG_MAXL = 1; const bool DBG_MOE = true; const int DBG_SLOT = 8; const bool DBG_PROBE = false;

    k_build_h<<<2048, 256, 0, stream>>>(x, meta, H);
    hipMemsetAsync(P.b.misc + 8, 0, 32, stream);
    launch_phases(P, fx::PH_PROLOGUE, fx::PH_PROLOGUE + 1, 0, stream);
    for (int l = 0; l < 2; ++l) {
        const float lam_init = 0.8f - 0.6f * expf(-0.3f * (float)l);
        k_lam<<<1, 64, 0, stream>>>(diff_lambda + l * 256, lam_init, LAM);
        for (int b = 0; b < NB; ++b) {
            const bool T = (b == 0) && (l <= DBG_MAXL);
            const int pb = PB0 + l * PPL;
            float* Hb = H + (size_t)b * L * D;
            rms(Hb, D, U, D, attn_norm_w + l * D, L, 1, D, 1.f);
            if (T) { if (l > 0) launch_phases(P, pb + fx::PL_NORM1, pb + fx::PL_NORM1 + 1, 0, stream);
                     if (l == 0) chkH(Hb, 1e-5f);
                     chk(P.b.Ub, 1, 1024, 0, U, D, 0, D, 1.f, 0.01f); }
            gemm(false, U, D, w_in + (size_t)l * D * INC, INC, PROJ, INC, L, INC, D, nullptr, 0);
            if (T) { launch_phases(P, pb + fx::PL_INPROJ, pb + fx::PL_INPROJ + 1, 0, stream);
                     chk(P.b.G1, 1, 1536, 0, PROJ, INC, 0, 1536, 1.f, 0.02f);
                     chk(P.b.G2, 1, 512, 0, PROJ, INC, C_DNZ, 512, 1.f, 0.02f);
                     chk(P.b.G3, 1, 1536, 0, PROJ, INC, C_DFQ, 1536, 1.f, 0.02f);
                     chk(P.b.G4, 1, 512, 0, PROJ, INC, C_MLQ, 448, 1.f, 0.02f);
                     chk(P.b.G4, 1, 512, 448, PROJ, INC, C_DNB, 16, 1.f, 0.02f); }
            k_dn_conv<<<2048, 256, 0, stream>>>(PROJ, dn_conv_w + l * 5 * 1536, QKVC);
            k_dn_l2<<<(L * 8 + 3) / 4, 256, 0, stream>>>(QKVC);
            k_dn_bg<<<(L * 8 + 255) / 256, 256, 0, stream>>>(PROJ, dn_a_log + l * 8, dn_dt_bias + l * 8, BETA, GG);
            k_dn_scan<<<8, 128, 0, stream>>>(QKVC, BETA, GG, ODN);
            k_dn_out<<<(L * 4 + 3) / 4, 256, 0, stream>>>(ODN, PROJ, dn_norm_w + l * 128, Y);
            rms(PROJ + C_DFQ, INC, DFQ, 512, diff_q_norm_w + l * 64, L, 8, 64, 1.f);
            rms(PROJ + C_DFK, INC, DFK, 512, diff_k_norm_w + l * 64, L, 8, 64, 1.f);
            for (int h = 0; h < 4; ++h) {
                gemm(true, DFQ + h * 128, 512, DFK + h * 128, 512, S0, L, L, L, 64, nullptr, 0);
                gemm(true, DFQ + h * 128 + 64, 512, DFK + h * 128 + 64, 512, S1, L, L, L, 64, nullptr, 0);
                k_diff_softmax<<<L, 256, 0, stream>>>(S0, S1, rel_table, h, LAM);
                gemm(false, S0, L, PROJ + C_DFV + h * 128, INC, ODF + h * 128, 512, L, 128, L, nullptr, 0);
            }
            rms(ODF, 512, Y + 512, DMIX, diff_subln_w + l * 128, L, 4, 128, 1.f - lam_init);
            rms(PROJ + C_MLQ, INC, CQN, 256, mla_q_lat_norm_w + l * 256, L, 1, 256, 1.f);
            rms(PROJ + C_MLKV, INC, CKVN, 128, mla_kv_lat_norm_w + l * 128, L, 1, 128, 1.f);
            gemm(false, CQN, 256, mla_w_uq + (size_t)l * 256 * 768, 768, MLQ, 768, L, 768, 256, nullptr, 0);
            gemm(false, CKVN, 128, mla_w_ukv + (size_t)l * 128 * 1024, 1024, MLKV, 1024, L, 1024, 128, nullptr, 0);
            k_mla_prep<<<(L * 8 + 3) / 4, 256, 0, stream>>>(MLQ, MLKV, PROJ, mla_q_norm_w + l * 192, mla_k_norm_w + l * 192, QF, KF);
            if (T) {
                launch_phases(P, pb + fx::PL_PREP, pb + fx::PL_PREP + 1, 0, stream);
                chk(P.b.G3, 1, 1536, 0, DFQ, 512, 0, 512, fx::DIFF_QSCALE, 0.02f);
                chk(P.b.G3, 1, 1536, 512, DFK, 512, 0, 512, 1.f, 0.02f);
                chk(P.b.G4, 1, 512, 0, CQN, 256, 0, 256, 1.f, 0.02f);
                chk(P.b.G4, 1, 512, 256, CKVN, 128, 0, 128, 1.f, 0.02f);
                chk(P.b.BG, 0, 16, 0, BETA, 8, 0, 8, 1.f, 0.02f);
                chk(P.b.BG, 0, 16, 8, GG, 8, 0, 8, 1.f, 0.02f);
                launch_phases(P, pb + fx::PL_MLAUP, pb + fx::PL_MLAFIN + 1, 1, stream);
                for (int h = 0; h < 4; ++h) {
                    chk(P.b.MLX, 1, 2048, 256 * h, QF, 768, 192 * h, 192, fx::MLA_QSCALE, 0.03f);
                    chk(P.b.MLX, 1, 2048, 256 * h + 192, KF, 768, 192 * h + 128, 64, 1.f, 0.03f);
                    chk(P.b.MLX, 1, 2048, 1024 + 256 * h, KF, 768, 192 * h, 128, 1.f, 0.03f);
                    chk(P.b.MLX, 1, 2048, 1024 + 256 * h + 128, MLKV, 1024, 256 * h + 128, 128, 1.f, 0.03f);
                }
            }
            for (int h = 0; h < 4; ++h) {
                gemm(true, QF + h * 192, 768, KF + h * 192, 768, S0, L, L, L, 192, nullptr, 0);
                k_softmax<<<L, 256, 0, stream>>>(S0, 0.07216878364870322f);
                gemm(false, S0, L, MLKV + h * 256 + 128, 1024, Y + 1024 + h * 128, DMIX, L, 128, L, nullptr, 0);
            }
            if (T) {
                launch_phases(P, pb + fx::PL_MIXER, pb + fx::PL_MIXER + 1, 1, stream);
                if (l == 0 && DBG_PROBE) { dbg::k_setchk<<<1, 1, 0, stream>>>(CHK + 2 * nchk, P.b.misc + DBG_SLOT); h_thr.t[nchk] = 0.f; ++nchk; }
                chk(P.b.ODN, 1, 512, 0, ODN, 512, 0, 512, 1.f, 0.03f);
                chk(P.b.ODN + (size_t)fx::MP * 512, 1, 512, 0, ODN + (size_t)L * 512, 512, 0, 512, 1.f, 0.03f);
                chk(P.b.G3, 1, 1536, 0, ODF, 512, 0, 512, 1.f, 0.03f);
                for (int h = 0; h < 4; ++h) chk(P.b.MLX, 1, 2048, 256 * h, Y, DMIX, 1024 + 128 * h, 128, 1.f, 0.03f);
            }
            if (T) { launch_phases(P, pb + fx::PL_POST, pb + fx::PL_POST + 1, 0, stream);
                     chk(P.b.G1, 1, 1536, 0, Y, DMIX, 0, 512, 1.f, 0.03f); chk(P.b.G1, 1, 1536, 512, Y, DMIX, 512, 512, 1.f, 0.03f); chk(P.b.G1, 1, 1536, 1024, Y, DMIX, 1024, 512, 1.f, 0.03f); }
            gemm(false, Y, DMIX, w_out + (size_t)l * DMIX * D, D, Hb, D, L, D, DMIX, nullptr, 1);
            if (T) { launch_phases(P, pb + fx::PL_OUTPROJ, pb + fx::PL_OUTPROJ + 1, 0, stream); chkH(Hb, 0.01f); }
            rms(Hb, D, U, D, ffn_norm_w + l * D, L, 1, D, 1.f);
            if (l == 0) {
                gemm(false, U, D, ffn_w_gate, DFF, FG, DFF, L, DFF, D, nullptr, 0);
                gemm(false, U, D, ffn_w_up, DFF, FU, DFF, L, DFF, D, nullptr, 0);
                k_swiglu_act<<<2048, 256, 0, stream>>>(FG, FU, DFF, DFF, L, nullptr);
                if (T) { launch_phases(P, pb + fx::PL_NORM2, pb + fx::PL_FFN1 + 1, 1, stream); chk(P.b.ACT, 1, DFF, 0, FG, DFF, 0, DFF, 1.f, 0.03f); }
                gemm(false, FG, DFF, ffn_w_down, D, Hb, D, L, D, DFF, nullptr, 1);
                if (T) { launch_phases(P, pb + fx::PL_FFN2, pb + fx::PL_FFN2 + 1, 0, stream); chkH(Hb, 0.01f); }
            } else {
                k_zero_int<<<1, 64, 0, stream>>>(CNT, 64);
                k_router<<<(L + 3) / 4, 256, 0, stream>>>(U, router_w, CNT, LIST, GATE);
                for (int e = 0; e < NE; ++e) {
                    k_gather<<<1024, 256, 0, stream>>>(U, LIST + e * L, CNT + e, XG);
                    gemm(false, XG, D, moe_w_gate + (size_t)e * D * DFE, DFE, FG, DFE, L, DFE, D, CNT + e, 0);
                    gemm(false, XG, D, moe_w_up + (size_t)e * D * DFE, DFE, FU, DFE, L, DFE, D, CNT + e, 0);
                    k_swiglu_act<<<2048, 256, 0, stream>>>(FG, FU, DFE, DFE, L, CNT + e);
                    gemm(false, FG, DFE, moe_w_down + (size_t)e * DFE * D, D, YE, D, L, D, DFE, CNT + e, 0);
                    k_scatter<<<1024, 256, 0, stream>>>(YE, LIST + e * L, CNT + e, YS);
                }
                k_moe_combine<<<2048, 256, 0, stream>>>(Hb, YS, GATE);
                if (T && DBG_MOE) { launch_phases(P, pb + fx::PL_NORM2, pb + fx::PL_COMB + 1, 1, stream); chkH(Hb, 0.02f); }
            }
        }
    }
    dbg::k_encode<<<1, 64, 0, stream>>>(CHK, h_thr, nchk, SX);
    dbg::k_write_out_dbg<<<2048, 256, 0, stream>>>(H, out, SX);
#endif
}
```

```cpp
#include <hip/hip_runtime.h>
#include <stdint.h>
#include <stdio.h>

#ifndef DEBUG_CHECK
#define DEBUG_CHECK 0
#endif
#if DEBUG_CHECK
#define NBF 1
#else
#define NBF 8
#endif

#ifndef PROBE
#define PROBE 0
#endif
#ifndef PROBE_A
#define PROBE_A 0
#define PROBE_B 0
#define PROBE_C 0
#define PROBE_D 0
#endif

#ifndef ATT_EXPERIMENT
#define ATT_EXPERIMENT 0
#endif
namespace nv {
constexpr int NB = 8, SEQ = 4096, NM = 16, L = 4112, D = 1024, INC = 4048, DMIX = 1536, DFF = 2816, NE = 8, DFE = 3584;
constexpr int C_DNQ = 0, C_DNK = 512, C_DNV = 1024, C_DNZ = 1536, C_DNB = 2048, C_DNA = 2056, C_DFQ = 2064, C_DFK = 2576, C_DFV = 3088,
              C_MLQ = 3600, C_MLKV = 3856, C_MLKR = 3984;
constexpr float EPS = 1e-6f;

__device__ __forceinline__ float siluf(float x) { return x / (1.f + expf(-x)); }
__device__ __forceinline__ float wave_sum(float v) {
#pragma unroll
    for (int o = 32; o > 0; o >>= 1) v += __shfl_xor(v, o);
    return v;
}
__device__ __forceinline__ float wave_max(float v) {
#pragma unroll
    for (int o = 32; o > 0; o >>= 1) v = fmaxf(v, __shfl_xor(v, o));
    return v;
}

template <bool TB>
__global__ void __launch_bounds__(256) k_gemm(const float* __restrict__ A, int lda, const float* __restrict__ B, int ldb, float* __restrict__ C, int ldc,
                                              int M, int N, int K, const int* Mdev, int accumulate) {
    if (Mdev) M = *Mdev;
    const int bm = blockIdx.y * 64, bn = blockIdx.x * 64;
    if (bm >= M) return;
    __shared__ float As[16][65], Bs[16][65];
    const int tx = threadIdx.x & 15, ty = threadIdx.x >> 4;
    float acc[4][4];
#pragma unroll
    for (int i = 0; i < 4; ++i)
#pragma unroll
        for (int j = 0; j < 4; ++j) acc[i][j] = 0.f;
    for (int k0 = 0; k0 < K; k0 += 16) {
#pragma unroll
        for (int i = 0; i < 4; ++i) {
            const int idx = threadIdx.x + i * 256;
            { const int r = idx >> 4, kk = idx & 15; As[kk][r] = (bm + r < M && k0 + kk < K) ? A[(size_t)(bm + r) * lda + k0 + kk] : 0.f; }
            if (TB) { const int n = idx >> 4, kk = idx & 15; Bs[kk][n] = (bn + n < N && k0 + kk < K) ? B[(size_t)(bn + n) * ldb + k0 + kk] : 0.f; }
            else    { const int kk = idx >> 6, n = idx & 63; Bs[kk][n] = (bn + n < N && k0 + kk < K) ? B[(size_t)(k0 + kk) * ldb + bn + n] : 0.f; }
        }
        __syncthreads();
#pragma unroll
        for (int kk = 0; kk < 16; ++kk) {
            float a[4], b[4];
#pragma unroll
            for (int i = 0; i < 4; ++i) { a[i] = As[kk][ty * 4 + i]; b[i] = Bs[kk][tx * 4 + i]; }
#pragma unroll
            for (int i = 0; i < 4; ++i)
#pragma unroll
                for (int j = 0; j < 4; ++j) acc[i][j] = fmaf(a[i], b[j], acc[i][j]);
        }
        __syncthreads();
    }
#pragma unroll
    for (int i = 0; i < 4; ++i)
#pragma unroll
        for (int j = 0; j < 4; ++j) {
            const int r = bm + ty * 4 + i, c = bn + tx * 4 + j;
            if (r < M && c < N) { float* p = C + (size_t)r * ldc + c; *p = accumulate ? (*p + acc[i][j]) : acc[i][j]; }
        }
}

__global__ void k_build_h(const float* __restrict__ x, const float* __restrict__ meta, float* __restrict__ H) {
    const size_t n = (size_t)NB * L * D;
    for (size_t i = (size_t)blockIdx.x * blockDim.x + threadIdx.x; i < n; i += (size_t)gridDim.x * blockDim.x) {
        const int d = (int)(i % D); const size_t r = i / D; const int t = (int)(r % L), b = (int)(r / L);
        H[i] = t < NM ? meta[t * D + d] : x[((size_t)b * SEQ + (t - NM)) * D + d];
    }
}
__global__ void k_write_out(const float* __restrict__ H, float* __restrict__ out) {
    const size_t n = (size_t)NB * SEQ * D;
    for (size_t i = (size_t)blockIdx.x * blockDim.x + threadIdx.x; i < n; i += (size_t)gridDim.x * blockDim.x) {
        const int d = (int)(i % D); const size_t r = i / D; const int s = (int)(r % SEQ), b = (int)(r / SEQ);
        out[i] = H[((size_t)b * L + NM + s) * D + d];
    }
}

__global__ void __launch_bounds__(256) k_rmsnorm(const float* __restrict__ in, int in_ld, float* __restrict__ out, int out_ld, const float* __restrict__ w,
                                                 int rows, int groups, int n, float scale) {
    const int wid = (blockIdx.x * blockDim.x + threadIdx.x) >> 6, lane = threadIdx.x & 63;
    if (wid >= rows * groups) return;
    const int r = wid / groups, g = wid % groups;
    const float* p = in + (size_t)r * in_ld + g * n; float* q = out + (size_t)r * out_ld + g * n;
    float ss = 0.f;
    for (int i = lane; i < n; i += 64) { const float v = p[i]; ss += v * v; }
    ss = wave_sum(ss);
    const float rs = rsqrtf(ss / (float)n + EPS) * scale;
    for (int i = lane; i < n; i += 64) q[i] = p[i] * rs * w[i];
}

__global__ void k_dn_conv(const float* __restrict__ proj, const float* __restrict__ cw, float* __restrict__ qkvc) {
    const int n = L * 1536;
    for (int i = blockIdx.x * blockDim.x + threadIdx.x; i < n; i += gridDim.x * blockDim.x) {
        const int c = i % 1536, t = i / 1536; float a = 0.f;
#pragma unroll
        for (int j = 0; j < 5; ++j) { const int tt = t + j - 2; if (tt >= 0 && tt < L) a += proj[(size_t)tt * INC + c] * cw[j * 1536 + c]; }
        qkvc[i] = siluf(a);
    }
}
__global__ void __launch_bounds__(256) k_dn_l2(float* __restrict__ qkvc) {
    const int wid = (blockIdx.x * blockDim.x + threadIdx.x) >> 6, lane = threadIdx.x & 63;
    if (wid >= L * 8) return;
    const int t = wid / 8, g = wid % 8;
    float* p = qkvc + (size_t)t * 1536 + g * 128;
    const float a = p[lane], b = p[lane + 64];
    const float ss = wave_sum(a * a + b * b);
    const float rs = rsqrtf(ss + EPS) * (g < 4 ? 0.08838834764831845f : 1.f);
    p[lane] = a * rs; p[lane + 64] = b * rs;
}
__global__ void k_dn_bg(const float* __restrict__ proj, const float* __restrict__ a_log, const float* __restrict__ dt_bias, float* __restrict__ beta, float* __restrict__ g) {
    const int n = L * 8;
    for (int i = blockIdx.x * blockDim.x + threadIdx.x; i < n; i += gridDim.x * blockDim.x) {
        const int j = i % 8, t = i / 8;
        const float bl = proj[(size_t)t * INC + C_DNB + j], al = proj[(size_t)t * INC + C_DNA + j] + dt_bias[j];
        beta[i] = 1.f / (1.f + expf(-bl));
        const float sp = al > 20.f ? al : log1pf(expf(al));
        g[i] = -expf(a_log[j]) * sp;
    }
}
__global__ void __launch_bounds__(128) k_dn_scan(const float* __restrict__ qkvc, const float* __restrict__ beta, const float* __restrict__ g, float* __restrict__ odn) {
    const int j = blockIdx.x, dir = j >> 2, h = j & 3, e = threadIdx.x;
    __shared__ float sq[16][128], sk[16][128];
    __shared__ float sb[16], sg[16];
    float S[128];
#pragma unroll
    for (int d = 0; d < 128; ++d) S[d] = 0.f;
    float* o = odn + (size_t)dir * L * 512;
    for (int i0 = 0; i0 < L; i0 += 16) {
        __syncthreads();
        float vv[16];
#pragma unroll
        for (int s = 0; s < 16; ++s) {
            const int i = i0 + s; const int t = (dir == 0 || i < NM) ? i : (L + NM - 1 - i);
            sq[s][e] = qkvc[(size_t)t * 1536 + h * 128 + e];
            sk[s][e] = qkvc[(size_t)t * 1536 + 512 + h * 128 + e];
            vv[s] = qkvc[(size_t)t * 1536 + 1024 + h * 128 + e];
            if (e == 0) { sb[s] = beta[t * 8 + j]; sg[s] = g[t * 8 + j]; }
        }
        __syncthreads();
#pragma unroll
        for (int s = 0; s < 16; ++s) {
            const int i = i0 + s; const int t = (dir == 0 || i < NM) ? i : (L + NM - 1 - i);
            const float al = expf(sg[s]), be = sb[s];
            float r = 0.f;
#pragma unroll
            for (int d = 0; d < 128; ++d) { S[d] *= al; r = fmaf(sk[s][d], S[d], r); }
            const float vn = be * (vv[s] - r);
            float oo = 0.f;
#pragma unroll
            for (int d = 0; d < 128; ++d) { S[d] = fmaf(sk[s][d], vn, S[d]); oo = fmaf(sq[s][d], S[d], oo); }
            o[(size_t)t * 512 + h * 128 + e] = oo;
        }
    }
}
__global__ void __launch_bounds__(256) k_dn_out(const float* __restrict__ odn, const float* __restrict__ proj, const float* __restrict__ w, float* __restrict__ y) {
    const int wid = (blockIdx.x * blockDim.x + threadIdx.x) >> 6, lane = threadIdx.x & 63;
    if (wid >= L * 4) return;
    const int t = wid / 4, h = wid % 4;
    const size_t o = (size_t)t * 512 + h * 128;
    const float a = odn[o + lane] + odn[(size_t)L * 512 + o + lane], b = odn[o + lane + 64] + odn[(size_t)L * 512 + o + lane + 64];
    const float ss = wave_sum(a * a + b * b);
    const float rs = rsqrtf(ss / 128.f + EPS);
    const float z0 = proj[(size_t)t * INC + C_DNZ + h * 128 + lane], z1 = proj[(size_t)t * INC + C_DNZ + h * 128 + lane + 64];
    y[(size_t)t * DMIX + h * 128 + lane] = a * rs * w[lane] * siluf(z0);
    y[(size_t)t * DMIX + h * 128 + lane + 64] = b * rs * w[lane + 64] * siluf(z1);
}

__device__ __forceinline__ int t5_bucket(int rel) {
    const int n = rel < 0 ? -rel : rel;
    int f;
    if (n < 8) f = n; else if (n < 12) f = 8; else if (n < 16) f = 9; else if (n < 23) f = 10; else if (n < 32) f = 11;
    else if (n < 46) f = 12; else if (n < 64) f = 13; else if (n < 91) f = 14; else f = 15;
    return (rel > 0 ? 16 : 0) + f;
}
__global__ void k_lam(const float* __restrict__ lp, float lam_init, float* __restrict__ lam) {
    const int lane = threadIdx.x;
    const float a = wave_sum(lp[lane] * lp[64 + lane]), b = wave_sum(lp[128 + lane] * lp[192 + lane]);
    if (lane == 0) *lam = expf(a) - expf(b) + lam_init;
}
__device__ __forceinline__ float block_max(float v, float* sm) {
    v = wave_max(v); const int w = threadIdx.x >> 6;
    __syncthreads(); if ((threadIdx.x & 63) == 0) sm[w] = v; __syncthreads();
    return fmaxf(fmaxf(sm[0], sm[1]), fmaxf(sm[2], sm[3]));
}
__device__ __forceinline__ float block_sum(float v, float* sm) {
    v = wave_sum(v); const int w = threadIdx.x >> 6;
    __syncthreads(); if ((threadIdx.x & 63) == 0) sm[w] = v; __syncthreads();
    return sm[0] + sm[1] + sm[2] + sm[3];
}
__global__ void __launch_bounds__(256) k_diff_softmax(float* __restrict__ S0, const float* __restrict__ S1, const float* __restrict__ table, int h, const float* __restrict__ lamp) {
    __shared__ float sm[4];
    const int i = blockIdx.x; const float lam = *lamp;
    float* r0 = S0 + (size_t)i * L; const float* r1 = S1 + (size_t)i * L;
    float m0 = -3e38f, m1 = -3e38f;
    for (int jx = threadIdx.x; jx < L; jx += 256) { const float bz = table[t5_bucket(jx - i) * 4 + h]; m0 = fmaxf(m0, r0[jx] * 0.125f + bz); m1 = fmaxf(m1, r1[jx] * 0.125f + bz); }
    m0 = block_max(m0, sm); m1 = block_max(m1, sm);
    float s0 = 0.f, s1 = 0.f;
    for (int jx = threadIdx.x; jx < L; jx += 256) { const float bz = table[t5_bucket(jx - i) * 4 + h]; s0 += expf(r0[jx] * 0.125f + bz - m0); s1 += expf(r1[jx] * 0.125f + bz - m1); }
    s0 = block_sum(s0, sm); s1 = block_sum(s1, sm);
    const float i0 = 1.f / s0, i1 = 1.f / s1;
    for (int jx = threadIdx.x; jx < L; jx += 256) { const float bz = table[t5_bucket(jx - i) * 4 + h];
        r0[jx] = expf(r0[jx] * 0.125f + bz - m0) * i0 - lam * expf(r1[jx] * 0.125f + bz - m1) * i1; }
}
__global__ void __launch_bounds__(256) k_softmax(float* __restrict__ S0, float scale) {
    __shared__ float sm[4];
    float* r0 = S0 + (size_t)blockIdx.x * L;
    float m0 = -3e38f;
    for (int jx = threadIdx.x; jx < L; jx += 256) m0 = fmaxf(m0, r0[jx] * scale);
    m0 = block_max(m0, sm);
    float s0 = 0.f;
    for (int jx = threadIdx.x; jx < L; jx += 256) s0 += expf(r0[jx] * scale - m0);
    s0 = block_sum(s0, sm);
    const float i0 = 1.f / s0;
    for (int jx = threadIdx.x; jx < L; jx += 256) r0[jx] = expf(r0[jx] * scale - m0) * i0;
}
__global__ void __launch_bounds__(256) k_mla_prep(const float* __restrict__ mlq, const float* __restrict__ mlkv, const float* __restrict__ proj,
                                                  const float* __restrict__ qw, const float* __restrict__ kw, float* __restrict__ qf, float* __restrict__ kf) {
    const int wid = (blockIdx.x * blockDim.x + threadIdx.x) >> 6, lane = threadIdx.x & 63;
    if (wid >= L * 8) return;
    const int t = wid / 8, h = (wid % 8) >> 1, which = wid & 1;
    float v[3];
    if (which == 0) { v[0] = mlq[(size_t)t * 768 + h * 192 + lane]; v[1] = mlq[(size_t)t * 768 + h * 192 + 64 + lane]; v[2] = mlq[(size_t)t * 768 + h * 192 + 128 + lane]; }
    else { v[0] = mlkv[(size_t)t * 1024 + h * 256 + lane]; v[1] = mlkv[(size_t)t * 1024 + h * 256 + 64 + lane]; v[2] = proj[(size_t)t * INC + C_MLKR + lane]; }
    const float ss = wave_sum(v[0] * v[0] + v[1] * v[1] + v[2] * v[2]);
    const float rs = rsqrtf(ss / 192.f + EPS);
    const float* w = which == 0 ? qw : kw;
#pragma unroll
    for (int c = 0; c < 3; ++c) v[c] = v[c] * rs * w[c * 64 + lane];
    const int i = lane & 31;
    const float inv = 1.0f / powf(10000.0f, (float)i / 32.0f);
    const float ang = (float)t * inv;
    const float cs = cosf(ang), sn = sinf(ang);
    const float other = __shfl_xor(v[2], 32);
    const float rv = lane < 32 ? (v[2] * cs - other * sn) : (other * sn + v[2] * cs);
    float* o = (which == 0 ? qf : kf) + (size_t)t * 768 + h * 192;
    o[lane] = v[0]; o[64 + lane] = v[1]; o[128 + lane] = rv;
}

__global__ void k_swiglu_act(float* __restrict__ G, const float* __restrict__ U, int ld, int cols, int rows, const int* rowsdev) {
    if (rowsdev) rows = *rowsdev;
    const size_t n = (size_t)rows * cols;
    for (size_t i = (size_t)blockIdx.x * blockDim.x + threadIdx.x; i < n; i += (size_t)gridDim.x * blockDim.x) {
        const size_t r = i / cols, c = i % cols; const size_t o = r * ld + c;
        G[o] = siluf(G[o]) * U[o];
    }
}
__global__ void k_zero_int(int* p, int n) { const int i = blockIdx.x * blockDim.x + threadIdx.x; if (i < n) p[i] = 0; }
__global__ void __launch_bounds__(256) k_router(const float* __restrict__ U, const float* __restrict__ rw, int* __restrict__ cnt, int* __restrict__ list, float* __restrict__ gate) {
    const int t = (blockIdx.x * blockDim.x + threadIdx.x) >> 6, lane = threadIdx.x & 63;
    if (t >= L) return;
    float lg[NE];
#pragma unroll
    for (int e = 0; e < NE; ++e) lg[e] = 0.f;
    for (int d = lane; d < D; d += 64) { const float u = U[(size_t)t * D + d];
#pragma unroll
        for (int e = 0; e < NE; ++e) lg[e] = fmaf(u, rw[d * NE + e], lg[e]); }
#pragma unroll
    for (int e = 0; e < NE; ++e) lg[e] = wave_sum(lg[e]);
    if (lane == 0) {
        int i0 = 0; float v0 = lg[0];
#pragma unroll
        for (int e = 1; e < NE; ++e) if (lg[e] > v0) { v0 = lg[e]; i0 = e; }
        int i1 = -1; float v1 = -3e38f;
#pragma unroll
        for (int e = 0; e < NE; ++e) if (e != i0 && lg[e] > v1) { v1 = lg[e]; i1 = e; }
        const float e1 = expf(v1 - v0), g0 = 1.f / (1.f + e1), g1 = e1 / (1.f + e1);
        gate[t * 2] = g0; gate[t * 2 + 1] = g1;
        const int p0 = atomicAdd(&cnt[i0], 1); list[i0 * L + p0] = t * 2;
        const int p1 = atomicAdd(&cnt[i1], 1); list[i1 * L + p1] = t * 2 + 1;
    }
}
__global__ void k_gather(const float* __restrict__ U, const int* __restrict__ list, const int* __restrict__ cnt, float* __restrict__ X) {
    const int n = *cnt;
    for (size_t i = (size_t)blockIdx.x * blockDim.x + threadIdx.x; i < (size_t)n * D; i += (size_t)gridDim.x * blockDim.x) {
        const int r = (int)(i / D), d = (int)(i % D); X[i] = U[(size_t)(list[r] >> 1) * D + d];
    }
}
__global__ void k_scatter(const float* __restrict__ Y, const int* __restrict__ list, const int* __restrict__ cnt, float* __restrict__ YS) {
    const int n = *cnt;
    for (size_t i = (size_t)blockIdx.x * blockDim.x + threadIdx.x; i < (size_t)n * D; i += (size_t)gridDim.x * blockDim.x) {
        const int r = (int)(i / D), d = (int)(i % D); YS[(size_t)list[r] * D + d] = Y[i];
    }
}
__global__ void k_moe_combine(float* __restrict__ H, const float* __restrict__ YS, const float* __restrict__ gate) {
    const size_t n = (size_t)L * D;
    for (size_t i = (size_t)blockIdx.x * blockDim.x + threadIdx.x; i < n; i += (size_t)gridDim.x * blockDim.x) {
        const size_t t = i / D, d = i % D;
        H[i] = H[i] + (gate[t * 2] * YS[(t * 2) * D + d] + gate[t * 2 + 1] * YS[(t * 2 + 1) * D + d]);
    }
}
}
namespace fx {
typedef unsigned short bf16_t;
typedef short bf16x8 __attribute__((ext_vector_type(8)));
typedef short s16x4 __attribute__((ext_vector_type(4)));
typedef float f32x4 __attribute__((ext_vector_type(4)));
typedef float f32x16 __attribute__((ext_vector_type(16)));
typedef unsigned u32x4 __attribute__((ext_vector_type(4)));
typedef unsigned u32x2 __attribute__((ext_vector_type(2)));
#define LAS __attribute__((address_space(3)))

constexpr int NB = NBF, SEQ = 4096, NM = 16, L = 4112, LP = 4160, PADF = 48, D = 1024, DMIX = 1536, DFF = 2816, NE = 8, DFE = 3584;
constexpr int MP = ((NB * LP + 255) / 256) * 256;
constexpr int NWG_THREADS = 512;
constexpr int LDS_MISC_OFF = 160384;
constexpr float EPS = 1e-6f;

#define XB_TMO      128
#define XB_XCNT(j)  (256  + 64 * (j))
#define XB_XSUB(j)  (1280 + 64 * (j))
#define XB_XGEN(j)  (2304 + 64 * (j))
#define XB_TOP      3328
#define XB_TOPGEN   3392
#define XCD_BAR_WORDS 3456
#define XB_SPIN_CAP (1u << 18)
__device__ __forceinline__ unsigned xb_ld(unsigned* p)              { return __hip_atomic_load(p, __ATOMIC_RELAXED, __HIP_MEMORY_SCOPE_AGENT); }
__device__ __forceinline__ unsigned xb_add(unsigned* p, unsigned v) { return __hip_atomic_fetch_add(p, v, __ATOMIC_RELAXED, __HIP_MEMORY_SCOPE_AGENT); }
__device__ __forceinline__ unsigned xb_xcc_id() { return (unsigned)__builtin_amdgcn_s_getreg((3 << 11) | 20) & 0xFu; }
#define XB_SPIN(cond, bar) do { unsigned _sp = 0; while (cond) { __builtin_amdgcn_s_sleep(1); \
    if ((++_sp & 255u) == 0u) { if (xb_ld(&(bar)[XB_TMO])) break; if (_sp > XB_SPIN_CAP) { atomicAdd(&(bar)[XB_TMO], 1u); break; } } } } while (0)
struct XcdBarrier { unsigned* bar; unsigned x; volatile LAS unsigned* st; };
__device__ __forceinline__ XcdBarrier xcd_barrier_post(unsigned* bar, volatile LAS unsigned* st) {
    XcdBarrier b; b.bar = bar; b.x = xb_xcc_id(); b.st = st;
    if (threadIdx.x == 0) (void)xb_add(&bar[XB_XCNT(b.x)], 1u);
    return b;
}
__device__ __forceinline__ void xcd_barrier_complete(unsigned* bar, unsigned x, unsigned& nloc, unsigned& nx) {
    const unsigned G = gridDim.x * gridDim.y * gridDim.z;
    unsigned sum, cnt, mine, sp = 0u;
    for (;;) {
        sum = 0u; cnt = 0u; mine = 0u;
#pragma unroll
        for (unsigned j = 0; j < 16; ++j) { const unsigned c = xb_ld(&bar[XB_XCNT(j)]); sum += c; cnt += (c > 0u) ? 1u : 0u; mine = (j == x) ? c : mine; }
        if (sum == G) break;
        __builtin_amdgcn_s_sleep(1);
        if ((++sp & 255u) == 0u) { if (xb_ld(&bar[XB_TMO])) break; if (sp > XB_SPIN_CAP) { atomicAdd(&bar[XB_TMO], 1u); break; } }
    }
    nloc = mine > 0u ? mine : 1u; nx = cnt > 0u ? cnt : 1u;
}
__device__ __forceinline__ void xcd_barrier(const XcdBarrier& b) {
    asm volatile("s_waitcnt vmcnt(0)" ::: "memory");
    __syncthreads();
    if (threadIdx.x == 0) {
        unsigned* bar = b.bar;
        __builtin_amdgcn_s_waitcnt(0);
        unsigned nloc = b.st[0], nx = b.st[1];
        if (nloc == 0u) { xcd_barrier_complete(bar, b.x, nloc, nx); b.st[0] = nloc; b.st[1] = nx; }
        const unsigned old = xb_add(&bar[XB_XSUB(b.x)], 1u);
        const unsigned gen = old / nloc;
        if (old + 1u == (gen + 1u) * nloc) {
            __builtin_amdgcn_fence(__ATOMIC_RELEASE, "agent");
            asm volatile("s_waitcnt vmcnt(0)" ::: "memory");
            const unsigned og = xb_add(&bar[XB_TOP], 1u);
            const unsigned tg = og / nx;
            if (og + 1u == (tg + 1u) * nx) xb_add(&bar[XB_TOPGEN], 1u);
            else XB_SPIN(xb_ld(&bar[XB_TOPGEN]) == tg, bar);
            __builtin_amdgcn_fence(__ATOMIC_ACQUIRE, "agent");
            xb_add(&bar[XB_XGEN(b.x)], 1u);
            asm volatile("s_waitcnt vmcnt(0)" ::: "memory");
        } else {
            XB_SPIN(xb_ld(&bar[XB_XGEN(b.x)]) == gen, bar);
            __builtin_amdgcn_fence(__ATOMIC_ACQUIRE, "agent");
            asm volatile("s_waitcnt vmcnt(0)" ::: "memory");
        }
    }
    __syncthreads();
}

__device__ __forceinline__ int lane_id() { int l; asm volatile("v_mbcnt_lo_u32_b32 %0, -1, 0\n\tv_mbcnt_hi_u32_b32 %0, -1, %0" : "=v"(l)); return l; }
__device__ int g_dummy_never_used;
#define fresh_tid() (wave_idx_ * 64 + lane_id())
typedef __bf16 bf16x2_t __attribute__((ext_vector_type(2)));
typedef float f32x2_t __attribute__((ext_vector_type(2)));
__device__ __forceinline__ unsigned cvt_pk_bf16(float lo, float hi) { const f32x2_t v = {lo, hi}; const bf16x2_t b = __builtin_convertvector(v, bf16x2_t); return __builtin_bit_cast(unsigned, b); }
__device__ __forceinline__ bf16_t f2bf(float f) { return (bf16_t)(cvt_pk_bf16(f, 0.f) & 0xFFFFu); }
__device__ __forceinline__ float bf2f(bf16_t b) { return __uint_as_float(((unsigned)b) << 16); }
__device__ __forceinline__ float bflo(unsigned u) { return __uint_as_float(u << 16); }
__device__ __forceinline__ float bfhi(unsigned u) { return __uint_as_float(u & 0xFFFF0000u); }
__device__ __forceinline__ float siluf(float x) { return x / (1.f + __expf(-x)); }
template <int M> __device__ __forceinline__ float shx(float v) {
    if constexpr (M < 32) return __int_as_float(__builtin_amdgcn_ds_swizzle(__float_as_int(v), (M << 10) | 0x1f));
    else { const int l = lane_id(); return __int_as_float(__builtin_amdgcn_ds_bpermute((l ^ 32) << 2, __float_as_int(v))); }
}
__device__ __forceinline__ float wave_sum(float v) {
    v += shx<32>(v); v += shx<16>(v); v += shx<8>(v); v += shx<4>(v); v += shx<2>(v); v += shx<1>(v);
    return v;
}
__device__ __forceinline__ float* hf_row(float* Hout, float* Hside, int row) {
    if (row >= NB * LP) return Hside + (size_t)(NB * 64 + (row - NB * LP)) * D;
    const int b = row / LP, lp = row - b * LP;
    return lp >= 64 ? Hout + ((size_t)b * SEQ + (lp - 64)) * D : Hside + (size_t)(b * 64 + lp) * D;
}
__device__ __forceinline__ bool row_valid(int row) {
    const int lp = row % LP; return row < NB * LP && lp >= PADF;
}

struct Bufs {
    unsigned* ctl;
    float* Hout;
    float* Hside;
    bf16_t* Ub;
    bf16_t* G1;
    bf16_t* G2;
    bf16_t* G3;
    bf16_t* G4;
    bf16_t* MLX;
    bf16_t* ODN;
    float* BG;
    bf16_t* ACT;
    bf16_t* WinT;
    bf16_t* WuT;
    bf16_t* WoutT;
    bf16_t* WguT;
    bf16_t* WdT;
    float* misc;
    float* PART;
    bf16_t* W1T;
    bf16_t* W2T;
    bf16_t* ACTM;
    bf16_t* YS1;
    int* LST;
    float* GL;
    float* PK;
};
struct Params {
    const float* in[28];
    float* out;
    Bufs b;
    int ph_lo, ph_hi, fused, pad;
    int kcap, pad2;
    int nmm_out, nmm_ffn;
};
typedef const __attribute__((address_space(4))) Params CParams;
__device__ __forceinline__ CParams* opaque_params() {
    CParams* q = (CParams*)__builtin_amdgcn_kernarg_segment_ptr();
    asm volatile("" : "+s"(q));
    return q;
}

namespace pg8 {
constexpr int BM = 256, BK = 64, HALF = 128, HTB = HALF * BK * 2, STAGE_BYTES = 8 * HTB, NXCD = 8, WGM = 8;
__host__ __device__ __forceinline__ int lds_byte(int r, int c) { const int st = (r >> 4) * 2 + (c >> 5), rr = r & 15, cc = c & 31, ob = rr * 64 + cc * 2; return st * 1024 + (ob ^ (((ob >> 9) & 1) << 5)); }
__host__ __device__ __forceinline__ void stage_rc(int b, int& R, int& C) { const int st = b / 1024, sb = b % 1024, swz = sb ^ (((sb >> 9) & 1) << 5); R = (st >> 1) * 16 + swz / 64; C = (st & 1) * 32 + (swz % 64) / 2; }
__host__ __device__ __forceinline__ int perm32(int rho) { const int n = rho >> 4, i = rho & 15; return 8 * (i >> 2) + 4 * n + (i & 3); }

struct Unit { int pm, pn; const char* A; const char* B; const int* rows; const float* gates; int valid, orow0, nt, part, kw, kb, kf; };

struct StaticOrder {
    int nM, nN, nwg, G, c, ntk, bdk = 0; const char* A; const char* B; size_t tstepA, tstepB;
    __device__ void init(int nM_, int nN_, int G_, int c_, const void* A_, int lda, const void* B_, int K) {
        nM = nM_; nN = nN_; nwg = nM * nN; G = G_; c = c_; ntk = K / BK; A = (const char*)A_; B = (const char*)B_; tstepA = (size_t)BM * lda * 2; tstepB = (size_t)BM * K * 2; }
    __device__ bool next(int i, Unit& u) const {
        const long Lx = (long)i * G + c; if (Lx >= nwg) return false;
        int wgid = (int)Lx; { const int q = nwg / NXCD, r = nwg % NXCD, xcd = wgid % NXCD, off = wgid / NXCD; wgid = (xcd < r ? xcd * (q + 1) : r * (q + 1) + (xcd - r) * q) + off; }
        const int nig = WGM * nN, gid = wgid / nig, fm = gid * WGM, gsz = (nM - fm) < WGM ? (nM - fm) : WGM;
        u.pm = fm + ((wgid % nig) % gsz); u.pn = (wgid % nig) / gsz; u.A = A + (size_t)u.pm * tstepA; u.B = B + (size_t)u.pn * tstepB; u.rows = nullptr; u.gates = nullptr; u.valid = BM; u.orow0 = u.pm * BM; u.nt = ntk; u.part = -1;
        if (bdk > 0) { if (u.pn < nN / 2) u.nt = bdk; else { u.nt = ntk - bdk; u.A += (size_t)bdk * (BK * 2); u.B += (size_t)bdk * (BK * 2); } }
        return true;
    }
};


__host__ __device__ __forceinline__ int tail_main_tiles(int nM, int nN, int G, int ntk, int split) {
    if (nM * nN > G) { const int r = (nM * nN) % G, tm = (r + nN - 1) / nN; if (r > 0 && ((nM - tm) * nN) % G == 0 && ntk % split == 0 && (ntk / split) % 2 == 0) return nM - tm; }
    return nM;
}
struct TailOrder {
    int nMm, tailM, nN, G, c, ntk, SPLIT; const char* A; const char* B; size_t tstepA, tstepB;
    __device__ void init(int nM, int nN_, int G_, int c_, const void* A_, int lda, const void* B_, int K, int split, int nmm) {
        nN = nN_; G = G_; c = c_; ntk = K / BK; SPLIT = split; A = (const char*)A_; B = (const char*)B_; tstepA = (size_t)BM * lda * 2; tstepB = (size_t)BM * K * 2;
        nMm = nmm; tailM = nM - nMm;
    }
    __device__ bool next(int i, Unit& u) const {
        const int nmain = nMm * nN; const long Lx = (long)i * G + c;
        u.rows = nullptr; u.gates = nullptr; u.valid = BM;
        if (Lx < nmain) {
            int wgid = (int)Lx; { const int q = nmain / NXCD, r = nmain % NXCD, xcd = wgid % NXCD, off = wgid / NXCD; wgid = (xcd < r ? xcd * (q + 1) : r * (q + 1) + (xcd - r) * q) + off; }
            const int nig = WGM * nN, gid = wgid / nig, fm = gid * WGM, gsz = (nMm - fm) < WGM ? (nMm - fm) : WGM;
            u.pm = fm + ((wgid % nig) % gsz); u.pn = (wgid % nig) / gsz; u.A = A + (size_t)u.pm * tstepA; u.B = B + (size_t)u.pn * tstepB; u.nt = ntk; u.part = -1; u.orow0 = u.pm * BM; return true;
        }
        const int q = (int)(Lx - nmain); if (q >= tailM * nN * SPLIT) return false;
        const int tu = q / SPLIT, sp = q - tu * SPLIT, nts = ntk / SPLIT;
        u.pm = nMm + tu / nN; u.pn = tu % nN; u.nt = nts; u.part = q; u.orow0 = u.pm * BM;
        u.A = A + (size_t)u.pm * tstepA + (size_t)sp * nts * (BK * 2); u.B = B + (size_t)u.pn * tstepB + (size_t)sp * nts * (BK * 2);
        return true;
    }
};

template <class Epi, class Sched, bool GATHER>
__device__ __forceinline__ void gemm_phase(LAS unsigned char* lds, const int lda, const int K, const Sched& S, const Epi& E, const int wave_idx_) {
    int tid_ = fresh_tid(); asm volatile("" : "+v"(tid_));
    const int tid = tid_, wid = __builtin_amdgcn_readfirstlane(tid >> 6), lane = tid & 63, wr = wid >> 2, wc = wid & 3, fr = lane & 15, fq = lane >> 4;
    unsigned voffB[2];
#pragma unroll
    for (int i = 0; i < 2; ++i) { int R, C; stage_rc(tid * 16 + i * 8192, R, C); const int Rb = Epi::PERM ? ((R & ~31) + perm32(R & 31)) : R;
        voffB[i] = (unsigned)(Rb * K + C) * 2u; }
    const size_t kstep = (size_t)(BK * 2);
    const size_t hstepB = (size_t)HALF * K * 2;
    const unsigned ldsw = (unsigned)wid * 1024u;
    const int aoff = lds_byte(wr * 64 + fr, fq * 8), boff = lds_byte(wc * 32 + fr, fq * 8);
#define PG8_SA(b, h) (((b) * 2 + (h)) * HTB)
#define PG8_SB(b, h) ((4 + (b) * 2 + (h)) * HTB)
#define PG8_STAGE(bufoff, gbase, voff) do { _Pragma("unroll") for (int _i = 0; _i < 2; ++_i) \
        __builtin_amdgcn_global_load_lds((const unsigned*)((const char*)(gbase) + (voff)[_i]), (LAS unsigned*)(lds + (bufoff) + ldsw + _i * 8192), 16, 0, 0); } while (0)
#define PG8_LDA(dst, b, h) do { _Pragma("unroll") for (int m = 0; m < 4; ++m) _Pragma("unroll") for (int k = 0; k < 2; ++k) dst[m][k] = *(const LAS bf16x8*)(lds + PG8_SA(b, h) + aoff + m * 2048 + k * 1024); } while (0)
#define PG8_LDB(dst, b, h) do { _Pragma("unroll") for (int n = 0; n < 2; ++n) _Pragma("unroll") for (int k = 0; k < 2; ++k) dst[n][k] = *(const LAS bf16x8*)(lds + PG8_SB(b, h) + boff + n * 2048 + k * 1024); } while (0)
#define PG8_MMA(ai, bj, At, Bt) do { __builtin_amdgcn_s_setprio(1); _Pragma("unroll") for (int m = 0; m < 4; ++m) _Pragma("unroll") for (int n = 0; n < 2; ++n) _Pragma("unroll") for (int k = 0; k < 2; ++k) \
        acc[ai][bj][m][n] = __builtin_amdgcn_mfma_f32_16x16x32_bf16(Bt[n][k], At[m][k], acc[ai][bj][m][n], 0, 0, 0); __builtin_amdgcn_s_setprio(0); } while (0)
#define PG8_WAIT_V(n) asm volatile("s_waitcnt vmcnt(" #n ")" ::: "memory")
#define PG8_WAIT_L(n) asm volatile("s_waitcnt lgkmcnt(" #n ")" ::: "memory")
#define PG8_BAR __builtin_amdgcn_s_barrier()
#define PG8_SCHED __builtin_amdgcn_sched_barrier(0)
#define PG8_SETOFF(u, o0, o1) do { int t2_ = tid; asm volatile("" : "+v"(t2_)); _Pragma("unroll") for (int _i = 0; _i < 2; ++_i) { int R_, C_; stage_rc(t2_ * 16 + _i * 8192, R_, C_); \
        if (GATHER) { const int r0_ = R_ < (u).valid ? ((u).rows[R_] >> 1) : 0, r1_ = R_ + HALF < (u).valid ? ((u).rows[R_ + HALF] >> 1) : 0; \
            o0[_i] = (unsigned)r0_ * (unsigned)(lda * 2) + (unsigned)C_ * 2u; o1[_i] = (unsigned)r1_ * (unsigned)(lda * 2) + (unsigned)C_ * 2u; } \
        else { o0[_i] = (unsigned)(R_ * lda + C_) * 2u; o1[_i] = o0[_i] + (unsigned)(HALF * lda * 2); } } } while (0)
    Unit cur, nxt; int ui = 0;
    if (!S.next(0, cur)) return;
    f32x4 acc[2][2][4][2];
#pragma unroll
    for (int a = 0; a < 2; ++a)
#pragma unroll
        for (int b = 0; b < 2; ++b)
#pragma unroll
            for (int m = 0; m < 4; ++m)
#pragma unroll
                for (int n = 0; n < 2; ++n) acc[a][b][m][n] = (f32x4){0.f, 0.f, 0.f, 0.f};
    bf16x8 At[4][2], B0[2][2], B1[2][2];
    unsigned vA0[2], vA1[2];
    LAS unsigned* rowbuf = (LAS unsigned*)(lds + LDS_MISC_OFF + 1024);
    PG8_SETOFF(cur, vA0, vA1);
    const char* cA = cur.A; const char* cB = cur.B;
    PG8_STAGE(PG8_SB(0, 0), cB, voffB); PG8_STAGE(PG8_SA(0, 0), cA, vA0); PG8_STAGE(PG8_SB(0, 1), cB + hstepB, voffB); PG8_STAGE(PG8_SA(0, 1), cA, vA1);
    if (wr == 1) PG8_BAR;
    PG8_WAIT_V(4); PG8_BAR;
    PG8_STAGE(PG8_SB(1, 0), cB + kstep, voffB); PG8_STAGE(PG8_SA(1, 0), cA + kstep, vA0); PG8_STAGE(PG8_SB(1, 1), cB + hstepB + kstep, voffB);
    PG8_WAIT_V(6); PG8_BAR;
    for (;;) {
        const bool has_next = S.next(ui + 1, nxt);
        if (GATHER && has_next && wid < 4) {
            __builtin_amdgcn_global_load_lds((const unsigned*)(nxt.rows + lane + wid * 64), (LAS unsigned*)(rowbuf + wid * 64), 4, 0, 0); }
        const char* nA = has_next ? nxt.A : cA; const char* nB = has_next ? nxt.B : cB;
        const int nt = cur.nt;
        for (int t = 0; t < nt; t += 2) {
            const bool last = (t == nt - 2);
            const char* a1 = cA + (size_t)(t + 1) * kstep;
            const char* a2 = last ? nA : cA + (size_t)(t + 2) * kstep; const char* b2 = last ? nB : cB + (size_t)(t + 2) * kstep;
            const char* a3 = a2 + kstep; const char* b3 = b2 + kstep;
            PG8_LDB(B0, 0, 0); PG8_SCHED; PG8_LDA(At, 0, 0); PG8_STAGE(PG8_SA(1, 1), a1, vA1);
            PG8_WAIT_L(8); PG8_BAR; PG8_WAIT_L(0); PG8_MMA(0, 0, At, B0); PG8_BAR; PG8_SCHED;
            if (GATHER && last && has_next) {
                int t4_ = tid; asm volatile("" : "+v"(t4_));
                _Pragma("unroll") for (int _i = 0; _i < 2; ++_i) { int R_, C_; stage_rc(t4_ * 16 + _i * 8192, R_, C_); vA0[_i] = (R_ < nxt.valid ? (rowbuf[R_] >> 1) : 0u) * (unsigned)(lda * 2) + (unsigned)C_ * 2u; vA1[_i] = (R_ + HALF < nxt.valid ? (rowbuf[R_ + HALF] >> 1) : 0u) * (unsigned)(lda * 2) + (unsigned)C_ * 2u; }
            }
            PG8_LDB(B1, 0, 1); PG8_STAGE(PG8_SB(0, 0), b2, voffB);
            PG8_BAR; PG8_WAIT_L(0); PG8_MMA(0, 1, At, B1); PG8_BAR;
            PG8_LDA(At, 0, 1); PG8_STAGE(PG8_SA(0, 0), a2, vA0);
            PG8_BAR; PG8_WAIT_L(0); PG8_MMA(1, 0, At, B0); PG8_BAR; PG8_SCHED;
            PG8_STAGE(PG8_SB(0, 1), b2 + hstepB, voffB);
            PG8_WAIT_V(6); PG8_BAR; PG8_MMA(1, 1, At, B1); PG8_BAR;
            PG8_LDB(B0, 1, 0); PG8_SCHED; PG8_LDA(At, 1, 0); PG8_STAGE(PG8_SA(0, 1), a2, vA1);
            PG8_WAIT_L(8); PG8_BAR; PG8_WAIT_L(0); PG8_MMA(0, 0, At, B0); PG8_BAR; PG8_SCHED;
            PG8_LDB(B1, 1, 1); PG8_STAGE(PG8_SB(1, 0), b3, voffB);
            PG8_BAR; PG8_WAIT_L(0); PG8_MMA(0, 1, At, B1); PG8_BAR;
            PG8_LDA(At, 1, 1); PG8_STAGE(PG8_SA(1, 0), a3, vA0);
            PG8_BAR; PG8_WAIT_L(0); PG8_MMA(1, 0, At, B0); PG8_BAR; PG8_SCHED;
            PG8_STAGE(PG8_SB(1, 1), b3 + hstepB, voffB);
            PG8_WAIT_V(6); PG8_BAR; PG8_MMA(1, 1, At, B1); PG8_BAR;
        }
        E(acc, cur, wr, wc, fr, fq);
        if (!has_next) break;
#pragma unroll
        for (int a = 0; a < 2; ++a)
#pragma unroll
            for (int b = 0; b < 2; ++b)
#pragma unroll
                for (int m = 0; m < 4; ++m)
#pragma unroll
                    for (int n = 0; n < 2; ++n) acc[a][b][m][n] = (f32x4){0.f, 0.f, 0.f, 0.f};
        cur = nxt; cA = nA; cB = nB; ++ui;
    }
    PG8_WAIT_V(0);
    if (wr == 0) PG8_BAR;
    PG8_BAR;
#undef PG8_SA
#undef PG8_SB
#undef PG8_STAGE
#undef PG8_LDA
#undef PG8_LDB
#undef PG8_MMA
#undef PG8_WAIT_V
#undef PG8_WAIT_L
#undef PG8_BAR
#undef PG8_SCHED
#undef PG8_SETOFF
}

struct EpiBf16 {
    static constexpr bool PERM = true;
    bf16_t* O; int ldc;
    bf16_t* R[4]; int rld[4]; int rt0[5];
    int route;
    __device__ __forceinline__ void operator()(const f32x4 (&acc)[2][2][4][2], const Unit& u, int wr, int wc, int fr, int fq) const {
        asm volatile("" : "+v"(fr), "+v"(fq));
        const int row0 = u.pm * BM + wr * 64 + fr; bf16_t* base = O + (size_t)u.pn * BM; int ld = ldc;
        if (route) {
#pragma unroll
            for (int k = 0; k < 4; ++k) if (u.pn >= rt0[k] && u.pn < rt0[k + 1]) { base = R[k] + (size_t)(u.pn - rt0[k]) * BM; ld = rld[k]; }
        }
        const int col0 = wc * 32 + 8 * fq;
#pragma unroll
        for (int ai = 0; ai < 2; ++ai)
#pragma unroll
            for (int m = 0; m < 4; ++m) { bf16_t* rowp = base + (size_t)(row0 + ai * HALF + m * 16) * ld + col0;
#pragma unroll
                for (int bj = 0; bj < 2; ++bj) { const f32x4 v0 = acc[ai][bj][m][0], v1 = acc[ai][bj][m][1];
                    u32x4 w = {cvt_pk_bf16(v0[0], v0[1]), cvt_pk_bf16(v0[2], v0[3]), cvt_pk_bf16(v1[0], v1[1]), cvt_pk_bf16(v1[2], v1[3])};
                    *(u32x4*)(rowp + bj * HALF) = w; } }
    }
};
struct EpiResid {
    static constexpr bool PERM = false;
    float* Hout; float* Hside; float* PART;
    __device__ __forceinline__ void operator()(const f32x4 (&acc)[2][2][4][2], const Unit& u, int wr, int wc, int fr, int fq) const {
        asm volatile("" : "+v"(fr), "+v"(fq));
        if (u.part >= 0) {
            float* base = PART + (size_t)u.part * (BM * BM) + (size_t)(wr * 64 + fr) * BM + wc * 32 + 4 * fq;
#pragma unroll
            for (int ai = 0; ai < 2; ++ai)
#pragma unroll
                for (int m = 0; m < 4; ++m)
#pragma unroll
                    for (int bj = 0; bj < 2; ++bj)
#pragma unroll
                        for (int n = 0; n < 2; ++n) *(f32x4*)(base + (size_t)(ai * HALF + m * 16) * BM + bj * HALF + n * 16) = acc[ai][bj][m][n];
            return;
        }
        const int row0 = u.pm * BM + wr * 64 + fr, col0 = u.pn * BM + wc * 32 + 4 * fq;
#pragma unroll
        for (int ai = 0; ai < 2; ++ai)
#pragma unroll
            for (int mh = 0; mh < 2; ++mh) {
                float* rowp[2]; bool ok[2]; f32x4 t[2][2][2];
#pragma unroll
                for (int mm = 0; mm < 2; ++mm) { const int row = row0 + ai * HALF + (2 * mh + mm) * 16; ok[mm] = row_valid(row); rowp[mm] = hf_row(Hout, Hside, ok[mm] ? row : row0) + col0;
#pragma unroll
                    for (int bj = 0; bj < 2; ++bj)
#pragma unroll
                        for (int n = 0; n < 2; ++n) { t[mm][bj][n] = (f32x4){0.f, 0.f, 0.f, 0.f}; if (ok[mm]) t[mm][bj][n] = *(const f32x4*)(rowp[mm] + bj * HALF + n * 16); } }
#pragma unroll
                for (int mm = 0; mm < 2; ++mm) { if (!ok[mm]) continue;
#pragma unroll
                    for (int bj = 0; bj < 2; ++bj)
#pragma unroll
                        for (int n = 0; n < 2; ++n) *(f32x4*)(rowp[mm] + bj * HALF + n * 16) = t[mm][bj][n] + acc[ai][bj][2 * mh + mm][n]; }
            }
    }
};
struct EpiSwiglu {
    static constexpr bool PERM = true;
    bf16_t* O; int ldc;
    __device__ __forceinline__ void operator()(const f32x4 (&acc)[2][2][4][2], const Unit& u, int wr, int wc, int fr, int fq) const {
        asm volatile("" : "+v"(fr), "+v"(fq));
        const int row0 = u.orow0 + wr * 64 + fr, col0 = u.pn * HALF + wc * 32 + 8 * fq;
#pragma unroll
        for (int ai = 0; ai < 2; ++ai)
#pragma unroll
            for (int m = 0; m < 4; ++m) { bf16_t* rowp = O + (size_t)(row0 + ai * HALF + m * 16) * ldc + col0;
                float r[8];
#pragma unroll
                for (int n = 0; n < 2; ++n)
#pragma unroll
                    for (int j = 0; j < 4; ++j) r[n * 4 + j] = siluf(acc[ai][0][m][n][j]) * acc[ai][1][m][n][j];
                u32x4 w = {cvt_pk_bf16(r[0], r[1]), cvt_pk_bf16(r[2], r[3]), cvt_pk_bf16(r[4], r[5]), cvt_pk_bf16(r[6], r[7])};
                *(u32x4*)rowp = w; }
    }
};

struct MoeSched {
    int G, c, nN, cap, gather, ntk, kcap; unsigned pc[4], pt[2]; const char* A; const char* B; size_t tstepA, tstepB, estepB; const int* lst; const float* gl;
    __device__ void init(const unsigned* cntw, int nN_, int G_, int c_, const void* A_, int lda, const void* B_, int K, size_t estep_elems, const int* lst_, const float* gl_, int cap_, int gather_, int kcap_ = 0) {
        kcap = kcap_;
        { const unsigned c0 = cntw[0], c1 = cntw[64], c2 = cntw[128], c3 = cntw[192], c4 = cntw[256], c5 = cntw[320], c6 = cntw[384], c7 = cntw[448];
          const unsigned t1 = (c0 + 255) >> 8, t2 = t1 + ((c1 + 255) >> 8), t3 = t2 + ((c2 + 255) >> 8), t4 = t3 + ((c3 + 255) >> 8), t5 = t4 + ((c4 + 255) >> 8), t6 = t5 + ((c5 + 255) >> 8), t7 = t6 + ((c6 + 255) >> 8), nM = t7 + ((c7 + 255) >> 8);
          pc[0] = c0 | (c1 << 16); pc[1] = c2 | (c3 << 16); pc[2] = c4 | (c5 << 16); pc[3] = c6 | (c7 << 16);
          pt[0] = t1 | (t2 << 8) | (t3 << 16) | (t4 << 24); pt[1] = t5 | (t6 << 8) | (t7 << 16) | (nM << 24); } nN = nN_; G = G_; c = c_; ntk = K / BK; A = (const char*)A_; B = (const char*)B_; tstepA = (size_t)BM * lda * 2; tstepB = (size_t)BM * K * 2; estepB = estep_elems * 2; lst = lst_; gl = gl_; cap = cap_; gather = gather_;
    }
    __device__ bool next(int i, Unit& u) const {
        const int c0 = pc[0] & 0xFFFF, c1 = pc[0] >> 16, c2 = pc[1] & 0xFFFF, c3 = pc[1] >> 16, c4 = pc[2] & 0xFFFF, c5 = pc[2] >> 16, c6 = pc[3] & 0xFFFF, c7 = pc[3] >> 16;
        const int t1 = pt[0] & 255, t2 = (pt[0] >> 8) & 255, t3 = (pt[0] >> 16) & 255, t4 = pt[0] >> 24, t5 = pt[1] & 255, t6 = (pt[1] >> 8) & 255, t7 = (pt[1] >> 16) & 255, nM = pt[1] >> 24;
        const int nwg = nM * nN;
        int S = 1, full = 0, tail = 0;
        if (kcap > 0) { full = nwg / G; tail = nwg - full * G;
            if (tail > 0) { if (ntk % 14 == 0 && tail * 7 <= G && tail * 7 <= kcap) S = 7; else if (ntk % 8 == 0 && tail * 4 <= G && tail * 4 <= kcap) S = 4; else if (ntk % 4 == 0 && tail * 2 <= G && tail * 2 <= kcap) S = 2; } }
        long Lx; int sj = 0, st = 0;
        if (i < 0) { if (S == 1 || c >= tail) return false; st = c; Lx = (long)full * G + st; }
        else if (S == 1) { Lx = (long)i * G + c; if (Lx >= nwg) return false; }
        else if (i < full) Lx = (long)i * G + c;
        else if (i == full && c < tail * S) { st = c / S; sj = c - st * S; Lx = (long)full * G + st; }
        else return false;
        int wgid = (int)Lx; { const int q = nwg / NXCD, r = nwg % NXCD, xcd = wgid % NXCD, off = wgid / NXCD; wgid = (xcd < r ? xcd * (q + 1) : r * (q + 1) + (xcd - r) * q) + off; }
        const int nig = WGM * nN, gid = wgid / nig, fm = gid * WGM, gsz = (nM - fm) < WGM ? (nM - fm) : WGM;
        const int pm = fm + ((wgid % nig) % gsz), pn = (wgid % nig) / gsz;
        const int e = (pm >= t1) + (pm >= t2) + (pm >= t3) + (pm >= t4) + (pm >= t5) + (pm >= t6) + (pm >= t7);
        const int tb = e == 0 ? 0 : e == 1 ? t1 : e == 2 ? t2 : e == 3 ? t3 : e == 4 ? t4 : e == 5 ? t5 : e == 6 ? t6 : t7;
        const int ce = e == 0 ? c0 : e == 1 ? c1 : e == 2 ? c2 : e == 3 ? c3 : e == 4 ? c4 : e == 5 ? c5 : e == 6 ? c6 : c7;
        const int m = pm - tb, rem = ce - m * BM;
        u.pm = pm; u.pn = pn; u.valid = rem < BM ? rem : BM; u.orow0 = pm * BM;
        u.rows = lst + (size_t)e * cap + m * BM; u.gates = gl + (size_t)e * cap + m * BM;
        u.A = gather ? A : A + (size_t)pm * tstepA; u.B = B + (size_t)e * estepB + (size_t)pn * tstepB; u.nt = ntk; u.part = -1; u.kw = S; u.kb = tail;
        if (S > 1 && (i == full || i < 0)) { const int nts = ntk / S; const size_t ko = (size_t)sj * nts * (BK * 2); u.nt = nts; u.A += ko; u.B += ko; u.part = st * S + sj; }
        return true;
    }
};
struct EpiMoeDown {
    static constexpr bool PERM = false;
    float* Hout; float* Hside; bf16_t* YS1; int b0;
    float* PK;
    __device__ __forceinline__ void operator()(const f32x4 (&acc)[2][2][4][2], const Unit& u, int wr, int wc, int fr, int fq) const {
        asm volatile("" : "+v"(fr), "+v"(fq));
        if (u.part >= 0) {
            float* base = PK + (size_t)u.part * (BM * BM) + (size_t)(wr * 64 + fr) * BM + wc * 32 + 4 * fq;
#pragma unroll
            for (int ai = 0; ai < 2; ++ai)
#pragma unroll
                for (int m = 0; m < 4; ++m)
#pragma unroll
                    for (int bj = 0; bj < 2; ++bj)
#pragma unroll
                        for (int n = 0; n < 2; ++n) *(f32x4*)(base + (size_t)(ai * HALF + m * 16) * BM + bj * HALF + n * 16) = acc[ai][bj][m][n];
            return;
        }
        const int col0 = u.pn * BM + wc * 32 + 4 * fq;
        int ent[2][4]; float gt[2][4];
#pragma unroll
        for (int ai = 0; ai < 2; ++ai)
#pragma unroll
            for (int m = 0; m < 4; ++m) { const int rl = ai * HALF + wr * 64 + m * 16 + fr; ent[ai][m] = -1; gt[ai][m] = 0.f; if (rl < u.valid) { ent[ai][m] = u.rows[rl]; gt[ai][m] = u.gates[rl]; } }
#pragma unroll
        for (int ai = 0; ai < 2; ++ai)
#pragma unroll
            for (int mh = 0; mh < 2; ++mh) {
                float* rowp[2]; f32x4 t[2][2][2];
#pragma unroll
                for (int mm = 0; mm < 2; ++mm) { const int entry = ent[ai][2 * mh + mm]; const bool s0 = entry >= 0 && (entry & 1) == 0; rowp[mm] = hf_row(Hout, Hside, s0 ? (entry >> 1) : PADF) + col0;
#pragma unroll
                    for (int bj = 0; bj < 2; ++bj)
#pragma unroll
                        for (int n = 0; n < 2; ++n) { t[mm][bj][n] = (f32x4){0.f, 0.f, 0.f, 0.f}; if (s0) t[mm][bj][n] = *(const f32x4*)(rowp[mm] + bj * HALF + n * 16); } }
#pragma unroll
                for (int mm = 0; mm < 2; ++mm) { const int m = 2 * mh + mm; const int entry = ent[ai][m]; if (entry < 0) continue; const float g = gt[ai][m]; const int row = entry >> 1;
                    if ((entry & 1) == 0) {
#pragma unroll
                        for (int bj = 0; bj < 2; ++bj)
#pragma unroll
                            for (int n = 0; n < 2; ++n) *(f32x4*)(rowp[mm] + bj * HALF + n * 16) = t[mm][bj][n] + acc[ai][bj][m][n] * g;
                    } else { const int b = row / LP, lp = row - b * LP; bf16_t* yp = YS1 + ((size_t)(b - b0) * L + (lp - PADF)) * D + col0;
#pragma unroll
                        for (int bj = 0; bj < 2; ++bj)
#pragma unroll
                            for (int n = 0; n < 2; ++n) { const f32x4 v = acc[ai][bj][m][n] * g; *(u32x2*)(yp + bj * HALF + n * 16) = (u32x2){cvt_pk_bf16(v[0], v[1]), cvt_pk_bf16(v[2], v[3])}; }
                    } }
            }
    }
};
__device__ __forceinline__ void moe_tail_fixup(const MoeSched& S0, float* Hout, float* Hside, bf16_t* YS1, int b0, const float* PK, int bx, int G, const int wave_idx_) {
    const int tid = fresh_tid(), lane = tid & 63, wv = tid >> 6;
    MoeSched S = S0; S.c = 0; Unit u;
    if (!S.next(-1, u)) return;
    const int tail = u.kb, ns = u.kw, bpu = G / tail;
    const int t = bx / bpu, sl = bx - t * bpu; if (t >= tail) return;
    S.c = t; if (!S.next(-1, u)) return;
    const int rpb = (BM + bpu - 1) / bpu, r0 = sl * rpb, r1 = (r0 + rpb < u.valid) ? r0 + rpb : u.valid;
    const float* pk = PK + (size_t)(t * ns) * (BM * BM);
    for (int rl = r0 + wv; rl < r1; rl += 8) {
        f32x4 v = *(const f32x4*)(pk + (size_t)rl * BM + 4 * lane);
        for (int s = 1; s < ns; ++s) v += *(const f32x4*)(pk + (size_t)s * (BM * BM) + (size_t)rl * BM + 4 * lane);
        const int entry = u.rows[rl]; const float g = u.gates[rl]; const int row = entry >> 1; v = v * g;
        if ((entry & 1) == 0) { f32x4* p = (f32x4*)(hf_row(Hout, Hside, row) + u.pn * BM + 4 * lane); *p = *p + v; }
        else { const int b = row / LP, lp = row - b * LP; *(u32x2*)(YS1 + ((size_t)(b - b0) * L + (lp - PADF)) * D + u.pn * BM + 4 * lane) = (u32x2){cvt_pk_bf16(v[0], v[1]), cvt_pk_bf16(v[2], v[3])}; }
    }
}
}

__device__ __forceinline__ int inproj_src_col(int n) {
    if (n < 2048) return n;
    if (n < 3584) return 2064 + (n - 2048);
    if (n < 3840) return 3600 + (n - 3584);
    if (n < 3968) return 3856 + (n - 3840);
    if (n < 4032) return 3984 + (n - 3968);
    if (n < 4048) return 2048 + (n - 4032);
    return -1;
}
struct XpReg { f32x4 a0, a1, b0, b1; };
__device__ __forceinline__ void xpose_load(XpReg& r, const int MODE, const int tid, const float* __restrict__ src, int ldsrc, int N, int n0, int k0) {
    const int kp = tid >> 3, nn = (tid & 7) * 8;
    const int n = n0 + nn;
    int sc = n; if (MODE == 1) sc = inproj_src_col(n);
    r.a0 = (f32x4){0.f, 0.f, 0.f, 0.f}; r.a1 = r.a0; r.b0 = r.a0; r.b1 = r.a0;
    if (sc >= 0 && n < N) { const float* p0 = src + (size_t)(k0 + 2 * kp) * ldsrc + sc;
        r.a0 = *(const f32x4*)p0; r.a1 = *(const f32x4*)(p0 + 4); r.b0 = *(const f32x4*)(p0 + ldsrc); r.b1 = *(const f32x4*)(p0 + ldsrc + 4); }
}
__device__ __forceinline__ void xpose_finish(const XpReg& r, const int MODE, LAS bf16_t* tile, const int tid, int N, bf16_t* __restrict__ dst, int lddst, int n0, int k0) {
    {
        const int kp = tid >> 3, nn = (tid & 7) * 8;
#pragma unroll
        for (int j = 0; j < 4; ++j) { *(LAS unsigned*)(tile + (nn + j) * 136 + 2 * kp) = cvt_pk_bf16(r.a0[j], r.b0[j]); *(LAS unsigned*)(tile + (nn + 4 + j) * 136 + 2 * kp) = cvt_pk_bf16(r.a1[j], r.b1[j]); }
    }
    __syncthreads();
    {
        const int nn = tid >> 3, kc = (tid & 7) * 16; const int n = n0 + nn;
        if (n < N || MODE == 1) {
            int dr = n; if (MODE == 2) dr = (n >> 7) * 256 + (n & 127); if (MODE == 3) dr = (n >> 7) * 256 + 128 + (n & 127);
            const u32x4 w0 = *(const LAS u32x4*)(tile + nn * 136 + kc), w1 = *(const LAS u32x4*)(tile + nn * 136 + kc + 8);
            bf16_t* q = dst + (size_t)dr * lddst + k0 + kc;
            *(u32x4*)q = w0; *(u32x4*)(q + 8) = w1;
        }
    }
    __syncthreads();
}
__device__ __forceinline__ void xpose_convert(const int MODE, LAS unsigned char* lds, const float* __restrict__ src, int ldsrc, int K, int N, bf16_t* __restrict__ dst, int lddst, int wg, int nwg, const int wave_idx_) {
    LAS bf16_t* tile = (LAS bf16_t*)lds;
    int tid_ = fresh_tid(); asm volatile("" : "+v"(tid_));
    const int tid = tid_, ntn = (N + 63) / 64, ntk = K / 128, ntiles = ntn * ntk;
    XpReg cur, nxt;
    if (wg < ntiles) xpose_load(cur, MODE, tid, src, ldsrc, N, (wg % ntn) * 64, (wg / ntn) * 128);
    for (int t = wg; t < ntiles; t += nwg) {
        const int tn = t + nwg;
        if (tn < ntiles) xpose_load(nxt, MODE, tid, src, ldsrc, N, (tn % ntn) * 64, (tn / ntn) * 128);
        xpose_finish(cur, MODE, tile, tid, N, dst, lddst, (t % ntn) * 64, (t / ntn) * 128);
        cur = nxt;
    }
}
__device__ __forceinline__ void moe_convert_queue(CParams& p, LAS unsigned char* lds, volatile LAS unsigned* misc, const int wave_idx_) {
    auto& B = p.b;
    LAS bf16_t* tile = (LAS bf16_t*)lds;
    int tid_ = fresh_tid(); asm volatile("" : "+v"(tid_));
    const int tid = tid_;
    constexpr int TOTAL = 24 * 448, BATCH = 4;
#define MOE_XP_LOAD(R, T) do { const int job_ = (T) / 448, tl_ = (T) - job_ * 448, e_ = job_ / 3, kind_ = job_ - 3 * e_; \
        if (kind_ == 0)      xpose_load(R, 2, tid, p.in[25] + (size_t)e_ * D * DFE, DFE, DFE, (tl_ % 56) * 64, (tl_ / 56) * 128); \
        else if (kind_ == 1) xpose_load(R, 3, tid, p.in[26] + (size_t)e_ * D * DFE, DFE, DFE, (tl_ % 56) * 64, (tl_ / 56) * 128); \
        else                 xpose_load(R, 0, tid, p.in[27] + (size_t)e_ * DFE * D, D, D, (tl_ % 16) * 64, (tl_ / 16) * 128); } while (0)
    for (;;) {
        __syncthreads();
        if (tid == 0) misc[17] = __hip_atomic_fetch_add(B.ctl + 9216, (unsigned)BATCH, __ATOMIC_RELAXED, __HIP_MEMORY_SCOPE_AGENT);
        __syncthreads();
        const int t0 = (int)misc[17];
        if (t0 >= TOTAL) break;
        XpReg cur, nxt, nx2;
        MOE_XP_LOAD(cur, t0);
        if (t0 + 1 < TOTAL) MOE_XP_LOAD(nxt, t0 + 1);
        for (int t = t0; t < t0 + BATCH && t < TOTAL; ++t) {
            if (t + 2 < t0 + BATCH && t + 2 < TOTAL) MOE_XP_LOAD(nx2, t + 2);
            const int job = t / 448, tl = t - job * 448, e = job / 3, kind = job - 3 * e;
            if (kind == 0)      xpose_finish(cur, 2, tile, tid, DFE, B.W1T + (size_t)e * 2 * DFE * D, D, (tl % 56) * 64, (tl / 56) * 128);
            else if (kind == 1) xpose_finish(cur, 3, tile, tid, DFE, B.W1T + (size_t)e * 2 * DFE * D, D, (tl % 56) * 64, (tl / 56) * 128);
            else                xpose_finish(cur, 0, tile, tid, D, B.W2T + (size_t)e * D * DFE, DFE, (tl % 16) * 64, (tl / 16) * 128);
            cur = nxt; nxt = nx2;
        }
    }
#undef MOE_XP_LOAD
}

__device__ __forceinline__ void norm_rows(float* Hout, float* Hside, const float* __restrict__ w, bf16_t* __restrict__ Ub, int wg, int nwg, const float* PART, int nMm, int SPLIT, const int wave_idx_) {
    int tid_ = fresh_tid(); asm volatile("" : "+v"(tid_));
    const int lane = tid_ & 63, wv = tid_ >> 6;
    f32x4 gw[4];
#pragma unroll
    for (int j = 0; j < 4; ++j) gw[j] = *(const f32x4*)(w + j * 256 + lane * 4);
    f32x4 vn[4];
#pragma unroll
    for (int j = 0; j < 4; ++j) vn[j] = (f32x4){0.f, 0.f, 0.f, 0.f};
    { const int row0 = wg * 8 + wv; if (row0 < MP) { const float* p0 = hf_row(Hout, Hside, row0);
#pragma unroll
        for (int j = 0; j < 4; ++j) vn[j] = *(const f32x4*)(p0 + j * 256 + lane * 4); } }
    for (int row = wg * 8 + wv; row < MP; row += nwg * 8) {
        float* p = hf_row(Hout, Hside, row); f32x4 v[4]; float ss = 0.f;
#pragma unroll
        for (int j = 0; j < 4; ++j) v[j] = vn[j];
        { const int rn = row + nwg * 8; if (rn < MP) { const float* pn = hf_row(Hout, Hside, rn);
#pragma unroll
            for (int j = 0; j < 4; ++j) vn[j] = *(const f32x4*)(pn + j * 256 + lane * 4); } }
        const bool fix = SPLIT > 0 && row >= nMm * 256 && row_valid(row);
#pragma unroll
        for (int j = 0; j < 4; ++j) {
            if (fix) { const float* pp = PART + ((size_t)((row / 256 - nMm) * 4 + j) * SPLIT) * 65536 + (size_t)(row % 256) * 256 + lane * 4;
                for (int sp = 0; sp < SPLIT; ++sp) v[j] += *(const f32x4*)(pp + (size_t)sp * 65536);
                *(f32x4*)(p + j * 256 + lane * 4) = v[j]; }
            ss += v[j][0] * v[j][0] + v[j][1] * v[j][1] + v[j][2] * v[j][2] + v[j][3] * v[j][3]; }
        ss = wave_sum(ss);
        const float rs = rsqrtf(ss * (1.f / D) + EPS);
#pragma unroll
        for (int j = 0; j < 4; ++j) { const f32x4 g = gw[j];
            u32x2 o = {cvt_pk_bf16(v[j][0] * rs * g[0], v[j][1] * rs * g[1]), cvt_pk_bf16(v[j][2] * rs * g[2], v[j][3] * rs * g[3])};
            *(u32x2*)(Ub + (size_t)row * D + j * 256 + lane * 4) = o; }
    }
}
__device__ __forceinline__ void build_rows(const float* __restrict__ x, const float* __restrict__ meta, const float* __restrict__ w, float* Hout, float* Hside, bf16_t* __restrict__ Ub, int wg, int nwg, const int wave_idx_) {
    int tid_ = fresh_tid(); asm volatile("" : "+v"(tid_));
    const int lane = tid_ & 63, wv = tid_ >> 6;
#define BUILD_LOAD(V, ROW) do { const int b_ = (ROW) / LP, lp_ = (ROW) % LP; const float* p_ = nullptr; \
        if ((ROW) < NB * LP && lp_ >= PADF) p_ = lp_ < PADF + NM ? meta + (size_t)(lp_ - PADF) * D : x + ((size_t)b_ * SEQ + (lp_ - PADF - NM)) * D; \
        _Pragma("unroll") for (int j_ = 0; j_ < 4; ++j_) V[j_] = p_ ? *(const f32x4*)(p_ + j_ * 256 + lane * 4) : (f32x4){0.f, 0.f, 0.f, 0.f}; } while (0)
    f32x4 vn[4];
#pragma unroll
    for (int j = 0; j < 4; ++j) vn[j] = (f32x4){0.f, 0.f, 0.f, 0.f};
    { const int row0 = wg * 8 + wv; if (row0 < MP) BUILD_LOAD(vn, row0); }
    for (int row = wg * 8 + wv; row < MP; row += nwg * 8) {
        f32x4 v[4]; float ss = 0.f;
#pragma unroll
        for (int j = 0; j < 4; ++j) v[j] = vn[j];
        { const int rn = row + nwg * 8; if (rn < MP) BUILD_LOAD(vn, rn); }
#pragma unroll
        for (int j = 0; j < 4; ++j) ss += v[j][0] * v[j][0] + v[j][1] * v[j][1] + v[j][2] * v[j][2] + v[j][3] * v[j][3];
        ss = wave_sum(ss);
        const float rs = rsqrtf(ss * (1.f / D) + EPS);
#pragma unroll
        for (int j = 0; j < 4; ++j) { const f32x4 g = *(const f32x4*)(w + j * 256 + lane * 4);
            *(f32x4*)(hf_row(Hout, Hside, row) + j * 256 + lane * 4) = v[j];
            u32x2 o = {cvt_pk_bf16(v[j][0] * rs * g[0], v[j][1] * rs * g[1]), cvt_pk_bf16(v[j][2] * rs * g[2], v[j][3] * rs * g[3])};
            *(u32x2*)(Ub + (size_t)row * D + j * 256 + lane * 4) = o; }
    }
}
constexpr float LOG2E = 1.4426950408889634f;
constexpr float DIFF_QSCALE = 0.125f * LOG2E;
constexpr float MLA_QSCALE = 0.07216878364870322f * LOG2E;

__device__ __forceinline__ void unpack8(const u32x4 w, float (&v)[8]) {
    v[0] = bflo(w[0]); v[1] = bfhi(w[0]); v[2] = bflo(w[1]); v[3] = bfhi(w[1]); v[4] = bflo(w[2]); v[5] = bfhi(w[2]); v[6] = bflo(w[3]); v[7] = bfhi(w[3]);
}
__device__ __forceinline__ u32x4 pack8(const float (&v)[8]) { return (u32x4){cvt_pk_bf16(v[0], v[1]), cvt_pk_bf16(v[2], v[3]), cvt_pk_bf16(v[4], v[5]), cvt_pk_bf16(v[6], v[7])}; }

__device__ __forceinline__ void prep_rows(CParams& p, int l, int wg, int nwg, const int wave_idx_) {
    auto& B = p.b;
    int tid_ = fresh_tid(); asm volatile("" : "+v"(tid_));
    const int lane = tid_ & 63, wv = tid_ >> 6;
    const float* qw = p.in[9] + l * 64; const float* kw = p.in[10] + l * 64;
    const float* cqw = p.in[13] + l * 256; const float* ckvw = p.in[15] + l * 128;
    const float* a_log = p.in[6] + l * 8; const float* dt_bias = p.in[7] + l * 8;
    float gq[8], gk[8];
#pragma unroll
    for (int j = 0; j < 8; ++j) { gq[j] = qw[(lane & 7) * 8 + j] * DIFF_QSCALE; gk[j] = kw[(lane & 7) * 8 + j]; }
    float gcq[4], gckv[2];
#pragma unroll
    for (int j = 0; j < 4; ++j) gcq[j] = cqw[lane * 4 + j];
    gckv[0] = ckvw[lane * 2]; gckv[1] = ckvw[lane * 2 + 1];
#define PREP_LOAD(WQ, WK, WC, WKV, WBA, ROW) do { const bf16_t* g3_ = B.G3 + (size_t)(ROW) * 1536; const bf16_t* g4_ = B.G4 + (size_t)(ROW) * 512; \
        WQ = *(const u32x4*)(g3_ + lane * 8); WK = *(const u32x4*)(g3_ + 512 + lane * 8); WC = *(const u32x2*)(g4_ + lane * 4); WKV = *(const unsigned*)(g4_ + 256 + lane * 2); \
        WBA = 0u; if (lane < 8) WBA = (unsigned)*(const unsigned short*)(g4_ + 448 + lane) | ((unsigned)*(const unsigned short*)(g4_ + 456 + lane) << 16); } while (0)
    u32x4 cq4 = {0u, 0u, 0u, 0u}, ck4 = {0u, 0u, 0u, 0u}; u32x2 cc2 = {0u, 0u}; unsigned ckv = 0u, cba = 0u;
    { const int row0 = wg * 8 + wv; if (row0 < MP) PREP_LOAD(cq4, ck4, cc2, ckv, cba, row0); }
    for (int row = wg * 8 + wv; row < MP; row += nwg * 8) {
        u32x4 nq4 = {0u, 0u, 0u, 0u}, nk4 = {0u, 0u, 0u, 0u}; u32x2 nc2 = {0u, 0u}; unsigned nkv = 0u, nba = 0u;
        { const int rn = row + nwg * 8; if (rn < MP) PREP_LOAD(nq4, nk4, nc2, nkv, nba, rn); }
        bf16_t* g3 = B.G3 + (size_t)row * 1536;
        {
            float v[8];
            unpack8(cq4, v);
            float ss = 0.f;
#pragma unroll
            for (int j = 0; j < 8; ++j) ss += v[j] * v[j];
            ss += shx<1>(ss); ss += shx<2>(ss); ss += shx<4>(ss);
            float rs = rsqrtf(ss * (1.f / 64.f) + EPS);
#pragma unroll
            for (int j = 0; j < 8; ++j) v[j] = v[j] * rs * gq[j];
            *(u32x4*)(g3 + lane * 8) = pack8(v);
            unpack8(ck4, v);
            ss = 0.f;
#pragma unroll
            for (int j = 0; j < 8; ++j) ss += v[j] * v[j];
            ss += shx<1>(ss); ss += shx<2>(ss); ss += shx<4>(ss);
            rs = rsqrtf(ss * (1.f / 64.f) + EPS);
#pragma unroll
            for (int j = 0; j < 8; ++j) v[j] = v[j] * rs * gk[j];
            *(u32x4*)(g3 + 512 + lane * 8) = pack8(v);
        }
        bf16_t* g4 = B.G4 + (size_t)row * 512;
        {
            float a0 = bflo(cc2[0]), a1 = bfhi(cc2[0]), a2 = bflo(cc2[1]), a3 = bfhi(cc2[1]);
            float ss = wave_sum(a0 * a0 + a1 * a1 + a2 * a2 + a3 * a3);
            float rs = rsqrtf(ss * (1.f / 256.f) + EPS);
            *(u32x2*)(g4 + lane * 4) = (u32x2){cvt_pk_bf16(a0 * rs * gcq[0], a1 * rs * gcq[1]), cvt_pk_bf16(a2 * rs * gcq[2], a3 * rs * gcq[3])};
            a0 = bflo(ckv); a1 = bfhi(ckv);
            ss = wave_sum(a0 * a0 + a1 * a1);
            rs = rsqrtf(ss * (1.f / 128.f) + EPS);
            *(unsigned*)(g4 + 256 + lane * 2) = cvt_pk_bf16(a0 * rs * gckv[0], a1 * rs * gckv[1]);
        }
        if (lane < 8) {
            const float bl = bflo(cba), al = bfhi(cba) + dt_bias[lane];
            const float sp = al > 20.f ? al : __logf(1.f + __expf(al));
            B.BG[(size_t)row * 16 + lane] = 1.f / (1.f + __expf(-bl));
            B.BG[(size_t)row * 16 + 8 + lane] = -__expf(a_log[lane]) * sp;
        }
        cq4 = nq4; ck4 = nk4; cc2 = nc2; ckv = nkv; cba = nba;
    }
#undef PREP_LOAD
}

__device__ __forceinline__ void build_wu(CParams& p, int wg, int nwg, const int wave_idx_) {
    const size_t n = (size_t)2 * 2048 * 384;
    int tid_ = fresh_tid(); asm volatile("" : "+v"(tid_));
    const size_t stride = (size_t)nwg * NWG_THREADS;
    for (size_t i0 = (size_t)wg * NWG_THREADS + tid_; i0 < n; i0 += 4 * stride) {
        float v[4];
#pragma unroll
        for (int q = 0; q < 4; ++q) { const size_t i = i0 + q * stride; v[q] = 0.f;
            if (i < n) { const int k = (int)(i % 384); const int nn = (int)((i / 384) % 2048); const int l = (int)(i / (384 * 2048));
                if (nn < 1024) { const int h = nn >> 8, j = nn & 255; if (j < 192 && k < 256) v[q] = p.in[14][((size_t)l * 256 + k) * 768 + h * 192 + j]; }
                else { const int h = (nn - 1024) >> 8, j = nn & 255; if (k >= 256) v[q] = p.in[16][((size_t)l * 128 + (k - 256)) * 1024 + h * 256 + j]; } } }
#pragma unroll
        for (int q = 0; q < 4; ++q) { const size_t i = i0 + q * stride; if (i < n) p.b.WuT[i] = f2bf(v[q]); }
    }
}

__device__ __forceinline__ void mla_finalize(CParams& p, int l, int wg, int nwg, const int wave_idx_) {
    auto& B = p.b;
    int tid_ = fresh_tid(); asm volatile("" : "+v"(tid_));
    const int lane = tid_ & 63, wv = tid_ >> 6;
    const float* qw = p.in[17] + l * 192; const float* kw = p.in[18] + l * 192;
    float gq[4] = {0.f, 0.f, 0.f, 0.f}, gk[4] = {0.f, 0.f, 0.f, 0.f};
    if (lane < 48) {
#pragma unroll
        for (int j = 0; j < 4; ++j) { gq[j] = qw[lane * 4 + j] * MLA_QSCALE; gk[j] = kw[lane * 4 + j]; }
    }
    const int ibase = (lane >= 40 ? lane - 40 : lane - 32) * 4;
    float invf[4];
#pragma unroll
    for (int j = 0; j < 4; ++j) invf[j] = __builtin_amdgcn_exp2f(-(float)(ibase + j) * (13.287712379549449f / 32.0f)) * 0.15915494309189535f;
#define MLAFIN_LOAD(W, ROW) do { const bf16_t* mx_ = B.MLX + (size_t)(ROW) * 2048; const bf16_t* g4_ = B.G4 + (size_t)(ROW) * 512; \
        _Pragma("unroll") for (int hw_ = 0; hw_ < 8; ++hw_) { const int h_ = hw_ >> 1, which_ = hw_ & 1; W[hw_] = (u32x2){0u, 0u}; \
            if (lane < 48) { const bf16_t* src_ = which_ == 0 ? mx_ + 256 * h_ + lane * 4 : (lane < 32 ? mx_ + 1024 + 256 * h_ + lane * 4 : g4_ + 384 + (lane - 32) * 4); W[hw_] = *(const u32x2*)src_; } } } while (0)
    u32x2 wcur[8], wnxt[8];
#pragma unroll
    for (int hw_ = 0; hw_ < 8; ++hw_) { wcur[hw_] = (u32x2){0u, 0u}; wnxt[hw_] = (u32x2){0u, 0u}; }
    { const int row0 = wg * 8 + wv; if (row0 < MP) MLAFIN_LOAD(wcur, row0); if (row0 + nwg * 8 < MP) MLAFIN_LOAD(wnxt, row0 + nwg * 8); }
    for (int row = wg * 8 + wv; row < MP; row += nwg * 8) {
        u32x2 wnx2[8];
        { const int rn = row + 2 * nwg * 8; if (rn < MP) MLAFIN_LOAD(wnx2, rn); else { _Pragma("unroll") for (int hw_ = 0; hw_ < 8; ++hw_) wnx2[hw_] = (u32x2){0u, 0u}; } }
        const int lp = row % LP; const float pos = (float)(lp - PADF);
        float cs[4], sn[4];
        if (lane >= 32 && lane < 48) {
#pragma unroll
            for (int j = 0; j < 4; ++j) { const float th = pos * invf[j], k = rintf(th), fr = fmaf(pos, invf[j], -k);
                cs[j] = __builtin_amdgcn_cosf(fr); sn[j] = __builtin_amdgcn_sinf(fr); }
        } else {
#pragma unroll
            for (int j = 0; j < 4; ++j) { cs[j] = 1.f; sn[j] = 0.f; }
        }
        bf16_t* mx = B.MLX + (size_t)row * 2048;
        float v[8][4], ss[8];
#pragma unroll
        for (int hw = 0; hw < 8; ++hw) { const int h = hw >> 1, which = hw & 1;
            (void)h; (void)which; const u32x2 w = wcur[hw];
            v[hw][0] = bflo(w[0]); v[hw][1] = bfhi(w[0]); v[hw][2] = bflo(w[1]); v[hw][3] = bfhi(w[1]);
            ss[hw] = v[hw][0] * v[hw][0] + v[hw][1] * v[hw][1] + v[hw][2] * v[hw][2] + v[hw][3] * v[hw][3]; }
#pragma unroll
        for (int hw = 0; hw < 8; ++hw) ss[hw] += shx<32>(ss[hw]);
#pragma unroll
        for (int hw = 0; hw < 8; ++hw) ss[hw] += shx<16>(ss[hw]);
#pragma unroll
        for (int hw = 0; hw < 8; ++hw) ss[hw] += shx<8>(ss[hw]);
#pragma unroll
        for (int hw = 0; hw < 8; ++hw) ss[hw] += shx<4>(ss[hw]);
#pragma unroll
        for (int hw = 0; hw < 8; ++hw) ss[hw] += shx<2>(ss[hw]);
#pragma unroll
        for (int hw = 0; hw < 8; ++hw) ss[hw] += shx<1>(ss[hw]);
#pragma unroll
        for (int hw = 0; hw < 8; ++hw) { const int h = hw >> 1, which = hw & 1;
            const float rs = rsqrtf(ss[hw] * (1.f / 192.f) + EPS);
            float o4[4];
#pragma unroll
            for (int j = 0; j < 4; ++j) { const float x = v[hw][j] * rs * (which == 0 ? gq[j] : gk[j]); const float other = shx<8>(x);
                o4[j] = lane < 32 ? x : (lane < 40 ? x * cs[j] - other * sn[j] : other * sn[j] + x * cs[j]); }
            if (lane < 48) {
                bf16_t* dst = which == 0 ? mx + 256 * h + lane * 4 : (lane < 32 ? mx + 1024 + 256 * h + lane * 4 : mx + 256 * h + 192 + (lane - 32) * 4);
                *(u32x2*)dst = (u32x2){cvt_pk_bf16(o4[0], o4[1]), cvt_pk_bf16(o4[2], o4[3])};
            }
        }
#pragma unroll
        for (int hw = 0; hw < 8; ++hw) { wcur[hw] = wnxt[hw]; wnxt[hw] = wnx2[hw]; }
    }
#undef MLAFIN_LOAD
}

__device__ __forceinline__ void post_mixer(CParams& p, int l, int wg, int nwg, const int wave_idx_) {
    auto& B = p.b;
    int tid_ = fresh_tid(); asm volatile("" : "+v"(tid_));
    const int lane = tid_ & 63, wv = tid_ >> 6;
    const float* dnw = p.in[8] + l * 128; const float* slw = p.in[12] + l * 128;
    const float lam_scale = 1.f - (0.8f - 0.6f * __expf(-0.3f * (float)l));
    float g1[8], g2[8];
#pragma unroll
    for (int j = 0; j < 8; ++j) { g1[j] = dnw[(lane & 15) * 8 + j]; g2[j] = slw[(lane & 15) * 8 + j] * lam_scale; }
    bf16_t* Y = B.G1;
#define POST_LOAD(W, ROW) do { W[0] = *(const u32x4*)(B.ODN + (size_t)(ROW) * 512 + lane * 8); W[1] = *(const u32x4*)(B.ODN + (size_t)MP * 512 + (size_t)(ROW) * 512 + lane * 8); \
        W[2] = *(const u32x4*)(B.G2 + (size_t)(ROW) * 512 + lane * 8); W[3] = *(const u32x4*)(B.G3 + (size_t)(ROW) * 1536 + lane * 8); \
        W[4] = *(const u32x4*)(B.MLX + (size_t)(ROW) * 2048 + (lane >> 4) * 256 + (lane & 15) * 8); } while (0)
    u32x4 wc[5];
#pragma unroll
    for (int i = 0; i < 5; ++i) wc[i] = (u32x4){0u, 0u, 0u, 0u};
    { const int row0 = wg * 8 + wv; if (row0 < MP) POST_LOAD(wc, row0); }
    for (int row = wg * 8 + wv; row < MP; row += nwg * 8) {
        u32x4 wn[5];
#pragma unroll
        for (int i = 0; i < 5; ++i) wn[i] = (u32x4){0u, 0u, 0u, 0u};
        { const int rn = row + nwg * 8; if (rn < MP) POST_LOAD(wn, rn); }
        float a[8], c[8], z[8];
        unpack8(wc[0], a);
        unpack8(wc[1], c);
        unpack8(wc[2], z);
        float ss = 0.f;
#pragma unroll
        for (int j = 0; j < 8; ++j) { a[j] += c[j]; ss += a[j] * a[j]; }
        ss += shx<1>(ss); ss += shx<2>(ss); ss += shx<4>(ss); ss += shx<8>(ss);
        float rs = rsqrtf(ss * (1.f / 128.f) + EPS);
#pragma unroll
        for (int j = 0; j < 8; ++j) a[j] = a[j] * rs * g1[j] * siluf(z[j]);
        const u32x4 y0 = pack8(a);
        unpack8(wc[3], a);
        ss = 0.f;
#pragma unroll
        for (int j = 0; j < 8; ++j) ss += a[j] * a[j];
        ss += shx<1>(ss); ss += shx<2>(ss); ss += shx<4>(ss); ss += shx<8>(ss);
        rs = rsqrtf(ss * (1.f / 128.f) + EPS);
#pragma unroll
        for (int j = 0; j < 8; ++j) a[j] = a[j] * rs * g2[j];
        const u32x4 y1 = pack8(a);
        const u32x4 y2 = wc[4];
        *(u32x4*)(Y + (size_t)row * 1536 + lane * 8) = y0;
        *(u32x4*)(Y + (size_t)row * 1536 + 512 + lane * 8) = y1;
        *(u32x4*)(Y + (size_t)row * 1536 + 1024 + lane * 8) = y2;
#pragma unroll
        for (int i = 0; i < 5; ++i) wc[i] = wn[i];
    }
#undef POST_LOAD
}
namespace att {
constexpr int NT = LP / 64;
constexpr int SHM_V = 64 * 128 * 2;
__device__ __forceinline__ int crow(int r, int hi) { return (r & 3) + 8 * (r >> 2) + 4 * hi; }
__device__ __forceinline__ int v_st(int k, int c) { const int kk = (k & ~0xC) | ((k & 4) << 1) | ((k & 8) >> 1); return ((kk >> 3) * 4 + (c >> 5)) * 512 + ((kk & 7) * 32 + (c & 31)) * 2; }
__device__ __forceinline__ int v_rd_base(int lane) { return ((lane & 3) << 3) | (((lane >> 2) & 3) << 6) | (((lane >> 4) & 1) << 5) | (((lane >> 5) & 1) << 8); }
constexpr int v_rd_off(int d0, int ks, int half) { return d0 * 512 + ks * 4096 + half * 2048; }
template <int OFF> __device__ __forceinline__ s16x4 tr_read(int vb) {
    s16x4 r; asm volatile("ds_read_b64_tr_b16 %0, %1 offset:%2" : "=&v"(r) : "v"(vb), "i"(OFF) : "memory"); return r;
}
#define PVPK(Lx, Hx) (bf16x8){Lx[0], Lx[1], Lx[2], Lx[3], Hx[0], Hx[1], Hx[2], Hx[3]}
template <int D0> __device__ __forceinline__ void pv_reads(s16x4 (&v)[8], int vb) {
    v[0] = tr_read<v_rd_off(D0, 0, 0)>(vb); v[1] = tr_read<v_rd_off(D0, 0, 1)>(vb); v[2] = tr_read<v_rd_off(D0, 1, 0)>(vb); v[3] = tr_read<v_rd_off(D0, 1, 1)>(vb);
    v[4] = tr_read<v_rd_off(D0, 2, 0)>(vb); v[5] = tr_read<v_rd_off(D0, 2, 1)>(vb); v[6] = tr_read<v_rd_off(D0, 3, 0)>(vb); v[7] = tr_read<v_rd_off(D0, 3, 1)>(vb);
}
__device__ __forceinline__ void pv_mma(f32x16& od, const s16x4 (&v)[8], bf16x8 pa0, bf16x8 pa1, bf16x8 pa2, bf16x8 pa3) {
    od = __builtin_amdgcn_mfma_f32_32x32x16_bf16(pa0, PVPK(v[0], v[1]), od, 0, 0, 0);
    od = __builtin_amdgcn_mfma_f32_32x32x16_bf16(pa1, PVPK(v[2], v[3]), od, 0, 0, 0);
    od = __builtin_amdgcn_mfma_f32_32x32x16_bf16(pa2, PVPK(v[4], v[5]), od, 0, 0, 0);
    od = __builtin_amdgcn_mfma_f32_32x32x16_bf16(pa3, PVPK(v[6], v[7]), od, 0, 0, 0);
}
__device__ __forceinline__ void pv_all(f32x16 (&o)[4], int vb, bf16x8 pa0, bf16x8 pa1, bf16x8 pa2, bf16x8 pa3) {
    s16x4 va[8], vbb[8];
    pv_reads<0>(va, vb);
    pv_reads<1>(vbb, vb);
    asm volatile("s_waitcnt lgkmcnt(8)" ::: "memory"); __builtin_amdgcn_sched_barrier(0);
    pv_mma(o[0], va, pa0, pa1, pa2, pa3); __builtin_amdgcn_sched_barrier(0);
    pv_reads<2>(va, vb);
    asm volatile("s_waitcnt lgkmcnt(8)" ::: "memory"); __builtin_amdgcn_sched_barrier(0);
    pv_mma(o[1], vbb, pa0, pa1, pa2, pa3); __builtin_amdgcn_sched_barrier(0);
    pv_reads<3>(vbb, vb);
    asm volatile("s_waitcnt lgkmcnt(8)" ::: "memory"); __builtin_amdgcn_sched_barrier(0);
    pv_mma(o[2], va, pa0, pa1, pa2, pa3); __builtin_amdgcn_sched_barrier(0);
    asm volatile("s_waitcnt lgkmcnt(0)" ::: "memory"); __builtin_amdgcn_sched_barrier(0);
    pv_mma(o[3], vbb, pa0, pa1, pa2, pa3);
}
template <int ROWB> __device__ __forceinline__ int kswz(int row, int colB) { return row * ROWB + (colB ^ (((row >> 1) & 7) << 4)); }

struct KVSrc {
    const bf16_t* k0; int ldk;
    const bf16_t* k1;
    const bf16_t* v; int ldv;
};

template <int DQK, int KSPLIT, bool BIAS, int ATT_X = 0>
__device__ __forceinline__ void attn_pass(const bf16x8 (&qr)[DQK / 16], const KVSrc& S, LAS unsigned char* lds, int qpos0, const LAS float* bias_tab, float bias_neg, float bias_pos, f32x16 (&o)[4], const bool active, const int wave_idx_) {
    constexpr int ROWB = DQK * 2, SHM_K = 64 * ROWB, NKC = DQK / 8, NKP = (64 * NKC) / 512;
    static_assert((64 * NKC) % 512 == 0, "K tile pieces");
    int tid_ = fresh_tid(); asm volatile("" : "+v"(tid_));
    const int tid = tid_, wid = tid >> 6, lane = tid & 63, r32 = lane & 31, hi = lane >> 5;
    LAS unsigned char* V_lds = lds; LAS unsigned char* K_lds = lds + 4 * SHM_V;
    LAS float* wsl = (LAS float*)(lds + 4 * SHM_V + 3 * SHM_K) + wid * 64; LAS float* li_l = wsl; LAS float* al_l = wsl + 32;
    float m_reg = -1e30f, l_reg = 0.f;
#pragma unroll
    for (int d = 0; d < 4; ++d)
#pragma unroll
        for (int r = 0; r < 16; ++r) o[d][r] = 0.f;
    unsigned voffs[2], koffs[NKP];
#pragma unroll
    for (int i = 0; i < 2; ++i) { const int P = i * 512 + tid, sub = P >> 5, kk = (sub >> 2) * 8 + ((P & 31) >> 2), c = (sub & 3) * 32 + (P & 3) * 8;
        const int k = (kk & ~0xC) | ((kk & 4) << 1) | ((kk & 8) >> 1); voffs[i] = (unsigned)(k * S.ldv + c); }
#pragma unroll
    for (int i = 0; i < NKP; ++i) { const int P = i * 512 + tid, row = P / NKC, cs = P % NKC, ch = cs ^ ((row >> 1) & 7); const int col = ch * 8;
        koffs[i] = (unsigned)(row * S.ldk + (col < KSPLIT ? col : col - KSPLIT)) | (col < KSPLIT ? 0u : 0x80000000u); }
    const unsigned ldsw = (unsigned)__builtin_amdgcn_readfirstlane(wid) * 1024u;
#define SDMA(t, bb, vv) do { const size_t kr_ = (size_t)(t) * 64; \
        _Pragma("unroll") for (int i_ = 0; i_ < 2; ++i_) __builtin_amdgcn_global_load_lds((const unsigned*)(S.v + kr_ * S.ldv + voffs[i_]), (LAS unsigned*)(V_lds + (vv) * SHM_V + i_ * 8192 + ldsw), 16, 0, 0); \
        _Pragma("unroll") for (int i_ = 0; i_ < NKP; ++i_) { const bf16_t* kb_ = (koffs[i_] & 0x80000000u) ? S.k1 : S.k0; \
            __builtin_amdgcn_global_load_lds((const unsigned*)(kb_ + kr_ * S.ldk + (koffs[i_] & 0x7FFFFFFFu)), (LAS unsigned*)(K_lds + (bb) * SHM_K + i_ * 8192 + ldsw), 16, 0, 0); } } while (0)
    const int vb0 = (int)(uintptr_t)V_lds + v_rd_base(lane);
    bf16x8 pa0, pa1, pa2, pa3;
    pa0 = pa1 = pa2 = pa3 = (bf16x8){0, 0, 0, 0, 0, 0, 0, 0};
    constexpr int PER = 2 + NKP;
    asm volatile("s_waitcnt vmcnt(0)" ::: "memory");
    SDMA(0, 0, 0); SDMA(1, 1, 1);
    asm volatile("s_waitcnt vmcnt(%0)" :: "n"(PER) : "memory");
    __syncthreads();
#define SB __builtin_amdgcn_sched_barrier(0)
#define PVM(D, PA, VL, VH) o[D] = __builtin_amdgcn_mfma_f32_32x32x16_bf16(PA, PVPK(VL, VH), o[D], 0, 0, 0)
    for (int j = 0; j < NT; ++j) {
        const int b = j % 3;
        if (j + 2 < NT) SDMA(j + 2, (j + 2) % 3, (j + 2) & 3);
        if (active) {
        f32x16 p0, p1;
#pragma unroll
        for (int r = 0; r < 16; ++r) { p0[r] = 0.f; p1[r] = 0.f; }
        {
            const LAS unsigned char* Kb = K_lds + b * SHM_K;
            constexpr int NG = DQK / 32;
            bf16x8 kf[2][4];
#define KLOAD(g, buf) do { _Pragma("unroll") for (int dd_ = 0; dd_ < 2; ++dd_) { const int cb_ = (((g) * 2 + dd_) * 16 + hi * 8) * 2; \
                kf[buf][2 * dd_] = *(const LAS bf16x8*)(Kb + kswz<ROWB>(r32, cb_)); kf[buf][2 * dd_ + 1] = *(const LAS bf16x8*)(Kb + kswz<ROWB>(32 + r32, cb_)); } } while (0)
            KLOAD(0, 0);
#pragma unroll
            for (int g = 0; g < NG; ++g) {
                if (g + 1 < NG) { KLOAD(g + 1, (g + 1) & 1); }
                SB;
#pragma unroll
                for (int dd = 0; dd < 2; ++dd) {
                    p0 = __builtin_amdgcn_mfma_f32_32x32x16_bf16(kf[g & 1][2 * dd], qr[g * 2 + dd], p0, 0, 0, 0);
                    p1 = __builtin_amdgcn_mfma_f32_32x32x16_bf16(kf[g & 1][2 * dd + 1], qr[g * 2 + dd], p1, 0, 0, 0); }
                SB;
            }
#undef KLOAD
        }
        float boff = 0.f;
        if (BIAS) {
            const int kpos0 = j * 64 - PADF;
            const int rel_min = kpos0 - (qpos0 + 31), rel_max = kpos0 + 63 - qpos0;
            if (rel_min >= 91) boff = bias_pos;
            else if (rel_max <= -91) boff = bias_neg;
            else {
                const int base = kpos0 - (qpos0 + r32) + 128;
#pragma unroll
                for (int r = 0; r < 16; ++r) { int i0 = base + crow(r, hi), i1 = i0 + 32;
                    i0 = i0 < 0 ? 0 : (i0 > 255 ? 255 : i0); i1 = i1 < 0 ? 0 : (i1 > 255 ? 255 : i1);
                    p0[r] += bias_tab[i0]; p1[r] += bias_tab[i1]; }
            }
        }
        if (j == 0) {
#pragma unroll
            for (int r = 0; r < 16; ++r) p0[r] = -1e30f;
#pragma unroll
            for (int r = 0; r < 8; ++r) p1[r] = -1e30f;
        }
        const int vb = vb0 + (j == 0 ? 0 : (j - 1) & 3) * SHM_V;
        s16x4 va[8], vbb[8];
        asm volatile("s_waitcnt lgkmcnt(0)" ::: "memory"); SB;
        pv_reads<0>(va, vb); pv_reads<1>(vbb, vb);
        asm volatile("s_waitcnt lgkmcnt(8)" ::: "memory"); SB;
        float pmax = p0[0];
        PVM(0, pa0, va[0], va[1]); SB;
#pragma unroll
        for (int r = 1; r < 8; ++r) pmax = fmaxf(pmax, p0[r]);
        SB; PVM(0, pa1, va[2], va[3]); SB;
#pragma unroll
        for (int r = 8; r < 16; ++r) pmax = fmaxf(pmax, p0[r]);
        SB; PVM(0, pa2, va[4], va[5]); SB;
#pragma unroll
        for (int r = 0; r < 8; ++r) pmax = fmaxf(pmax, p1[r]);
        SB; PVM(0, pa3, va[6], va[7]); SB;
#pragma unroll
        for (int r = 8; r < 16; ++r) pmax = fmaxf(pmax, p1[r]);
        { auto rr = __builtin_amdgcn_permlane32_swap(__float_as_uint(pmax), __float_as_uint(pmax), false, false);
          pmax = fmaxf(__uint_as_float(rr[0]), __uint_as_float(rr[1])) + boff; }
        float alpha = 1.f, mn = m_reg;
        const bool need = !__all(pmax - m_reg <= 8.f);
        if (need) { mn = fmaxf(m_reg, pmax); alpha = __builtin_amdgcn_exp2f(m_reg - mn); m_reg = mn; }
        float ps = 0.f;
        const float mnb = mn - boff;
        SB;
        pv_reads<2>(va, vb);
        asm volatile("s_waitcnt lgkmcnt(8)" ::: "memory"); SB;
#define EX(P, R) do { P[R] = __builtin_amdgcn_exp2f(P[R] - mnb); ps += P[R]; } while (0)
        PVM(1, pa0, vbb[0], vbb[1]); SB; EX(p0, 0); EX(p0, 1); EX(p0, 2); SB;
        PVM(1, pa1, vbb[2], vbb[3]); SB; EX(p0, 3); EX(p0, 4); EX(p0, 5); SB;
        PVM(1, pa2, vbb[4], vbb[5]); SB; EX(p0, 6); EX(p0, 7); EX(p0, 8); SB;
        PVM(1, pa3, vbb[6], vbb[7]); SB; EX(p0, 9); EX(p0, 10); EX(p0, 11); SB;
        pv_reads<3>(vbb, vb);
        asm volatile("s_waitcnt lgkmcnt(8)" ::: "memory"); SB;
        PVM(2, pa0, va[0], va[1]); SB; EX(p0, 12); EX(p0, 13); EX(p0, 14); SB;
        PVM(2, pa1, va[2], va[3]); SB; EX(p0, 15); EX(p1, 0); EX(p1, 1); SB;
        PVM(2, pa2, va[4], va[5]); SB; EX(p1, 2); EX(p1, 3); SB;
        PVM(2, pa3, va[6], va[7]); SB; EX(p1, 4); EX(p1, 5); SB;
        asm volatile("s_waitcnt lgkmcnt(0)" ::: "memory"); SB;
        PVM(3, pa0, vbb[0], vbb[1]); SB; EX(p1, 6); EX(p1, 7); EX(p1, 8); SB;
        PVM(3, pa1, vbb[2], vbb[3]); SB; EX(p1, 9); EX(p1, 10); EX(p1, 11); SB;
        PVM(3, pa2, vbb[4], vbb[5]); SB; EX(p1, 12); EX(p1, 13); SB;
        PVM(3, pa3, vbb[6], vbb[7]); SB; EX(p1, 14); EX(p1, 15); SB;
#undef EX
        l_reg = l_reg * alpha + ps;
#define PK4(P, BASE, OUT) do { unsigned a0 = cvt_pk_bf16(P[BASE + 0], P[BASE + 1]), a1 = cvt_pk_bf16(P[BASE + 2], P[BASE + 3]);   \
        unsigned b0_ = cvt_pk_bf16(P[BASE + 4], P[BASE + 5]), b1_ = cvt_pk_bf16(P[BASE + 6], P[BASE + 7]);                              \
        auto r0 = __builtin_amdgcn_permlane32_swap(a0, b0_, false, false); auto r1 = __builtin_amdgcn_permlane32_swap(a1, b1_, false, false); \
        u32x4 w = {r0[0], r1[0], r0[1], r1[1]}; OUT = *reinterpret_cast<bf16x8*>(&w); } while (0)
        PK4(p0, 0, pa0); PK4(p0, 8, pa1); PK4(p1, 0, pa2); PK4(p1, 8, pa3);
#undef PK4
        if (need) {
            if (hi == 0) al_l[r32] = alpha;
            asm volatile("s_waitcnt lgkmcnt(0)" ::: "memory");
#pragma unroll
            for (int r = 0; r < 16; ++r) { const float a = al_l[crow(r, hi)];
#pragma unroll
                for (int d = 0; d < 4; ++d) o[d][r] *= a; }
        }
        }
        if (j + 2 < NT) asm volatile("s_waitcnt vmcnt(%0)" :: "n"(PER) : "memory"); else asm volatile("s_waitcnt vmcnt(0)" ::: "memory");
        __syncthreads();
    }
#undef PVM
#undef SB
    if (active) {
        const int vb = vb0 + ((NT - 1) & 3) * SHM_V;
        pv_all(o, vb, pa0, pa1, pa2, pa3);
    }
    { auto rr = __builtin_amdgcn_permlane32_swap(__float_as_uint(l_reg), __float_as_uint(l_reg), false, false);
      l_reg = __uint_as_float(rr[0]) + __uint_as_float(rr[1]); }
    if (hi == 0) li_l[r32] = l_reg;
    asm volatile("s_waitcnt lgkmcnt(0)" ::: "memory");
#pragma unroll
    for (int r = 0; r < 16; ++r) { const float il = __builtin_amdgcn_rcpf(li_l[crow(r, hi)]);
#pragma unroll
        for (int d = 0; d < 4; ++d) o[d][r] *= il; }
    __syncthreads();
#undef SDMA
}
}

__device__ __forceinline__ int t5_bucket(int rel) {
    const int n = rel < 0 ? -rel : rel;
    int f;
    if (n < 8) f = n; else if (n < 12) f = 8; else if (n < 16) f = 9; else if (n < 23) f = 10; else if (n < 32) f = 11;
    else if (n < 46) f = 12; else if (n < 64) f = 13; else if (n < 91) f = 14; else f = 15;
    return (rel > 0 ? 16 : 0) + f;
}

__device__ __forceinline__ void diff_unit(CParams& p, int l, int b, int h, int qb, LAS unsigned char* lds, const int wave_idx_) {
    auto& B = p.b;
    int tid_ = fresh_tid(); asm volatile("" : "+v"(tid_));
    const int tid = tid_, wid = tid >> 6, lane = tid & 63, r32 = lane & 31, hi = lane >> 5;
    constexpr int LDS_TAB = 4 * att::SHM_V + 3 * 64 * 128 + 8 * 64 * 4;
    LAS float* tab = (LAS float*)(lds + LDS_TAB);
    const float* table = p.in[2];
    if (tid < 256) { const int rel = tid - 128; tab[tid] = table[t5_bucket(rel) * 4 + h] * LOG2E; }
    const float bias_neg = table[15 * 4 + h] * LOG2E, bias_pos = table[31 * 4 + h] * LOG2E;
    const float lam = p.b.misc[l];
    const size_t row0 = (size_t)b * LP;
    const int qrow = qb * 256 + wid * 32 + r32;
    const bool valid = qrow < LP;
    const size_t qr_g = row0 + (valid ? qrow : LP - 1);
    bf16x8 q0[4];
    const bf16_t* qp = B.G3 + qr_g * 1536 + h * 128 + hi * 8;
#pragma unroll
    for (int d0 = 0; d0 < 4; ++d0) q0[d0] = *(const bf16x8*)(qp + d0 * 16);
    __syncthreads();
    att::KVSrc S; S.ldk = 1536; S.ldv = 1536; S.v = B.G3 + row0 * 1536 + 1024 + h * 128;
    const int qpos0 = qb * 256 + wid * 32 - PADF;
    const int wrow0 = qb * 256 + wid * 32;
    f32x16 o[4];
    S.k0 = B.G3 + row0 * 1536 + 512 + h * 128; S.k1 = S.k0;
    att::attn_pass<64, 64, true>(q0, S, lds, qpos0, tab, bias_neg, bias_pos, o, wrow0 < LP, wave_idx_);
#if PROBE
    if (false && blockIdx.x == 100 && qb == 0) {
        f32x16 od[4];
        __syncthreads();
        if (tid == 0) ((volatile unsigned long long*)(p.b.ctl + 12288))[52] = wall_clock64();
        att::attn_pass<64, 64, true, ATT_EXPERIMENT>(q0, S, lds, qpos0, tab, bias_neg, bias_pos, od, wrow0 < LP, wave_idx_);
        if (tid == 0) ((volatile unsigned long long*)(p.b.ctl + 12288))[53] = wall_clock64();
        if (od[0][0] == 12345.f) p.b.misc[40] = od[1][1];
    }
#endif
#pragma unroll
    for (int d0 = 0; d0 < 4; ++d0) q0[d0] = *(const bf16x8*)(qp + 64 + d0 * 16);
    asm volatile("s_waitcnt vmcnt(0)" ::: "memory");
#pragma unroll
    for (int r = 0; r < 16; ++r) { const int lr = wrow0 + att::crow(r, hi);
        if (lr < LP) { bf16_t* op = B.G3 + (row0 + lr) * 1536 + h * 128 + r32;
#pragma unroll
            for (int d = 0; d < 4; ++d) op[d * 32] = f2bf(o[d][r]); } }
    S.k0 = B.G3 + row0 * 1536 + 512 + h * 128 + 64; S.k1 = S.k0;
    att::attn_pass<64, 64, true>(q0, S, lds, qpos0, tab, bias_neg, bias_pos, o, wrow0 < LP, wave_idx_);
    {
        bf16_t pk[16][4];
#pragma unroll
        for (int r = 0; r < 16; ++r) { const int lr = wrow0 + att::crow(r, hi); const int lc = lr < LP ? lr : LP - 1;
            const bf16_t* op = B.G3 + (row0 + lc) * 1536 + h * 128 + r32;
#pragma unroll
            for (int d = 0; d < 4; ++d) pk[r][d] = op[d * 32]; }
#pragma unroll
        for (int r = 0; r < 16; ++r) { const int lr = wrow0 + att::crow(r, hi);
            if (lr < LP) { bf16_t* op = B.G3 + (row0 + lr) * 1536 + h * 128 + r32;
#pragma unroll
                for (int d = 0; d < 4; ++d) op[d * 32] = f2bf(bf2f(pk[r][d]) - lam * o[d][r]); } }
    }
}

__device__ __forceinline__ void mla_unit(CParams& p, int b, int h, int qb, LAS unsigned char* lds, const int wave_idx_) {
    auto& B = p.b;
    int tid_ = fresh_tid(); asm volatile("" : "+v"(tid_));
    const int tid = tid_, wid = tid >> 6, lane = tid & 63, r32 = lane & 31, hi = lane >> 5;
    const size_t row0 = (size_t)b * LP;
    const int qrow = qb * 256 + wid * 32 + r32;
    const bool valid = qrow < LP;
    const size_t qr_g = row0 + (valid ? qrow : LP - 1);
    bf16x8 q[12];
    const bf16_t* qp = B.MLX + qr_g * 2048 + h * 256 + hi * 8;
#pragma unroll
    for (int d0 = 0; d0 < 12; ++d0) q[d0] = *(const bf16x8*)(qp + d0 * 16);
    att::KVSrc S; S.ldk = 2048; S.ldv = 2048;
    S.k0 = B.MLX + row0 * 2048 + 1024 + h * 256; S.k1 = B.MLX + row0 * 2048 + h * 256 + 192; S.v = B.MLX + row0 * 2048 + 1024 + h * 256 + 128;
    f32x16 o[4];
    att::attn_pass<192, 128, false>(q, S, lds, 0, nullptr, 0.f, 0.f, o, qb * 256 + wid * 32 < LP, wave_idx_);
    const int wrow0 = qb * 256 + wid * 32;
#pragma unroll
    for (int r = 0; r < 16; ++r) { const int lr = wrow0 + att::crow(r, hi);
        if (lr < LP) { bf16_t* op = B.MLX + (row0 + lr) * 2048 + h * 256 + r32;
#pragma unroll
            for (int d = 0; d < 4; ++d) op[d * 32] = f2bf(o[d][r]); } }
}
namespace dn {
#ifndef DN_PREFETCH
#define DN_PREFETCH 1
#endif
constexpr int RS = 272;
constexpr int QS = 136;
constexpr int LD = 65;
constexpr int O_Q = 0, O_K = 17408, O_VB = O_K  , O_KB = 2 * 17408, O_KT = 3 * 17408, O_KG = 4 * 17408, O_VT = 5 * 17408,
              O_QK = 6 * 17408, O_TI = O_QK + 8704, O_A = O_TI + 8704, O_T = O_A + 64 * LD * 4, O_P = O_T + 64 * LD * 4, O_TAB = O_P + 4224, O_END = O_TAB + 1024, O_TAB2 = 160384 + 2048;
__device__ __forceinline__ int crow32(int r, int hi) { return (r & 3) + 8 * (r >> 2) + 4 * hi; }
typedef short bf16x4 __attribute__((ext_vector_type(4)));
__device__ __forceinline__ bf16x8 cat4(bf16x4 a, bf16x4 b) { return (bf16x8){a[0], a[1], a[2], a[3], b[0], b[1], b[2], b[3]}; }

template <int CTRL, int ROWMASK> __device__ __forceinline__ float dpp_f(float v) {
    return __int_as_float(__builtin_amdgcn_update_dpp(0, __float_as_int(v), CTRL, ROWMASK, 0xf, ROWMASK == 0xf)); }
__device__ __forceinline__ float wave_scan_incl(float v) {
    v += dpp_f<0x111, 0xf>(v); v += dpp_f<0x112, 0xf>(v); v += dpp_f<0x114, 0xf>(v); v += dpp_f<0x118, 0xf>(v);
    v += dpp_f<0x142, 0xa>(v);
    v += dpp_f<0x143, 0xc>(v);
    return v; }
template <int M> __device__ __forceinline__ float swz_xor(float v) {
    return __int_as_float(__builtin_amdgcn_ds_swizzle(__float_as_int(v), (M << 10) | 0x1f)); }
#ifndef DN_SWAP
#define DN_SWAP 0
#endif
__device__ __forceinline__ void dn_item(CParams& p, int l, int b, int h, int dir, int c_lo, int c_hi, float* stbuf, LAS unsigned char* lds, const int wave_idx_) {
    auto& B = p.b;
    int tid_ = fresh_tid(); asm volatile("" : "+v"(tid_));
    const int tid0 = tid_, w = __builtin_amdgcn_readfirstlane(tid0 >> 6), lane0 = tid0 & 63;
    LAS float* Amat = (LAS float*)(lds + O_A);
    LAS float* Tmat = (LAS float*)(lds + O_T);
    LAS float* Pmat = (LAS float*)(lds + O_P);
    const size_t row0 = (size_t)b * LP;
    const bf16_t* G1 = B.G1 + row0 * 1536;
    const float* BGb = B.BG + row0 * 16;
    const int jb = dir * 4 + h;
    f32x4 St[8];
#pragma unroll
    for (int t = 0; t < 8; ++t) St[t] = (f32x4){0.f, 0.f, 0.f, 0.f};
    if (c_lo > 0) {
        int tl = tid0; asm volatile("" : "+v"(tl)); const float* sp = stbuf + tl;
#pragma unroll
        for (int t = 0; t < 8; ++t)
#pragma unroll
            for (int r = 0; r < 4; ++r) St[t][r] = sp[(t * 4 + r) * NWG_THREADS];
    }
    bf16_t* outp0 = B.ODN + (size_t)dir * MP * 512 + row0 * 512 + h * 128 + 16 * w;
    for (int i = tid0; i < 64 * LD; i += NWG_THREADS) Tmat[i] = 0.f;
    for (int i = tid0; i < 8704 / 4; i += NWG_THREADS) ((LAS unsigned*)(lds + O_TI))[i] = 0u;

    unsigned cwp2[3][5];
    { const float* cwp = p.in[5] + (size_t)l * 5 * 1536 + h * 128 + 2 * lane0;
#pragma unroll
      for (int t = 0; t < 3; ++t)
#pragma unroll
        for (int j = 0; j < 5; ++j) { const float2 c2 = *(const float2*)(cwp + j * 1536 + t * 512); cwp2[t][j] = cvt_pk_bf16(c2.x, c2.y); } }
    float g_nx = 0.f, be_nx = 0.f;
#define DN_LOAD_BG(cc) do { const bool rv_ = (dir == 1 && (cc) > 0); int lpp_ = rv_ ? (4223 - 64 * (cc) - lane0) : (64 * (cc) + lane0); asm volatile("" : "+v"(lpp_)); \
        const bool ok_ = !((cc) == 0 && lane0 < PADF); g_nx = ok_ ? BGb[(size_t)lpp_ * 16 + 8 + jb] : 0.f; be_nx = ok_ ? BGb[(size_t)lpp_ * 16 + jb] : 0.f; } while (0)
    unsigned xr[3][12];
#define DN_LOAD_RAW_T(cc, tt) do { const bool rv_ = (dir == 1 && (cc) > 0); int lpl_ = rv_ ? (4223 - 64 * (cc) - 8 * w - 7) : (64 * (cc) + 8 * w); asm volatile("" : "+v"(lpl_)); \
        const bf16_t* gp_ = G1 + (ptrdiff_t)(lpl_ - 2) * 1536 + h * 128 + 2 * lane0 + (tt) * 512; \
        _Pragma("unroll") for (int rr_ = 0; rr_ < 12; ++rr_) { const int lp_ = lpl_ - 2 + rr_; const bool ok_ = (lp_ >= PADF) && (lp_ < LP); \
            unsigned u_ = 0u; if (ok_) u_ = *(const unsigned*)(gp_ + rr_ * 1536); xr[tt][rr_] = u_; } } while (0)
#define DN_LOAD_RAW(cc) do { const bool rv_ = (dir == 1 && (cc) > 0); int lpl_ = rv_ ? (4223 - 64 * (cc) - 8 * w - 7) : (64 * (cc) + 8 * w); asm volatile("" : "+v"(lpl_)); \
        const bf16_t* gp_ = G1 + (ptrdiff_t)(lpl_ - 2) * 1536 + h * 128 + 2 * lane0; \
        _Pragma("unroll") for (int rr_ = 0; rr_ < 12; ++rr_) { const int lp_ = lpl_ - 2 + rr_; const bool ok_ = (lp_ >= PADF) && (lp_ < LP); \
            _Pragma("unroll") for (int t_ = 0; t_ < 3; ++t_) { unsigned u_ = 0u; if (ok_) u_ = *(const unsigned*)(gp_ + rr_ * 1536 + t_ * 512); xr[t_][rr_] = u_; } } } while (0)

    unsigned iq[8], ik[8], ikg[2][4], ivt[2][4];
#define DN_CONV_(t_, yy_) do { unsigned cq_[5]; _Pragma("unroll") for (int j_ = 0; j_ < 5; ++j_) { cq_[j_] = cwp2[t_][j_]; asm volatile("" : "+v"(cq_[j_])); } \
          _Pragma("unroll") for (int m_ = 0; m_ < 8; ++m_) _Pragma("unroll") for (int e_ = 0; e_ < 2; ++e_) { float a_ = 0.f; \
            _Pragma("unroll") for (int j_ = 0; j_ < 5; ++j_) a_ = fmaf(e_ ? bfhi(xr[t_][m_ + j_]) : bflo(xr[t_][m_ + j_]), e_ ? bfhi(cq_[j_]) : bflo(cq_[j_]), a_); \
            yy_[m_][e_] = zero_wave_ ? 0.f : a_ * __builtin_amdgcn_rcpf(1.f + __builtin_amdgcn_exp2f(-a_ * LOG2E)); } } while (0)
#define DN_S1_COMPUTE(cc) do { \
        int lane = lane0; asm volatile("" : "+v"(lane)); \
        const bool zero_wave_ = ((cc) == 0 && w < 6), rev_ = (dir == 1 && (cc) > 0); \
        const float be_c = be_nx, gc_c = wave_scan_incl(g_nx), egc_c = __expf(gc_c); \
        if (w == 0) { LAS float* tw_ = (LAS float*)(lds + (((cc) & 1) ? O_TAB2 : O_TAB)); const float gl_ = __int_as_float(__builtin_amdgcn_readlane(__float_as_int(gc_c), 63)); \
            tw_[lane] = gc_c; tw_[64 + lane] = egc_c; tw_[128 + lane] = __expf(gl_ - gc_c); tw_[192 + lane] = be_c; } \
        float be8_[8], beg8_[8]; \
        _Pragma("unroll") for (int m_ = 0; m_ < 8; ++m_) { const int i_ = 8 * w + (rev_ ? 7 - m_ : m_); \
            be8_[m_] = __int_as_float(__builtin_amdgcn_readlane(__float_as_int(be_c), i_)); beg8_[m_] = be8_[m_] * __int_as_float(__builtin_amdgcn_readlane(__float_as_int(egc_c), i_)); } \
        { float yq_[8][2], yk_[8][2]; \
          DN_CONV_(0, yq_); DN_CONV_(1, yk_); \
          float v_[16]; \
          _Pragma("unroll") for (int m_ = 0; m_ < 8; ++m_) { v_[m_] = yq_[m_][0] * yq_[m_][0] + yq_[m_][1] * yq_[m_][1]; v_[8 + m_] = yk_[m_][0] * yk_[m_][0] + yk_[m_][1] * yk_[m_][1]; } \
          { const int a32_ = (lane ^ 32) << 2; const bool up_ = (lane & 32) != 0; \
            _Pragma("unroll") for (int j_ = 0; j_ < 8; ++j_) { const float send_ = up_ ? v_[j_] : v_[j_ + 8], keep_ = up_ ? v_[j_ + 8] : v_[j_]; v_[j_] = keep_ + __int_as_float(__builtin_amdgcn_ds_bpermute(a32_, __float_as_int(send_))); } } \
          { const bool up_ = (lane & 16) != 0; \
            _Pragma("unroll") for (int j_ = 0; j_ < 4; ++j_) { const float send_ = up_ ? v_[j_] : v_[j_ + 4], keep_ = up_ ? v_[j_ + 4] : v_[j_]; v_[j_] = keep_ + swz_xor<16>(send_); } } \
          { const bool up_ = (lane & 8) != 0; \
            _Pragma("unroll") for (int j_ = 0; j_ < 2; ++j_) { const float send_ = up_ ? v_[j_] : v_[j_ + 2], keep_ = up_ ? v_[j_ + 2] : v_[j_]; v_[j_] = keep_ + swz_xor<8>(send_); } } \
          { const bool up_ = (lane & 4) != 0; const float send_ = up_ ? v_[0] : v_[1], keep_ = up_ ? v_[1] : v_[0]; v_[0] = keep_ + swz_xor<4>(send_); } \
          v_[0] += swz_xor<2>(v_[0]); v_[0] += swz_xor<1>(v_[0]); \
          _Pragma("unroll") for (int m_ = 0; m_ < 8; ++m_) { \
            const float sq_ = __int_as_float(__builtin_amdgcn_readlane(__float_as_int(v_[0]), ((m_ >> 2) & 1) * 16 + ((m_ >> 1) & 1) * 8 + (m_ & 1) * 4)); \
            const float sk_ = __int_as_float(__builtin_amdgcn_readlane(__float_as_int(v_[0]), 32 + ((m_ >> 2) & 1) * 16 + ((m_ >> 1) & 1) * 8 + (m_ & 1) * 4)); \
            const float rq_ = rsqrtf(sq_ + EPS) * 0.08838834764831845f, rk_ = rsqrtf(sk_ + EPS); \
            yk_[m_][0] *= rk_; yk_[m_][1] *= rk_; \
            yq_[m_][0] *= rq_; yq_[m_][1] *= rq_; } \
          _Pragma("unroll") for (int r_ = 0; r_ < 8; ++r_) { \
            iq[r_] = rev_ ? cvt_pk_bf16(yq_[7 - r_][0], yq_[7 - r_][1]) : cvt_pk_bf16(yq_[r_][0], yq_[r_][1]); ik[r_] = rev_ ? cvt_pk_bf16(yk_[7 - r_][0], yk_[7 - r_][1]) : cvt_pk_bf16(yk_[r_][0], yk_[r_][1]); } \
          _Pragma("unroll") for (int e_ = 0; e_ < 2; ++e_) _Pragma("unroll") for (int mm_ = 0; mm_ < 4; ++mm_) { \
            const int m0_ = rev_ ? 7 - 2 * mm_ : 2 * mm_, m1_ = rev_ ? 6 - 2 * mm_ : 2 * mm_ + 1; \
            const float k0_ = rev_ ? yk_[7 - 2 * mm_][e_] : yk_[2 * mm_][e_], k1_ = rev_ ? yk_[6 - 2 * mm_][e_] : yk_[2 * mm_ + 1][e_]; \
            const float b0_ = rev_ ? beg8_[7 - 2 * mm_] : beg8_[2 * mm_], b1_ = rev_ ? beg8_[6 - 2 * mm_] : beg8_[2 * mm_ + 1]; (void)m0_; (void)m1_; \
            ikg[e_][mm_] = cvt_pk_bf16(k0_ * b0_, k1_ * b1_); } } \
        asm volatile("" ::: "memory"); \
        { float yv_[8][2]; DN_CONV_(2, yv_); \
          _Pragma("unroll") for (int e_ = 0; e_ < 2; ++e_) _Pragma("unroll") for (int mm_ = 0; mm_ < 4; ++mm_) { \
            const float v0_ = rev_ ? yv_[7 - 2 * mm_][e_] * be8_[7 - 2 * mm_] : yv_[2 * mm_][e_] * be8_[2 * mm_], v1_ = rev_ ? yv_[6 - 2 * mm_][e_] * be8_[6 - 2 * mm_] : yv_[2 * mm_ + 1][e_] * be8_[2 * mm_ + 1]; \
            ivt[e_][mm_] = cvt_pk_bf16(v0_, v1_); } } } while (0)
    DN_LOAD_RAW(c_lo);
    DN_LOAD_BG(c_lo);
    DN_S1_COMPUTE(c_lo);
    __syncthreads();
    for (int c = c_lo; c < c_hi; ++c) {
        const bool rev = (dir == 1 && c > 0);
        LAS float* tab = (LAS float*)(lds + ((c & 1) ? O_TAB2 : O_TAB));

#if PROBE
        if (c == 32 && b == 0 && h == 0 && dir == 0 && tid0 == 0) ((volatile unsigned long long*)(B.ctl + 12288))[42] = wall_clock64();
#endif
        {
            int lane = lane0; asm volatile("" : "+v"(lane));
            if (c + 1 < c_hi) DN_LOAD_BG(c + 1);
#pragma unroll
            for (int r = 0; r < 8; ++r) { const int i = 8 * w + r;
                *(LAS unsigned*)(lds + O_Q + i * RS + 4 * lane) = iq[r];
                *(LAS unsigned*)(lds + O_K + i * RS + 4 * lane) = ik[r]; }
#pragma unroll
            for (int mm = 0; mm < 4; ++mm) { const int off = (2 * lane) * QS + (8 * w + 2 * mm) * 2;
                *(LAS unsigned*)(lds + O_KT + off) = (ik[2 * mm] & 0xFFFFu) | (ik[2 * mm + 1] << 16);
                *(LAS unsigned*)(lds + O_KT + off + QS) = (ik[2 * mm] >> 16) | (ik[2 * mm + 1] & 0xFFFF0000u);
                *(LAS unsigned*)(lds + O_KG + off) = ikg[0][mm]; *(LAS unsigned*)(lds + O_KG + off + QS) = ikg[1][mm];
                *(LAS unsigned*)(lds + O_VT + off) = ivt[0][mm]; *(LAS unsigned*)(lds + O_VT + off + QS) = ivt[1][mm]; }
        }
        __syncthreads();

#if PROBE
        if (c == 32 && b == 0 && h == 0 && dir == 0 && tid0 == 0) ((volatile unsigned long long*)(B.ctl + 12288))[43] = wall_clock64();
#endif
#if DN_PREFETCH == 1
        if (c + 1 < c_hi) DN_LOAD_RAW_T(c + 1, 0);
#endif
        {
            int lane = lane0; asm volatile("" : "+v"(lane));
            const int tsel = w >> 2, a = (w >> 1) & 1, bc = w & 1, r32 = lane & 31, hi = lane >> 5;
            if (tsel != 0) {} else if (!(a == 0 && bc == 1)) {
                f32x16 acc;
#pragma unroll
                for (int r = 0; r < 16; ++r) acc[r] = 0.f;
                const LAS unsigned char* Ai = lds + (tsel ? O_Q : O_K) + (32 * a + r32) * RS + hi * 16;
                const LAS unsigned char* Bi = lds + O_K + (32 * bc + r32) * RS + hi * 16;
#pragma unroll
                for (int s = 0; s < 8; ++s) { const bf16x8 af = *(const LAS bf16x8*)(Ai + s * 32), bf = *(const LAS bf16x8*)(Bi + s * 32);
                    acc = __builtin_amdgcn_mfma_f32_32x32x16_bf16(af, bf, acc, 0, 0, 0); }
                const int j = 32 * bc + r32; const float gcj = tab[j];
#pragma unroll
                for (int r = 0; r < 16; ++r) { const int i = 32 * a + crow32(r, hi); const float gci = tab[i];
                    const bool keep = tsel ? (j <= i) : (j < i);
                    float v = keep ? acc[r] * __expf(gci - gcj) : 0.f;
                    if (tsel == 0) Amat[i * LD + j] = v * tab[192 + i]; else *(LAS bf16_t*)(lds + O_QK + i * QS + j * 2) = f2bf(v); }
            } else {
                const int j = 32 + (lane & 31);
#pragma unroll
                for (int r = 0; r < 16; ++r) { const int i = crow32(r, lane >> 5);
                    if (tsel == 0) Amat[i * LD + j] = 0.f; else *(LAS bf16_t*)(lds + O_QK + i * QS + j * 2) = (bf16_t)0; }
            }
        }
        __syncthreads();

#if PROBE
        if (c == 32 && b == 0 && h == 0 && dir == 0 && tid0 == 0) ((volatile unsigned long long*)(B.ctl + 12288))[44] = wall_clock64();
#endif
        int tid = tid0; asm volatile("" : "+v"(tid));
        if (tid < 64) {
            const int k = tid >> 4, cc = tid & 15, r0 = 16 * k;
            float x[16];
#pragma unroll
            for (int i = 0; i < 16; ++i) { float a0 = (i == cc) ? 1.f : 0.f, a1 = 0.f;
#pragma unroll
                for (int j = 0; j < i; ++j) { const float av = Amat[(r0 + i) * LD + r0 + j]; if (j & 1) a1 = fmaf(-av, x[j], a1); else a0 = fmaf(-av, x[j], a0); }
                x[i] = a0 + a1;
                Tmat[(r0 + i) * LD + r0 + cc] = x[i]; *(LAS bf16_t*)(lds + O_TI + (r0 + i) * QS + (r0 + cc) * 2) = f2bf(x[i]); }
        }
        {
            int lane = lane0; asm volatile("" : "+v"(lane));
            const int tsel = w >> 2, a = (w >> 1) & 1, bc = w & 1, r32 = lane & 31, hi = lane >> 5;
            if (tsel != 1) {} else if (!(a == 0 && bc == 1)) {
                f32x16 acc;
#pragma unroll
                for (int r = 0; r < 16; ++r) acc[r] = 0.f;
                const LAS unsigned char* Ai = lds + (tsel ? O_Q : O_K) + (32 * a + r32) * RS + hi * 16;
                const LAS unsigned char* Bi = lds + O_K + (32 * bc + r32) * RS + hi * 16;
#pragma unroll
                for (int s = 0; s < 8; ++s) { const bf16x8 af = *(const LAS bf16x8*)(Ai + s * 32), bf = *(const LAS bf16x8*)(Bi + s * 32);
                    acc = __builtin_amdgcn_mfma_f32_32x32x16_bf16(af, bf, acc, 0, 0, 0); }
                const int j = 32 * bc + r32; const float gcj = tab[j];
#pragma unroll
                for (int r = 0; r < 16; ++r) { const int i = 32 * a + crow32(r, hi); const float gci = tab[i];
                    const bool keep = tsel ? (j <= i) : (j < i);
                    float v = keep ? acc[r] * __expf(gci - gcj) : 0.f;
                    if (tsel == 0) Amat[i * LD + j] = v * tab[192 + i]; else *(LAS bf16_t*)(lds + O_QK + i * QS + j * 2) = f2bf(v); }
            } else {
                const int j = 32 + (lane & 31);
#pragma unroll
                for (int r = 0; r < 16; ++r) { const int i = crow32(r, lane >> 5);
                    if (tsel == 0) Amat[i * LD + j] = 0.f; else *(LAS bf16_t*)(lds + O_QK + i * QS + j * 2) = (bf16_t)0; }
            }
        }
        __syncthreads();

#if PROBE
        if (c == 32 && b == 0 && h == 0 && dir == 0 && tid0 == 0) ((volatile unsigned long long*)(B.ctl + 12288))[45] = wall_clock64();
#endif
#if DN_PREFETCH == 1
        if (c + 1 < c_hi) DN_LOAD_RAW_T(c + 1, 1);
#endif
        {
            const int which = tid >> 8, i = (tid >> 4) & 15, cc = tid & 15, r0 = which * 32;
            float a0 = 0.f, a1 = 0.f;
#pragma unroll
            for (int j = 0; j < 16; j += 2) { a0 = fmaf(Amat[(r0 + 16 + i) * LD + r0 + j], Tmat[(r0 + j) * LD + r0 + cc], a0); a1 = fmaf(Amat[(r0 + 16 + i) * LD + r0 + j + 1], Tmat[(r0 + j + 1) * LD + r0 + cc], a1); }
            Pmat[(which * 16 + i) * 17 + cc] = a0 + a1;
        }
        __syncthreads();
        {
            const int which = tid >> 8, i = (tid >> 4) & 15, cc = tid & 15, r0 = which * 32;
            float a0 = 0.f, a1 = 0.f;
#pragma unroll
            for (int j = 0; j < 16; j += 2) { a0 = fmaf(Tmat[(r0 + 16 + i) * LD + r0 + 16 + j], Pmat[(which * 16 + j) * 17 + cc], a0); a1 = fmaf(Tmat[(r0 + 16 + i) * LD + r0 + 16 + j + 1], Pmat[(which * 16 + j + 1) * 17 + cc], a1); }
            const float v = -(a0 + a1);
            Tmat[(r0 + 16 + i) * LD + r0 + cc] = v; *(LAS bf16_t*)(lds + O_TI + (r0 + 16 + i) * QS + (r0 + cc) * 2) = f2bf(v);
        }
        __syncthreads();
        {
            const int i = tid >> 4, c0 = (tid & 15) * 2;
            float a0 = 0.f, a1 = 0.f;
#pragma unroll
            for (int j = 0; j < 32; ++j) { const float av = Amat[(32 + i) * LD + j]; a0 = fmaf(av, Tmat[j * LD + c0], a0); a1 = fmaf(av, Tmat[j * LD + c0 + 1], a1); }
            Pmat[i * 33 + c0] = a0; Pmat[i * 33 + c0 + 1] = a1;
        }
        __syncthreads();
        {
            const int i = tid >> 4, c0 = (tid & 15) * 2;
            float a0 = 0.f, a1 = 0.f;
#pragma unroll
            for (int j = 0; j < 32; ++j) { const float tv = Tmat[(32 + i) * LD + 32 + j]; a0 = fmaf(tv, Pmat[j * 33 + c0], a0); a1 = fmaf(tv, Pmat[j * 33 + c0 + 1], a1); }
            Tmat[(32 + i) * LD + c0] = -a0; Tmat[(32 + i) * LD + c0 + 1] = -a1;
            *(LAS unsigned*)(lds + O_TI + (32 + i) * QS + c0 * 2) = cvt_pk_bf16(-a0, -a1);
        }
        __syncthreads();

#if PROBE
        if (c == 32 && b == 0 && h == 0 && dir == 0 && tid0 == 0) ((volatile unsigned long long*)(B.ctl + 12288))[46] = wall_clock64();
#endif
#if DN_PREFETCH == 1
        if (c + 1 < c_hi) DN_LOAD_RAW_T(c + 1, 2);
#endif
        {
            int lane = lane0; asm volatile("" : "+v"(lane)); const int n16 = lane & 15, q4 = lane >> 4;
#pragma unroll
            for (int tt = 0; tt < 2; ++tt) {
                const int t = 2 * w + tt;
                const LAS unsigned char* arow = lds + (t < 8 ? O_KG + (16 * t + n16) * QS : O_VT + (16 * (t - 8) + n16) * QS) + q4 * 16;
                bf16x8 af[2];
#pragma unroll
                for (int s = 0; s < 2; ++s) af[s] = cat4(*(const LAS bf16x4*)(arow + s * 64), *(const LAS bf16x4*)(arow + s * 64 + 8));
#pragma unroll
                for (int it = 0; it < 4; ++it) {
                    f32x4 acc = (f32x4){0.f, 0.f, 0.f, 0.f};
                    const LAS unsigned char* brow = lds + O_TI + (16 * it + n16) * QS + q4 * 16;
#pragma unroll
                    for (int s = 0; s < 2; ++s) { const bf16x8 bf = cat4(*(const LAS bf16x4*)(brow + s * 64), *(const LAS bf16x4*)(brow + s * 64 + 8));
                        acc = __builtin_amdgcn_mfma_f32_16x16x32_bf16(af[s], bf, acc, 0, 0, 0); }
                    LAS unsigned char* dst = lds + (t < 8 ? O_KB + (16 * it + n16) * RS + (16 * t + 4 * q4) * 2 : O_VB + (16 * it + n16) * RS + (16 * (t - 8) + 4 * q4) * 2);
                    *(LAS u32x2*)dst = (u32x2){cvt_pk_bf16(acc[0], acc[1]), cvt_pk_bf16(acc[2], acc[3])};
                }
            }
        }
        __syncthreads();

#if PROBE
        if (c == 32 && b == 0 && h == 0 && dir == 0 && tid0 == 0) ((volatile unsigned long long*)(B.ctl + 12288))[47] = wall_clock64();
#endif
        auto s4_stage = [&]() __attribute__((always_inline)) {
            int lane = lane0; asm volatile("" : "+v"(lane)); const int n16 = lane & 15, q4 = lane >> 4;
            bf16x8 Sb[4];
#pragma unroll
            for (int s = 0; s < 4; ++s) { const u32x4 wv = {cvt_pk_bf16(St[2 * s][0], St[2 * s][1]), cvt_pk_bf16(St[2 * s][2], St[2 * s][3]), cvt_pk_bf16(St[2 * s + 1][0], St[2 * s + 1][1]), cvt_pk_bf16(St[2 * s + 1][2], St[2 * s + 1][3])};
                Sb[s] = *reinterpret_cast<const bf16x8*>(&wv); }
            f32x4 U[4], Q[4];
#pragma unroll
            for (int a = 0; a < 4; ++a) { U[a] = (f32x4){0.f, 0.f, 0.f, 0.f}; Q[a] = (f32x4){0.f, 0.f, 0.f, 0.f}; }
#pragma unroll
            for (int a = 0; a < 4; ++a)
#pragma unroll
                for (int s = 0; s < 4; ++s) {
                    const LAS unsigned char* pk = lds + O_KB + (16 * a + n16) * RS + (32 * s + 4 * q4) * 2;
                    const LAS unsigned char* pq = lds + O_Q + (16 * a + n16) * RS + (32 * s + 4 * q4) * 2;
                    const bf16x8 ak = cat4(*(const LAS bf16x4*)pk, *(const LAS bf16x4*)(pk + 32));
                    const bf16x8 aq = cat4(*(const LAS bf16x4*)pq, *(const LAS bf16x4*)(pq + 32));
                    U[a] = __builtin_amdgcn_mfma_f32_16x16x32_bf16(ak, Sb[s], U[a], 0, 0, 0);
                    Q[a] = __builtin_amdgcn_mfma_f32_16x16x32_bf16(aq, Sb[s], Q[a], 0, 0, 0);
                }
            f32x4 Vn[4];
#pragma unroll
            for (int a = 0; a < 4; ++a)
#pragma unroll
                for (int r = 0; r < 4; ++r) { const int i = 16 * a + 4 * q4 + r;
                    const float val = bf2f(*(const LAS bf16_t*)(lds + O_VB + i * RS + (16 * w + n16) * 2));
                    Vn[a][r] = val - U[a][r]; Q[a][r] *= tab[64 + i]; }
            bf16x8 Vb[2], Vs[2];
#pragma unroll
            for (int s = 0; s < 2; ++s) {
                float e0[4], e1[4];
#pragma unroll
                for (int r = 0; r < 4; ++r) { e0[r] = tab[128 + 32 * s + 4 * q4 + r]; e1[r] = tab[128 + 32 * s + 16 + 4 * q4 + r]; }
                const u32x4 w0 = {cvt_pk_bf16(Vn[2 * s][0], Vn[2 * s][1]), cvt_pk_bf16(Vn[2 * s][2], Vn[2 * s][3]), cvt_pk_bf16(Vn[2 * s + 1][0], Vn[2 * s + 1][1]), cvt_pk_bf16(Vn[2 * s + 1][2], Vn[2 * s + 1][3])};
                const u32x4 w1 = {cvt_pk_bf16(Vn[2 * s][0] * e0[0], Vn[2 * s][1] * e0[1]), cvt_pk_bf16(Vn[2 * s][2] * e0[2], Vn[2 * s][3] * e0[3]),
                                  cvt_pk_bf16(Vn[2 * s + 1][0] * e1[0], Vn[2 * s + 1][1] * e1[1]), cvt_pk_bf16(Vn[2 * s + 1][2] * e1[2], Vn[2 * s + 1][3] * e1[3])};
                Vb[s] = *reinterpret_cast<const bf16x8*>(&w0); Vs[s] = *reinterpret_cast<const bf16x8*>(&w1);
            }
#pragma unroll
            for (int a = 0; a < 4; ++a)
#pragma unroll
                for (int s = 0; s < 2; ++s) {
                    const LAS unsigned char* pa = lds + O_QK + (16 * a + n16) * QS + (32 * s + 4 * q4) * 2;
                    const bf16x8 af = cat4(*(const LAS bf16x4*)pa, *(const LAS bf16x4*)(pa + 32));
                    Q[a] = __builtin_amdgcn_mfma_f32_16x16x32_bf16(af, Vb[s], Q[a], 0, 0, 0);
                }
            const float egl = tab[64 + 63];
#pragma unroll
            for (int t = 0; t < 8; ++t) {
                St[t] *= egl;
#pragma unroll
                for (int s = 0; s < 2; ++s) {
                    const LAS unsigned char* pa = lds + O_KT + (16 * t + n16) * QS + (32 * s + 4 * q4) * 2;
                    const bf16x8 af = cat4(*(const LAS bf16x4*)pa, *(const LAS bf16x4*)(pa + 32));
                    St[t] = __builtin_amdgcn_mfma_f32_16x16x32_bf16(af, Vs[s], St[t], 0, 0, 0);
                }
            }
#pragma unroll
            for (int a = 0; a < 4; ++a)
#pragma unroll
                for (int r = 0; r < 4; ++r) { const int i = 16 * a + 4 * q4 + r; const int lp = rev ? (4223 - 64 * c - i) : (64 * c + i);
                    outp0[(size_t)lp * 512 + n16] = f2bf(Q[a][r]); }
        };
#if DN_SWAP
        if (w < 4) { s4_stage(); if (c + 1 < c_hi) DN_S1_COMPUTE(c + 1); }
        else       { if (c + 1 < c_hi) DN_S1_COMPUTE(c + 1); s4_stage(); }
#else
        s4_stage(); if (c + 1 < c_hi) DN_S1_COMPUTE(c + 1);
#endif
        __syncthreads();
#if PROBE
        if (c == 32 && b == 0 && h == 0 && dir == 0 && tid0 == 0) ((volatile unsigned long long*)(B.ctl + 12288))[48] = wall_clock64();
#endif
    }
    if (c_hi < 65) {
        int tl = tid0; asm volatile("" : "+v"(tl)); float* sp = stbuf + tl;
#pragma unroll
        for (int t = 0; t < 8; ++t)
#pragma unroll
            for (int r = 0; r < 4; ++r) sp[(t * 4 + r) * NWG_THREADS] = St[t][r];
    }
#undef DN_LOAD_RAW
#undef DN_LOAD_RAW_T
#undef DN_LOAD_BG
}
}
constexpr int NHALF = NB >= 2 ? 2 : 1, BPH = NB / NHALF, CAP = BPH * L;
constexpr int CW_MOECNT = 8192, CW_KFLAG = 10240;

__device__ __forceinline__ void norm_router_rows(CParams& p, int wg, int nwg, LAS unsigned char* lds, int nMm, int SPLIT, const int wave_idx_) {
    auto& B = p.b;
    int tid_ = fresh_tid(); asm volatile("" : "+v"(tid_));
    const int tid = tid_, lane = tid & 63, wv = tid >> 6;
    LAS float* Wr = (LAS float*)lds;
    { const float* rw = p.in[24];
      for (int i = tid; i < 8192; i += NWG_THREADS) { const int d = i >> 3, e = i & 7; Wr[e * 1024 + d] = rw[i]; } }
    __syncthreads();
    const float* w = p.in[20] + D;
    int kr = 0, ke0 = 0, ke1 = 0; float kg0 = 0.f, kg1 = 0.f; int nk = 0;
    f32x4 vn[4];
#pragma unroll
    for (int j = 0; j < 4; ++j) vn[j] = (f32x4){0.f, 0.f, 0.f, 0.f};
    { const int row0 = wg * 8 + wv; if (row0 < MP) { const float* p0 = hf_row(B.Hout, B.Hside, row0);
#pragma unroll
        for (int j = 0; j < 4; ++j) vn[j] = *(const f32x4*)(p0 + j * 256 + lane * 4); } }
    for (int row = wg * 8 + wv; row < MP; row += nwg * 8) {
        float* hp = hf_row(B.Hout, B.Hside, row); f32x4 v[4]; float ss = 0.f;
#pragma unroll
        for (int j = 0; j < 4; ++j) v[j] = vn[j];
        { const int rn = row + nwg * 8; if (rn < MP) { const float* pn = hf_row(B.Hout, B.Hside, rn);
#pragma unroll
            for (int j = 0; j < 4; ++j) vn[j] = *(const f32x4*)(pn + j * 256 + lane * 4); } }
        const bool fix = SPLIT > 0 && row >= nMm * 256 && row_valid(row);
#pragma unroll
        for (int j = 0; j < 4; ++j) {
            if (fix) { const float* pp = B.PART + ((size_t)((row / 256 - nMm) * 4 + j) * SPLIT) * 65536 + (size_t)(row % 256) * 256 + lane * 4;
                for (int sp = 0; sp < SPLIT; ++sp) v[j] += *(const f32x4*)(pp + (size_t)sp * 65536);
                *(f32x4*)(hp + j * 256 + lane * 4) = v[j]; }
            ss += v[j][0] * v[j][0] + v[j][1] * v[j][1] + v[j][2] * v[j][2] + v[j][3] * v[j][3]; }
        ss = wave_sum(ss);
        const float rs = rsqrtf(ss * (1.f / D) + EPS);
        float lg[8];
#pragma unroll
        for (int e = 0; e < 8; ++e) lg[e] = 0.f;
#pragma unroll
        for (int j = 0; j < 4; ++j) { const f32x4 g = *(const f32x4*)(w + j * 256 + lane * 4);
            f32x4 u; u[0] = v[j][0] * rs * g[0]; u[1] = v[j][1] * rs * g[1]; u[2] = v[j][2] * rs * g[2]; u[3] = v[j][3] * rs * g[3];
            *(u32x2*)(B.Ub + (size_t)row * D + j * 256 + lane * 4) = (u32x2){cvt_pk_bf16(u[0], u[1]), cvt_pk_bf16(u[2], u[3])};
#pragma unroll
            for (int e = 0; e < 8; ++e) { const f32x4 wr4 = *(const LAS f32x4*)(Wr + e * 1024 + j * 256 + lane * 4);
                lg[e] += u[0] * wr4[0] + u[1] * wr4[1] + u[2] * wr4[2] + u[3] * wr4[3]; } }
#pragma unroll
        for (int e = 0; e < 8; ++e) lg[e] = wave_sum(lg[e]);
        int i0 = 0; float v0 = lg[0];
#pragma unroll
        for (int e = 1; e < 8; ++e) if (lg[e] > v0) { v0 = lg[e]; i0 = e; }
        int i1 = -1; float v1 = -3e38f;
#pragma unroll
        for (int e = 0; e < 8; ++e) if (e != i0 && lg[e] > v1) { v1 = lg[e]; i1 = e; }
        const float e1 = __expf(v1 - v0), g0 = 1.f / (1.f + e1), g1 = e1 / (1.f + e1);
        if (row_valid(row)) { if (lane == nk) { kr = row; ke0 = i0; ke1 = i1; kg0 = g0; kg1 = g1; } ++nk; }
    }
    const bool have = lane < nk; const int hfl = have ? (kr / LP) / BPH : -1;
    const unsigned long long lt = (1ull << lane) - 1ull;
#pragma unroll
    for (int hf = 0; hf < NHALF; ++hf)
#pragma unroll
        for (int e = 0; e < 8; ++e) {
            const bool m0 = have && hfl == hf && ke0 == e, m1 = have && hfl == hf && ke1 == e;
            const unsigned long long b0 = __ballot(m0), b1 = __ballot(m1);
            const int n0 = __popcll(b0), n = n0 + __popcll(b1);
            if (n) {
                unsigned base = 0u;
                if (lane == 0) base = __hip_atomic_fetch_add(B.ctl + CW_MOECNT + (hf * 8 + e) * 64, (unsigned)n, __ATOMIC_RELAXED, __HIP_MEMORY_SCOPE_AGENT);
                base = (unsigned)__builtin_amdgcn_readfirstlane((int)base);
                if (m0) { const size_t pos = (size_t)(hf * 8 + e) * CAP + base + __popcll(b0 & lt); B.LST[pos] = kr * 2; B.GL[pos] = kg0; }
                if (m1) { const size_t pos = (size_t)(hf * 8 + e) * CAP + base + n0 + __popcll(b1 & lt); B.LST[pos] = kr * 2 + 1; B.GL[pos] = kg1; }
            }
        }
}
__device__ __forceinline__ void moe_combine(CParams& p, int hf, int wg, int nwg, const int wave_idx_) {
    auto& B = p.b;
    int tid_ = fresh_tid(); asm volatile("" : "+v"(tid_));
    const int lane = tid_ & 63, wv = tid_ >> 6;
#define COMB_LOAD(YW, HW, T) do { const int bl_ = (T) / L, pos_ = (T) - bl_ * L; const int row_ = (hf * BPH + bl_) * LP + PADF + pos_; \
        const float* hp_ = hf_row(B.Hout, B.Hside, row_); const bf16_t* yp_ = B.YS1 + (size_t)(T) * D; \
        _Pragma("unroll") for (int j_ = 0; j_ < 2; ++j_) { YW[j_] = *(const u32x4*)(yp_ + j_ * 512 + lane * 8); HW[2 * j_] = *(const f32x4*)(hp_ + j_ * 512 + lane * 8); HW[2 * j_ + 1] = *(const f32x4*)(hp_ + j_ * 512 + lane * 8 + 4); } } while (0)
    u32x4 yn[2]; f32x4 hn[4];
#pragma unroll
    for (int j = 0; j < 2; ++j) { yn[j] = (u32x4){0u, 0u, 0u, 0u}; hn[2 * j] = hn[2 * j + 1] = (f32x4){0.f, 0.f, 0.f, 0.f}; }
    { const int t0 = wg * 8 + wv; if (t0 < CAP) COMB_LOAD(yn, hn, t0); }
    for (int t = wg * 8 + wv; t < CAP; t += nwg * 8) {
        const int bl = t / L, pos = t - bl * L; const int row = (hf * BPH + bl) * LP + PADF + pos;
        float* hp = hf_row(B.Hout, B.Hside, row);
        u32x4 yc[2]; f32x4 hc[4];
#pragma unroll
        for (int j = 0; j < 2; ++j) { yc[j] = yn[j]; hc[2 * j] = hn[2 * j]; hc[2 * j + 1] = hn[2 * j + 1]; }
        { const int tn = t + nwg * 8; if (tn < CAP) COMB_LOAD(yn, hn, tn); }
#pragma unroll
        for (int j = 0; j < 2; ++j) { float y[8]; unpack8(yc[j], y);
            f32x4* h0 = (f32x4*)(hp + j * 512 + lane * 8); f32x4 a = hc[2 * j], c = hc[2 * j + 1];
            a[0] += y[0]; a[1] += y[1]; a[2] += y[2]; a[3] += y[3]; c[0] += y[4]; c[1] += y[5]; c[2] += y[6]; c[3] += y[7];
            h0[0] = a; h0[1] = c; }
    }
#undef COMB_LOAD
}
constexpr int LDS_STAGE = 131072, MISC_OFF = LDS_MISC_OFF, LDS_BYTES = MISC_OFF + 2048 + 1024;
static_assert(dn::O_END <= MISC_OFF && dn::O_TAB2 + 1024 <= LDS_BYTES && pg8::STAGE_BYTES <= MISC_OFF && LDS_BYTES <= 163840, "LDS map");
constexpr int PH_PROLOGUE = 0, PH_LAYER0 = 1, PH_PER_LAYER = 16, PH_FINAL = PH_LAYER0 + 2 * PH_PER_LAYER, PH_END = PH_FINAL + 1;
constexpr int DN_C1 = 4, DN_C2 = 4; constexpr bool DN_SKIP_MLA = true;
constexpr int PL_NORM1 = 0, PL_INPROJ = 1, PL_PREP = 2, PL_MLAUP = 3, PL_MLAFIN = 4, PL_MIXER = 5, PL_POST = 6, PL_OUTPROJ = 7, PL_NORM2 = 8, PL_FFN1 = 9, PL_FFN2 = 10, PL_COMB = 11, PL_FFN1B = 12, PL_FFN2B = 13, PL_COMBB = 14;

__device__ __forceinline__ int opq(int v) { asm volatile("" : "+s"(v)); return v; }
__device__ __forceinline__ bool in_phase(int lo, int hi, int k) { asm volatile("" : "+s"(lo), "+s"(hi)); return lo <= k && k < hi; }
__global__ void __launch_bounds__(NWG_THREADS, 2) mega(Params p_) {
    extern __shared__ __attribute__((aligned(16))) unsigned char lds_raw[];
    LAS unsigned char* lds = (LAS unsigned char*)lds_raw;
    volatile LAS unsigned* misc = (volatile LAS unsigned*)(lds + MISC_OFF);
    const int wave_idx_ = __builtin_amdgcn_readfirstlane((int)threadIdx.x >> 6);
    const int tid = fresh_tid();
    if (tid < 64) misc[tid] = 0u;
    __syncthreads();
#if PROBE
    if ((tid & 63) == 0) misc[24 + (tid >> 6)] = (unsigned)__builtin_amdgcn_s_getreg(((2 - 1) << 11) | (4 << 6) | 4);
    __syncthreads();
#endif
    const int G0 = gridDim.x; const int bx0 = blockIdx.x;
    XcdBarrier bar; bar.bar = p_.b.ctl; bar.x = 0; bar.st = misc + 8;
    const int fused = p_.fused;
    if (fused) bar = xcd_barrier_post(p_.b.ctl, misc + 8);
    const int lo = p_.ph_lo, hi = p_.ph_hi;
#if PROBE
    if (bx0 == 0 && fresh_tid() == 0) ((volatile unsigned long long*)(p_.b.ctl + 12288))[0] = wall_clock64();
#endif
#define IN(k) in_phase(lo, hi, (k))
#define MOE_KCAP(hf_) ((hf_) == 0 || p.kcap == 0 || !fused ? p.kcap : 256)
#define MOE_PK(hf_) ((hf_) == 0 || p.kcap == 0 || !fused ? B.PK : (float*)B.Ub)
#if PROBE
#define SEAM(k) do { if (fused && IN((k) + 1)) xcd_barrier(bar); if (bx0 == 0 && fresh_tid() == 0) ((volatile unsigned long long*)(p_.b.ctl + 12288))[(k) + 1] = wall_clock64(); } while (0)
#else
#define SEAM(k) do { if (fused && IN((k) + 1)) xcd_barrier(bar); } while (0)
#endif

    if (IN(PH_PROLOGUE)) { CParams& p = *opaque_params(); auto& B = p.b; const int bx = opq(bx0), G = opq(G0); (void)B; (void)bx; (void)G;
        {
            LAS bf16_t* tile = (LAS bf16_t*)lds; int tq_ = fresh_tid(); asm volatile("" : "+v"(tq_)); const int tq = tq_;
            constexpr int T0 = 512, T1 = 1024, T2 = 1216, T3 = 1408, T4 = 1760, T5 = 2112, TT = 2464;
#define PRO_JOB(T) int mode, ldsrc, N, lddst, ntn, tl; const float* src; bf16_t* dst; { const int t_ = (T); const int job = (t_ >= T0) + (t_ >= T1) + (t_ >= T2) + (t_ >= T3) + (t_ >= T4) + (t_ >= T5); \
                if (job < 2)      { mode = 1; src = p.in[4] + (size_t)job * D * 4048; ldsrc = 4048; N = 4096; dst = B.WinT + (size_t)job * 4096 * D; lddst = D; tl = t_ - job * 512; } \
                else if (job < 4) { mode = 0; src = p.in[19] + (size_t)(job - 2) * DMIX * D; ldsrc = D; N = D; dst = B.WoutT + (size_t)(job - 2) * D * DMIX; lddst = DMIX; tl = t_ - T1 - (job - 2) * 192; } \
                else if (job == 4) { mode = 2; src = p.in[21]; ldsrc = DFF; N = DFF; dst = B.WguT; lddst = D; tl = t_ - T3; } \
                else if (job == 5) { mode = 3; src = p.in[22]; ldsrc = DFF; N = DFF; dst = B.WguT; lddst = D; tl = t_ - T4; } \
                else               { mode = 0; src = p.in[23]; ldsrc = D; N = D; dst = B.WdT; lddst = DFF; tl = t_ - T5; } \
                ntn = (N + 63) / 64; }
            XpReg cur, nxt;
            if (bx < TT) { PRO_JOB(bx); (void)dst; (void)lddst; xpose_load(cur, mode, tq, src, ldsrc, N, (tl % ntn) * 64, (tl / ntn) * 128); }
            for (int t = bx; t < TT; t += G) {
                if (t + G < TT) { PRO_JOB(t + G); (void)dst; (void)lddst; xpose_load(nxt, mode, tq, src, ldsrc, N, (tl % ntn) * 64, (tl / ntn) * 128); }
                { PRO_JOB(t); (void)src; (void)ldsrc; xpose_finish(cur, mode, tile, tq, N, dst, lddst, (tl % ntn) * 64, (tl / ntn) * 128); }
                cur = nxt;
            }
#undef PRO_JOB
        }
        build_wu(p, bx, G, wave_idx_);
        if (bx == 0 && tid < 64) {
            for (int l = 0; l < 2; ++l) { const float* lp = p.in[11] + l * 256;
                const float a = wave_sum(lp[tid] * lp[64 + tid]), c = wave_sum(lp[128 + tid] * lp[192 + tid]);
                if (tid == 0) B.misc[l] = __expf(a) - __expf(c) + (0.8f - 0.6f * __expf(-0.3f * (float)l)); }
        }
        build_rows(p.in[0], p.in[1], p.in[3], B.Hout, B.Hside, B.Ub, bx, G, wave_idx_);
        SEAM(PH_PROLOGUE);
    }
    for (int l = 0; l < 2; ++l) {
        const int pb = PH_LAYER0 + l * PH_PER_LAYER;
        if (l > 0 && IN(pb + PL_NORM1)) { CParams& p = *opaque_params(); auto& B = p.b; const int bx = opq(bx0), G = opq(G0); (void)B; (void)bx; (void)G;
            norm_rows(B.Hout, B.Hside, p.in[3] + (size_t)l * D, B.Ub, bx, G, B.PART, p.nmm_ffn, p.nmm_ffn < MP / 256 ? 2 : 0, wave_idx_);
            SEAM(pb + PL_NORM1);
        }
        if (IN(pb + PL_INPROJ)) { CParams& p = *opaque_params(); auto& B = p.b; const int bx = opq(bx0), G = opq(G0); (void)B; (void)bx; (void)G;
            pg8::StaticOrder S; S.init(MP / 256, 16, G, bx, B.Ub, D, B.WinT + (size_t)l * 4096 * D, D);
            pg8::EpiBf16 E; E.O = B.G1; E.ldc = 1536; E.route = 1;
            E.R[0] = B.G1; E.rld[0] = 1536; E.R[1] = B.G2; E.rld[1] = 512; E.R[2] = B.G3; E.rld[2] = 1536; E.R[3] = B.G4; E.rld[3] = 512;
            E.rt0[0] = 0; E.rt0[1] = 6; E.rt0[2] = 8; E.rt0[3] = 14; E.rt0[4] = 16;
            pg8::gemm_phase<pg8::EpiBf16, pg8::StaticOrder, false>(lds, D, D, S, E, wave_idx_);
            SEAM(pb + PL_INPROJ);
        }
        if (IN(pb + PL_PREP)) { CParams& p = *opaque_params(); auto& B = p.b; const int bx = opq(bx0), G = opq(G0); (void)B; (void)bx; (void)G; prep_rows(p, l, bx, G, wave_idx_); SEAM(pb + PL_PREP); }
        for (int sp_ = PL_MLAUP; sp_ <= PL_MIXER; ++sp_) { const int sp = opq(sp_); if (!IN(pb + sp)) continue;
            CParams& p = *opaque_params(); auto& B = p.b; const int bx = opq(bx0), G = opq(G0); (void)B; (void)bx; (void)G;
            const bool split = G >= 2 * NB * 8;
            { int c_lo = 0, c_hi = (sp == PL_MIXER) ? 65 : 0;
              if (split) { c_lo = sp == PL_MLAUP ? 0 : sp == PL_MLAFIN ? DN_C1 : DN_C2; c_hi = sp == PL_MLAUP ? DN_C1 : sp == PL_MLAFIN ? DN_C2 : 65; }
              if (c_hi > c_lo) for (int it = bx; it < NB * 8; it += G) dn::dn_item(p, l, it >> 3, (it >> 1) & 3, it & 1, c_lo, c_hi, B.PART + (size_t)it * 32 * NWG_THREADS, lds, wave_idx_); }
            const bool dnph = split && (sp == PL_MLAUP ? DN_C1 > 0 : DN_C2 > DN_C1);
            const bool worker = !dnph || bx >= NB * 8; const int wb = dnph ? bx - NB * 8 : bx, wG = dnph ? G - NB * 8 : G;
            if (sp == PL_MLAUP) { if (worker) {
                pg8::StaticOrder S; S.init(MP / 256, 8, wG, wb, B.G4, 512, B.WuT + (size_t)l * 2048 * 384, 384);
                S.bdk = 4;
                pg8::EpiBf16 E; E.O = B.MLX; E.ldc = 2048; E.route = 0;
                E.R[0] = E.R[1] = E.R[2] = E.R[3] = B.MLX; E.rld[0] = E.rld[1] = E.rld[2] = E.rld[3] = 2048; E.rt0[0] = E.rt0[1] = E.rt0[2] = E.rt0[3] = E.rt0[4] = 0;
                pg8::gemm_phase<pg8::EpiBf16, pg8::StaticOrder, false>(lds, 512, 384, S, E, wave_idx_); }
            } else if (sp == PL_MLAFIN) { if (worker) mla_finalize(p, l, wb, wG, wave_idx_);
            } else {
            unsigned* qctr = B.ctl + 4096 + l * 256;
            const int n_att = NB * 4 * 17;
#if PROBE
            if (l == 0 && bx0 == 0 && fresh_tid() == 0) ((volatile unsigned long long*)(p_.b.ctl + 12288))[40] = wall_clock64();
#endif
#if PROBE
            if (l == 0 && bx0 == 100 && fresh_tid() == 0) ((volatile unsigned long long*)(p_.b.ctl + 12288))[54] = wall_clock64();
#endif
            for (;;) {
                __syncthreads();
                if (tid == 0) misc[16] = atomicAdd(qctr, 1u);
                __syncthreads();
                const int u = (int)misc[16];
                if (u >= n_att) break;
                int qb, bh; if (u < NB * 4 * 16) { qb = u & 15; bh = u >> 4; } else { qb = 16; bh = u - NB * 4 * 16; }
                const int h = bh & 3, b = bh >> 2;
                diff_unit(p, l, b, h, qb, lds, wave_idx_);
            }
#if PROBE
            if (l == 0 && bx0 == 100 && fresh_tid() == 0) ((volatile unsigned long long*)(p_.b.ctl + 12288))[55] = wall_clock64();
#endif
            if (!(split && bx < NB * 8 && DN_SKIP_MLA))
            for (;;) {
                __syncthreads();
                if (tid == 0) misc[16] = atomicAdd(qctr + 64, 1u);
                __syncthreads();
                const int u = (int)misc[16];
                if (u >= n_att) break;
                int qb, bh; if (u < NB * 4 * 16) { qb = u & 15; bh = u >> 4; } else { qb = 16; bh = u - NB * 4 * 16; }
                const int h = bh & 3, b = bh >> 2;
                mla_unit(p, b, h, qb, lds, wave_idx_);
            }
#if PROBE
            if (l == 0 && bx0 == 100 && fresh_tid() == 0) ((volatile unsigned long long*)(p_.b.ctl + 12288))[41] = wall_clock64();
#endif
            }
            SEAM(pb + sp);
        }
        if (IN(pb + PL_POST)) { CParams& p = *opaque_params(); auto& B = p.b; const int bx = opq(bx0), G = opq(G0); (void)B; (void)bx; (void)G; post_mixer(p, l, bx, G, wave_idx_); SEAM(pb + PL_POST); }
        if (IN(pb + PL_OUTPROJ)) { CParams& p = *opaque_params(); auto& B = p.b; const int bx = opq(bx0), G = opq(G0); (void)B; (void)bx; (void)G;
            pg8::TailOrder S; S.init(MP / 256, 4, G, bx, B.G1, DMIX, B.WoutT + (size_t)l * D * DMIX, DMIX, 4, p.nmm_out);
            pg8::EpiResid E; E.Hout = B.Hout; E.Hside = B.Hside; E.PART = B.PART;
            pg8::gemm_phase<pg8::EpiResid, pg8::TailOrder, false>(lds, DMIX, DMIX, S, E, wave_idx_);
            if (l == 1 && !DEBUG_CHECK) moe_convert_queue(p, lds, misc, wave_idx_);
            SEAM(pb + PL_OUTPROJ);
        }
        if (IN(pb + PL_NORM2)) { CParams& p = *opaque_params(); auto& B = p.b; const int bx = opq(bx0), G = opq(G0); (void)B; (void)bx; (void)G;
            if (l == 0) norm_rows(B.Hout, B.Hside, p.in[20], B.Ub, bx, G, B.PART, p.nmm_out, p.nmm_out < MP / 256 ? 4 : 0, wave_idx_);
            else {
                moe_convert_queue(p, lds, misc, wave_idx_);
                __syncthreads();
                norm_router_rows(p, bx, G, lds, p.nmm_out, p.nmm_out < MP / 256 ? 4 : 0, wave_idx_);
            }
            SEAM(pb + PL_NORM2); }
        if (l == 0) {
            if (IN(pb + PL_FFN1)) { CParams& p = *opaque_params(); auto& B = p.b; const int bx = opq(bx0), G = opq(G0); (void)B; (void)bx; (void)G;
                pg8::StaticOrder S; S.init(MP / 256, DFF / 128, G, bx, B.Ub, D, B.WguT, D);
                pg8::EpiSwiglu E; E.O = B.ACT; E.ldc = DFF;
                pg8::gemm_phase<pg8::EpiSwiglu, pg8::StaticOrder, false>(lds, D, D, S, E, wave_idx_);
                SEAM(pb + PL_FFN1);
            }
            if (IN(pb + PL_FFN2)) { CParams& p = *opaque_params(); auto& B = p.b; const int bx = opq(bx0), G = opq(G0); (void)B; (void)bx; (void)G;
                pg8::TailOrder S; S.init(MP / 256, 4, G, bx, B.ACT, DFF, B.WdT, DFF, 2, p.nmm_ffn);
                pg8::EpiResid E; E.Hout = B.Hout; E.Hside = B.Hside; E.PART = B.PART;
                pg8::gemm_phase<pg8::EpiResid, pg8::TailOrder, false>(lds, DFF, DFF, S, E, wave_idx_);
                SEAM(pb + PL_FFN2);
            }
        } else {
            for (int hf = 0; hf < NHALF; ++hf) {
                const int po = pb + (hf == 0 ? PL_FFN1 : PL_FFN1B);
                if (IN(po)) { CParams& p = *opaque_params(); auto& B = p.b; const int bx = opq(bx0), G = opq(G0); (void)B; (void)bx; (void)G;
                    pg8::MoeSched S; S.init(B.ctl + CW_MOECNT + hf * 8 * 64, 2 * DFE / 256, G, bx, B.Ub, D, B.W1T, D, (size_t)2 * DFE * D, B.LST + (size_t)hf * 8 * CAP, B.GL + (size_t)hf * 8 * CAP, CAP, 1);
                    pg8::EpiSwiglu E; E.O = B.ACTM; E.ldc = DFE;
                    pg8::gemm_phase<pg8::EpiSwiglu, pg8::MoeSched, true>(lds, D, D, S, E, wave_idx_);
                    SEAM(po);
                }
                if (IN(po + 1)) { CParams& p = *opaque_params(); auto& B = p.b; const int bx = opq(bx0), G = opq(G0); (void)B; (void)bx; (void)G;
                    pg8::MoeSched S; S.init(B.ctl + CW_MOECNT + hf * 8 * 64, D / 256, G, bx, B.ACTM, DFE, B.W2T, DFE, (size_t)D * DFE, B.LST + (size_t)hf * 8 * CAP, B.GL + (size_t)hf * 8 * CAP, CAP, 0, MOE_KCAP(hf));
                    pg8::EpiMoeDown E; E.Hout = B.Hout; E.Hside = B.Hside; E.YS1 = B.YS1; E.b0 = hf * BPH; E.PK = MOE_PK(hf);
                    pg8::gemm_phase<pg8::EpiMoeDown, pg8::MoeSched, false>(lds, DFE, DFE, S, E, wave_idx_);
                    SEAM(po + 1);
                }
                if (IN(po + 2)) { CParams& p = *opaque_params(); const int bx = opq(bx0), G = opq(G0);
                    if (p.kcap > 0) { auto& B = p.b;
                        pg8::MoeSched S; S.init(B.ctl + CW_MOECNT + hf * 8 * 64, D / 256, G, bx, B.ACTM, DFE, B.W2T, DFE, (size_t)D * DFE, B.LST + (size_t)hf * 8 * CAP, B.GL + (size_t)hf * 8 * CAP, CAP, 0, MOE_KCAP(hf));
                        pg8::moe_tail_fixup(S, B.Hout, B.Hside, B.YS1, hf * BPH, MOE_PK(hf), bx, G, wave_idx_);
                        if (fused) xcd_barrier(bar); }
                    moe_combine(p, hf, bx, G, wave_idx_);
                    if (hf == NHALF - 1 || !fused) SEAM(po + 2);
                }
            }
        }
    }
#if PROBE
    {
        xcd_barrier(bar);
        if (bx0 == 0 && fresh_tid() == 0) {
            const volatile unsigned long long* ts = (const volatile unsigned long long*)(p_.b.ctl + 12288);
            const unsigned long long d = (ts[PROBE_B + 1] - ts[PROBE_A]) * (unsigned long long)PROBE_C, t0 = wall_clock64();
            while (wall_clock64() - t0 < d) __builtin_amdgcn_s_sleep(32);
#if PROBE_D >= 1
            if (misc[24] == misc[24 + PROBE_D]) { const unsigned long long t1 = wall_clock64(); while (wall_clock64() - t1 < 200000ull) __builtin_amdgcn_s_sleep(32); }
#endif
        }
    }
#endif
#undef IN
#undef SEAM
}
}
namespace dbg {
__global__ void __launch_bounds__(256) k_cmp(const void* fast, int is_bf16, int ldf, int colf, const float* ref, int ldr, int colr, int cols, float refscale, float* acc, int frow0, int rrow0, int nrows) {
    __shared__ float s0[4], s1[4];
    float d2 = 0.f, r2 = 0.f;
    const size_t n = (size_t)nrows * cols;
    for (size_t i = (size_t)blockIdx.x * blockDim.x + threadIdx.x; i < n; i += (size_t)gridDim.x * blockDim.x) {
        const int pos = (int)(i / cols), c = (int)(i % cols);
        const size_t fo = (size_t)(frow0 + pos) * ldf + colf + c;
        const float a = is_bf16 ? fx::bf2f(((const fx::bf16_t*)fast)[fo]) : ((const float*)fast)[fo];
        const float b = ref[(size_t)(rrow0 + pos) * ldr + colr + c] * refscale;
        d2 += (a - b) * (a - b); r2 += b * b;
    }
    d2 = nv::wave_sum(d2); r2 = nv::wave_sum(r2);
    if ((threadIdx.x & 63) == 0) { s0[threadIdx.x >> 6] = d2; s1[threadIdx.x >> 6] = r2; }
    __syncthreads();
    if (threadIdx.x == 0) { atomicAdd(acc, s0[0] + s0[1] + s0[2] + s0[3]); atomicAdd(acc + 1, s1[0] + s1[1] + s1[2] + s1[3]); }
}
__global__ void k_setchk(float* acc, const float* v) { const float e = 1.f + log10f(fabsf(v[0]) + 1e-9f) * 0.25f; acc[0] = e * e; acc[1] = 1.f; }
__global__ void k_zero(float* p, int n) { const int i = blockIdx.x * blockDim.x + threadIdx.x; if (i < n) p[i] = 0.f; }
struct Thr { float t[128]; };
__global__ void k_encode(const float* acc, Thr thr, int nchk, float* sx) {
    if (threadIdx.x != 0 || blockIdx.x != 0) return;
    float s = 0.f, X = 0.f;
    for (int k = 0; k < nchk; ++k) {
        const float err = sqrtf(acc[2 * k] / fmaxf(acc[2 * k + 1], 1e-30f));
        const bool bad = !(err <= thr.t[k]);
        if (bad) { s = 0.1f * (float)(k + 1); X = 20.f + 100.f * fminf(err, 2.f); if (!(err == err)) X = 250.f; break; }
    }
    sx[0] = s; sx[1] = X;
}
__global__ void k_write_out_dbg(const float* __restrict__ H, float* __restrict__ out, const float* sx) {
    const size_t n = (size_t)nv::NB * nv::SEQ * nv::D; const float s = sx[0], X = sx[1];
    for (size_t i = (size_t)blockIdx.x * blockDim.x + threadIdx.x; i < n; i += (size_t)gridDim.x * blockDim.x) {
        const int d = (int)(i % nv::D); const size_t r = i / nv::D; const int sq = (int)(r % nv::SEQ), b = (int)(r / nv::SEQ);
        float v = H[((size_t)b * nv::L + nv::NM + sq) * nv::D + d] * (1.f + s);
        if (i == 0 && X != 0.f) v = X;
        out[i] = v;
    }
}
}

struct Region { unsigned char* base; size_t off, cap; };
static void* rtake(Region& r, size_t bytes) { void* p = r.base + r.off; r.off += (bytes + 255) & ~(size_t)255; return p; }

static void carve_fast(fx::Bufs& B, Region& r, float* out) {
    B.Hout = out;
    using namespace fx;
    B.ctl = (unsigned*)rtake(r, 65536);
    B.misc = (float*)rtake(r, 4096);
    B.PART = (float*)rtake(r, (size_t)32 * 256 * 256 * 4);
    B.Hside = (float*)rtake(r, (size_t)(NB * 64 + (MP - NB * LP) + 8) * D * 4);
    B.G1 = (bf16_t*)rtake(r, (size_t)MP * 1536 * 2);
    B.G2 = (bf16_t*)rtake(r, (size_t)MP * 512 * 2);
    B.G4 = (bf16_t*)rtake(r, (size_t)MP * 512 * 2);
    B.ODN = (bf16_t*)rtake(r, (size_t)2 * MP * 512 * 2);
    B.ACT = B.G1;
    B.WinT = (bf16_t*)rtake(r, (size_t)2 * 4096 * 1024 * 2);
    B.WuT = (bf16_t*)rtake(r, (size_t)2 * 2048 * 384 * 2);
    B.WoutT = (bf16_t*)rtake(r, (size_t)2 * 1024 * 1536 * 2);
    B.WguT = (bf16_t*)rtake(r, (size_t)5632 * 1024 * 2);
    B.WdT = (bf16_t*)rtake(r, (size_t)1024 * 2816 * 2);
    B.BG = (float*)rtake(r, (size_t)MP * 16 * 4);
    B.MLX = (bf16_t*)rtake(r, (size_t)MP * 2048 * 2);
    B.Ub = B.MLX;
    B.G3 = (bf16_t*)rtake(r, (size_t)MP * 1536 * 2);
    B.W1T = B.W2T = B.ACTM = B.YS1 = nullptr; B.LST = nullptr; B.GL = nullptr;
}
static int g_kcap = 0;
static void carve_moe_release(fx::Bufs& B, unsigned char* ws, size_t ws_size) {
    using namespace fx;
    unsigned char* a0 = (unsigned char*)B.G1; size_t o = 0;
    B.ACTM = (bf16_t*)(a0 + o); o += (size_t)136 * 256 * DFE * 2;
    B.YS1 = (bf16_t*)(a0 + o); o += (size_t)CAP * D * 2;
    if (a0 + o > (unsigned char*)B.MLX) fprintf(stderr, "moe overlay A too big\n");
    unsigned char* m0 = (unsigned char*)B.MLX + (size_t)MP * D * 2; o = 0;
    B.W2T = (bf16_t*)(m0 + o); o += (size_t)8 * D * DFE * 2;
    B.LST = (int*)(m0 + o); o += (size_t)NHALF * 8 * CAP * 4;
    B.GL = (float*)(m0 + o); o += (size_t)NHALF * 8 * CAP * 4;
    if (m0 + o > (unsigned char*)B.MLX + (size_t)MP * 2048 * 2) fprintf(stderr, "moe overlay MLX too big\n");
    B.W1T = (bf16_t*)B.G3;
    if ((unsigned char*)B.W1T + (size_t)8 * 2 * DFE * D * 2 > ws + ws_size) fprintf(stderr, "moe overlay W1T beyond workspace\n");
    unsigned char* k0 = (unsigned char*)B.W1T + (size_t)8 * 2 * DFE * D * 2; k0 += (256 - ((size_t)k0 & 255)) & 255;
    long long room = (long long)((ws + ws_size) - k0) / (256 * 256 * 4); if (room < 0) room = 0; if (room > 128) room = 128;
    B.PK = (float*)k0; g_kcap = (int)room;
}

static int g_grid = 0;
static int fast_setup() {
    if (g_grid) return g_grid;
    int dev = 0, cus = 0, per_cu = 0;
    if (hipGetDevice(&dev) != hipSuccess || hipDeviceGetAttribute(&cus, hipDeviceAttributeMultiprocessorCount, dev) != hipSuccess) { g_grid = -1; return g_grid; }
    if (hipFuncSetAttribute((const void*)fx::mega, hipFuncAttributeMaxDynamicSharedMemorySize, fx::LDS_BYTES) != hipSuccess) { fprintf(stderr, "hipFuncSetAttribute failed\n"); g_grid = -1; return g_grid; }
    if (hipOccupancyMaxActiveBlocksPerMultiprocessor(&per_cu, (const void*)fx::mega, fx::NWG_THREADS, fx::LDS_BYTES) != hipSuccess || per_cu < 1) { fprintf(stderr, "occupancy query: %d\n", per_cu); (void)hipGetLastError(); g_grid = -1; return g_grid; }
    (void)hipGetLastError();
    g_grid = cus;
    return g_grid;
}
static void launch_phases(const fx::Params& p0, int lo, int hi, int fused, hipStream_t stream) {
    fx::Params p = p0; p.ph_lo = lo; p.ph_hi = hi; p.fused = fused; p.pad = 0; p.kcap = g_kcap; p.pad2 = 0;
    p.nmm_out = fx::pg8::tail_main_tiles(fx::MP / 256, 4, g_grid, fx::DMIX / 64, 4); p.nmm_ffn = fx::pg8::tail_main_tiles(fx::MP / 256, 4, g_grid, fx::DFF / 64, 2);
    if (fused) hipMemsetAsync(p.b.ctl, 0, 65536, stream);
    hipLaunchKernelGGL(fx::mega, dim3(g_grid), dim3(fx::NWG_THREADS), fx::LDS_BYTES, stream, p);
}

extern "C" void kernel_launch(void* const* d_in, const int* in_sizes, int n_in, void* d_out, int out_size, void* d_ws, size_t ws_size, hipStream_t stream) {
    if (fast_setup() <= 0) return;
    fx::Params P{};
    for (int i = 0; i < 28; ++i) P.in[i] = (const float*)d_in[i];
    P.out = (float*)d_out;
#if !DEBUG_CHECK
    {
        Region r{(unsigned char*)d_ws, 0, ws_size};
        carve_fast(P.b, r, (float*)d_out);
        if (r.off > ws_size) { fprintf(stderr, "workspace too small: need %zu have %zu\n", r.off, ws_size); return; }
        carve_moe_release(P.b, (unsigned char*)d_ws, ws_size);
        launch_phases(P, 0, fx::PH_END, 1, stream);
    }
#else
    using namespace nv;
    const float* x = (const float*)d_in[0];
    const float* meta = (const float*)d_in[1];
    const float* rel_table = (const float*)d_in[2];
    const float* attn_norm_w = (const float*)d_in[3];
    const float* w_in = (const float*)d_in[4];
    const float* dn_conv_w = (const float*)d_in[5];
    const float* dn_a_log = (const float*)d_in[6];
    const float* dn_dt_bias = (const float*)d_in[7];
    const float* dn_norm_w = (const float*)d_in[8];
    const float* diff_q_norm_w = (const float*)d_in[9];
    const float* diff_k_norm_w = (const float*)d_in[10];
    const float* diff_lambda = (const float*)d_in[11];
    const float* diff_subln_w = (const float*)d_in[12];
    const float* mla_q_lat_norm_w = (const float*)d_in[13];
    const float* mla_w_uq = (const float*)d_in[14];
    const float* mla_kv_lat_norm_w = (const float*)d_in[15];
    const float* mla_w_ukv = (const float*)d_in[16];
    const float* mla_q_norm_w = (const float*)d_in[17];
    const float* mla_k_norm_w = (const float*)d_in[18];
    const float* w_out = (const float*)d_in[19];
    const float* ffn_norm_w = (const float*)d_in[20];
    const float* ffn_w_gate = (const float*)d_in[21];
    const float* ffn_w_up = (const float*)d_in[22];
    const float* ffn_w_down = (const float*)d_in[23];
    const float* router_w = (const float*)d_in[24];
    const float* moe_w_gate = (const float*)d_in[25];
    const float* moe_w_up = (const float*)d_in[26];
    const float* moe_w_down = (const float*)d_in[27];
    float* out = (float*)d_out;

    float* ws = (float*)d_ws; size_t off = 0;
    auto take = [&](size_t n) { float* p = ws + off; off += (n + 63) & ~(size_t)63; return p; };
    float* H = take((size_t)NB * L * D);
    float* U = take((size_t)L * D);
    float* PROJ = take((size_t)L * INC);
    float* QKVC = take((size_t)L * 1536);
    float* BETA = take((size_t)L * 8);
    float* GG = take((size_t)L * 8);
    float* ODN = take((size_t)2 * L * 512);
    float* Y = take((size_t)L * DMIX);
    float* DFQ = take((size_t)L * 512);
    float* DFK = take((size_t)L * 512);
    float* ODF = take((size_t)L * 512);
    float* CQN = take((size_t)L * 256);
    float* CKVN = take((size_t)L * 128);
    float* MLQ = take((size_t)L * 768);
    float* MLKV = take((size_t)L * 1024);
    float* QF = take((size_t)L * 768);
    float* KF = take((size_t)L * 768);
    float* LAM = take(64);
    float* GATE = take((size_t)L * 2);
    int* CNT = (int*)take(64);
    int* LIST = (int*)take((size_t)NE * L);
    float* CHK = take(256);
    float* THR = take(64);
    float* SX = take(64);
    float* S0 = take((size_t)L * L);
    float* S1 = take((size_t)L * L);
    float* FG = S0; float* FU = S1; float* XG = QKVC; float* YE = PROJ; float* YS = PROJ + (size_t)L * D;

    Region rf{(unsigned char*)d_out, (size_t)NBF * fx::SEQ * fx::D * 4, (size_t)out_size * 4};
    carve_fast(P.b, rf, (float*)d_out);
    if (rf.off > (size_t)out_size * 4) { fprintf(stderr, "debug carve too big: %zu\n", rf.off); return; }
    {
        unsigned char* a0 = (unsigned char*)U; size_t o = 0;
        P.b.W1T = (fx::bf16_t*)(a0 + o); o += (size_t)8 * 2 * fx::DFE * fx::D * 2;
        P.b.W2T = (fx::bf16_t*)(a0 + o); o += (size_t)8 * fx::D * fx::DFE * 2;
        if (a0 + o > (unsigned char*)LAM) fprintf(stderr, "debug moe weights overlay too big\n");
        unsigned char* s0 = (unsigned char*)S0; o = 0;
        P.b.ACTM = (fx::bf16_t*)(s0 + o); o += (size_t)48 * 256 * fx::DFE * 2;
        P.b.YS1 = (fx::bf16_t*)(s0 + o); o += (size_t)fx::CAP * fx::D * 2;
        P.b.LST = (int*)(s0 + o); o += (size_t)fx::NHALF * 8 * fx::CAP * 4;
        P.b.GL = (float*)(s0 + o); o += (size_t)fx::NHALF * 8 * fx::CAP * 4;
    }
    hipMemsetAsync(P.b.ctl, 0, 65536, stream);
    dbg::k_zero<<<1, 256, 0, stream>>>(CHK, 256);
    dbg::Thr h_thr{}; int nchk = 0;
    auto chk = [&](const void* fast, int is_bf16, int ldf, int colf, const float* ref, int ldr, int colr, int cols, float refscale, float thr) {
        dbg::k_cmp<<<512, 256, 0, stream>>>(fast, is_bf16, ldf, colf, ref, ldr, colr, cols, refscale, CHK + 2 * nchk, 48, 0, L);
        if (nchk < 127) { h_thr.t[nchk] = thr; ++nchk; }
    };
    auto chkH = [&](const float* Hb, float thr) {
        dbg::k_cmp<<<512, 256, 0, stream>>>(P.b.Hout, 0, 1024, 0, Hb, D, 0, D, 1.f, CHK + 2 * nchk, 0, NM, SEQ);
        if (nchk < 127) { h_thr.t[nchk] = thr; ++nchk; }
    };

    auto gemm = [&](bool tb, const float* A, int lda, const float* B, int ldb, float* C, int ldc, int M, int N, int K, const int* Mdev, int acc) {
        dim3 g((N + 63) / 64, (M + 63) / 64);
        if (tb) k_gemm<true><<<g, 256, 0, stream>>>(A, lda, B, ldb, C, ldc, M, N, K, Mdev, acc);
        else    k_gemm<false><<<g, 256, 0, stream>>>(A, lda, B, ldb, C, ldc, M, N, K, Mdev, acc);
    };
    auto rms = [&](const float* in, int in_ld, float* o, int out_ld, const float* w, int rows, int groups, int n, float scale) {
        const int waves = rows * groups; k_rmsnorm<<<(waves + 3) / 4, 256, 0, stream>>>(in, in_ld, o, out_ld, w, rows, groups, n, scale);
    };
    const int PB0 = fx::PH_LAYER0, PPL = fx::PH_PER_LAYER;
    const int DBG_MAXL = 1; const bool DBG_MOE = true; const int DBG_SLOT = 8; const bool DBG_PROBE = false;

    k_build_h<<<2048, 256, 0, stream>>>(x, meta, H);
    hipMemsetAsync(P.b.misc + 8, 0, 32, stream);
    launch_phases(P, fx::PH_PROLOGUE, fx::PH_PROLOGUE + 1, 0, stream);
    for (int l = 0; l < 2; ++l) {
        const float lam_init = 0.8f - 0.6f * expf(-0.3f * (float)l);
        k_lam<<<1, 64, 0, stream>>>(diff_lambda + l * 256, lam_init, LAM);
        for (int b = 0; b < NB; ++b) {
            const bool T = (b == 0) && (l <= DBG_MAXL);
            const int pb = PB0 + l * PPL;
            float* Hb = H + (size_t)b * L * D;
            rms(Hb, D, U, D, attn_norm_w + l * D, L, 1, D, 1.f);
            if (T) { if (l > 0) launch_phases(P, pb + fx::PL_NORM1, pb + fx::PL_NORM1 + 1, 0, stream);
                     if (l == 0) chkH(Hb, 1e-5f);
                     chk(P.b.Ub, 1, 1024, 0, U, D, 0, D, 1.f, 0.01f); }
            gemm(false, U, D, w_in + (size_t)l * D * INC, INC, PROJ, INC, L, INC, D, nullptr, 0);
            if (T) { launch_phases(P, pb + fx::PL_INPROJ, pb + fx::PL_INPROJ + 1, 0, stream);
                     chk(P.b.G1, 1, 1536, 0, PROJ, INC, 0, 1536, 1.f, 0.02f);
                     chk(P.b.G2, 1, 512, 0, PROJ, INC, C_DNZ, 512, 1.f, 0.02f);
                     chk(P.b.G3, 1, 1536, 0, PROJ, INC, C_DFQ, 1536, 1.f, 0.02f);
                     chk(P.b.G4, 1, 512, 0, PROJ, INC, C_MLQ, 448, 1.f, 0.02f);
                     chk(P.b.G4, 1, 512, 448, PROJ, INC, C_DNB, 16, 1.f, 0.02f); }
            k_dn_conv<<<2048, 256, 0, stream>>>(PROJ, dn_conv_w + l * 5 * 1536, QKVC);
            k_dn_l2<<<(L * 8 + 3) / 4, 256, 0, stream>>>(QKVC);
            k_dn_bg<<<(L * 8 + 255) / 256, 256, 0, stream>>>(PROJ, dn_a_log + l * 8, dn_dt_bias + l * 8, BETA, GG);
            k_dn_scan<<<8, 128, 0, stream>>>(QKVC, BETA, GG, ODN);
            k_dn_out<<<(L * 4 + 3) / 4, 256, 0, stream>>>(ODN, PROJ, dn_norm_w + l * 128, Y);
            rms(PROJ + C_DFQ, INC, DFQ, 512, diff_q_norm_w + l * 64, L, 8, 64, 1.f);
            rms(PROJ + C_DFK, INC, DFK, 512, diff_k_norm_w + l * 64, L, 8, 64, 1.f);
            for (int h = 0; h < 4; ++h) {
                gemm(true, DFQ + h * 128, 512, DFK + h * 128, 512, S0, L, L, L, 64, nullptr, 0);
                gemm(true, DFQ + h * 128 + 64, 512, DFK + h * 128 + 64, 512, S1, L, L, L, 64, nullptr, 0);
                k_diff_softmax<<<L, 256, 0, stream>>>(S0, S1, rel_table, h, LAM);
                gemm(false, S0, L, PROJ + C_DFV + h * 128, INC, ODF + h * 128, 512, L, 128, L, nullptr, 0);
            }
            rms(ODF, 512, Y + 512, DMIX, diff_subln_w + l * 128, L, 4, 128, 1.f - lam_init);
            rms(PROJ + C_MLQ, INC, CQN, 256, mla_q_lat_norm_w + l * 256, L, 1, 256, 1.f);
            rms(PROJ + C_MLKV, INC, CKVN, 128, mla_kv_lat_norm_w + l * 128, L, 1, 128, 1.f);
            gemm(false, CQN, 256, mla_w_uq + (size_t)l * 256 * 768, 768, MLQ, 768, L, 768, 256, nullptr, 0);
            gemm(false, CKVN, 128, mla_w_ukv + (size_t)l * 128 * 1024, 1024, MLKV, 1024, L, 1024, 128, nullptr, 0);
            k_mla_prep<<<(L * 8 + 3) / 4, 256, 0, stream>>>(MLQ, MLKV, PROJ, mla_q_norm_w + l * 192, mla_k_norm_w + l * 192, QF, KF);
            if (T) {
                launch_phases(P, pb + fx::PL_PREP, pb + fx::PL_PREP + 1, 0, stream);
                chk(P.b.G3, 1, 1536, 0, DFQ, 512, 0, 512, fx::DIFF_QSCALE, 0.02f);
                chk(P.b.G3, 1, 1536, 512, DFK, 512, 0, 512, 1.f, 0.02f);
                chk(P.b.G4, 1, 512, 0, CQN, 256, 0, 256, 1.f, 0.02f);
                chk(P.b.G4, 1, 512, 256, CKVN, 128, 0, 128, 1.f, 0.02f);
                chk(P.b.BG, 0, 16, 0, BETA, 8, 0, 8, 1.f, 0.02f);
                chk(P.b.BG, 0, 16, 8, GG, 8, 0, 8, 1.f, 0.02f);
                launch_phases(P, pb + fx::PL_MLAUP, pb + fx::PL_MLAFIN + 1, 1, stream);
                for (int h = 0; h < 4; ++h) {
                    chk(P.b.MLX, 1, 2048, 256 * h, QF, 768, 192 * h, 192, fx::MLA_QSCALE, 0.03f);
                    chk(P.b.MLX, 1, 2048, 256 * h + 192, KF, 768, 192 * h + 128, 64, 1.f, 0.03f);
                    chk(P.b.MLX, 1, 2048, 1024 + 256 * h, KF, 768, 192 * h, 128, 1.f, 0.03f);
                    chk(P.b.MLX, 1, 2048, 1024 + 256 * h + 128, MLKV, 1024, 256 * h + 128, 128, 1.f, 0.03f);
                }
            }
            for (int h = 0; h < 4; ++h) {
                gemm(true, QF + h * 192, 768, KF + h * 192, 768, S0, L, L, L, 192, nullptr, 0);
                k_softmax<<<L, 256, 0, stream>>>(S0, 0.07216878364870322f);
                gemm(false, S0, L, MLKV + h * 256 + 128, 1024, Y + 1024 + h * 128, DMIX, L, 128, L, nullptr, 0);
            }
            if (T) {
                launch_phases(P, pb + fx::PL_MIXER, pb + fx::PL_MIXER + 1, 1, stream);
                if (l == 0 && DBG_PROBE) { dbg::k_setchk<<<1, 1, 0, stream>>>(CHK + 2 * nchk, P.b.misc + DBG_SLOT); h_thr.t[nchk] = 0.f; ++nchk; }
                chk(P.b.ODN, 1, 512, 0, ODN, 512, 0, 512, 1.f, 0.03f);
                chk(P.b.ODN + (size_t)fx::MP * 512, 1, 512, 0, ODN + (size_t)L * 512, 512, 0, 512, 1.f, 0.03f);
                chk(P.b.G3, 1, 1536, 0, ODF, 512, 0, 512, 1.f, 0.03f);
                for (int h = 0; h < 4; ++h) chk(P.b.MLX, 1, 2048, 256 * h, Y, DMIX, 1024 + 128 * h, 128, 1.f, 0.03f);
            }
            if (T) { launch_phases(P, pb + fx::PL_POST, pb + fx::PL_POST + 1, 0, stream);
                     chk(P.b.G1, 1, 1536, 0, Y, DMIX, 0, 512, 1.f, 0.03f); chk(P.b.G1, 1, 1536, 512, Y, DMIX, 512, 512, 1.f, 0.03f); chk(P.b.G1, 1, 1536, 1024, Y, DMIX, 1024, 512, 1.f, 0.03f); }
            gemm(false, Y, DMIX, w_out + (size_t)l * DMIX * D, D, Hb, D, L, D, DMIX, nullptr, 1);
            if (T) { launch_phases(P, pb + fx::PL_OUTPROJ, pb + fx::PL_OUTPROJ + 1, 0, stream); chkH(Hb, 0.01f); }
            rms(Hb, D, U, D, ffn_norm_w + l * D, L, 1, D, 1.f);
            if (l == 0) {
                gemm(false, U, D, ffn_w_gate, DFF, FG, DFF, L, DFF, D, nullptr, 0);
                gemm(false, U, D, ffn_w_up, DFF, FU, DFF, L, DFF, D, nullptr, 0);
                k_swiglu_act<<<2048, 256, 0, stream>>>(FG, FU, DFF, DFF, L, nullptr);
                if (T) { launch_phases(P, pb + fx::PL_NORM2, pb + fx::PL_FFN1 + 1, 1, stream); chk(P.b.ACT, 1, DFF, 0, FG, DFF, 0, DFF, 1.f, 0.03f); }
                gemm(false, FG, DFF, ffn_w_down, D, Hb, D, L, D, DFF, nullptr, 1);
                if (T) { launch_phases(P, pb + fx::PL_FFN2, pb + fx::PL_FFN2 + 1, 0, stream); chkH(Hb, 0.01f); }
            } else {
                k_zero_int<<<1, 64, 0, stream>>>(CNT, 64);
                k_router<<<(L + 3) / 4, 256, 0, stream>>>(U, router_w, CNT, LIST, GATE);
                for (int e = 0; e < NE; ++e) {
                    k_gather<<<1024, 256, 0, stream>>>(U, LIST + e * L, CNT + e, XG);
                    gemm(false, XG, D, moe_w_gate + (size_t)e * D * DFE, DFE, FG, DFE, L, DFE, D, CNT + e, 0);
                    gemm(false, XG, D, moe_w_up + (size_t)e * D * DFE, DFE, FU, DFE, L, DFE, D, CNT + e, 0);
                    k_swiglu_act<<<2048, 256, 0, stream>>>(FG, FU, DFE, DFE, L, CNT + e);
                    gemm(false, FG, DFE, moe_w_down + (size_t)e * DFE * D, D, YE, D, L, D, DFE, CNT + e, 0);
                    k_scatter<<<1024, 256, 0, stream>>>(YE, LIST + e * L, CNT + e, YS);
                }
                k_moe_combine<<<2048, 256, 0, stream>>>(Hb, YS, GATE);
                if (T && DBG_MOE) { launch_phases(P, pb + fx::PL_NORM2, pb + fx::PL_COMB + 1, 1, stream); chkH(Hb, 0.02f); }
            }
        }
    }
    dbg::k_encode<<<1, 64, 0, stream>>>(CHK, h_thr, nchk, SX);
    dbg::k_write_out_dbg<<<2048, 256, 0, stream>>>(H, out, SX);
#endif
}
```
